# Optimizing an MI355X kernel written in HIP

```python
import jax, jax.numpy as jnp
from jax import lax
import numpy as np

D_MODEL = 1024
BATCH = 4
SEQ = 8192
DEPTH = 2

LRU_WIDTH = D_MODEL
LRU_BLOCKS = 8
LRU_BLOCK_W = LRU_WIDTH // LRU_BLOCKS
CONV_W = 4
LRU_C = 8.0
MLA_HEADS = 8
QK_NOPE = 128
QK_ROPE = 64
QK_HEAD = QK_NOPE + QK_ROPE
V_HEAD = D_MODEL // MLA_HEADS
Q_RANK = 256
KV_RANK = 128
ROPE_THETA = 10000.0
Q_BLOCK = 128
D_FF = -(-8 * D_MODEL // (3 * 256)) * 256
EPS = 1e-6
D_IN = LRU_WIDTH + Q_RANK + KV_RANK + QK_ROPE + 2 * D_MODEL
IN_SPLIT_POINTS = (LRU_WIDTH,
                   LRU_WIDTH + Q_RANK,
                   LRU_WIDTH + Q_RANK + KV_RANK,
                   LRU_WIDTH + Q_RANK + KV_RANK + QK_ROPE,
                   LRU_WIDTH + Q_RANK + KV_RANK + QK_ROPE + D_MODEL)

kernel_name = 'hybrid_rglru_mla_adaln_block'


def rms_norm(x, gain=None):
    xf = x.astype(jnp.float32)
    y = xf * lax.rsqrt(jnp.mean(xf * xf, axis=-1, keepdims=True) + EPS)
    if gain is not None:
        y = y * gain.astype(jnp.float32)
    return y.astype(x.dtype)


def rope_tables(positions):
    inv_freq = ROPE_THETA ** (-jnp.arange(0, QK_ROPE, 2, dtype=jnp.float32) / QK_ROPE)
    ang = positions.astype(jnp.float32)[..., None] * inv_freq
    return jnp.cos(ang), jnp.sin(ang)


def apply_rope(x, cos, sin):
    half = QK_ROPE // 2
    xf = x.astype(jnp.float32)
    x1, x2 = xf[..., :half], xf[..., half:]
    return jnp.concatenate([x1 * cos - x2 * sin, x2 * cos + x1 * sin], axis=-1).astype(x.dtype)


def causal_depthwise_conv(x, w, b):
    y = lax.conv_general_dilated(x, w[:, None, :].astype(x.dtype), window_strides=(1,),
                                 padding=((CONV_W - 1, 0),),
                                 dimension_numbers=('NWC', 'WIO', 'NWC'),
                                 feature_group_count=x.shape[-1])
    return y + b


def rg_lru(x, positions, w_a, b_a, w_x, b_x, a_param):
    B, S, _ = x.shape
    xf = x.astype(jnp.float32)
    xb = xf.reshape(B, S, LRU_BLOCKS, LRU_BLOCK_W)
    r = jax.nn.sigmoid(jnp.einsum('bsni,nij->bsnj', xb, w_a.astype(jnp.float32))
                       + b_a.astype(jnp.float32)).reshape(B, S, LRU_WIDTH)
    i = jax.nn.sigmoid(jnp.einsum('bsni,nij->bsnj', xb, w_x.astype(jnp.float32))
                       + b_x.astype(jnp.float32)).reshape(B, S, LRU_WIDTH)
    log_a = -LRU_C * r * jax.nn.softplus(-a_param.astype(jnp.float32))
    reset = (positions == 0)[..., None]
    a = jnp.where(reset, 0.0, jnp.exp(log_a))
    mult = jnp.where(reset, 1.0, jnp.sqrt(-jnp.expm1(2.0 * log_a)))
    b_in = xf * i * mult

    def combine(left, right):
        return (left[0] * right[0], right[0] * left[1] + right[1])

    _, h = lax.associative_scan(combine, (a, b_in), axis=1)
    return h.astype(x.dtype)


def causal_block_attention(q, k, v):
    B, S, H, Dk = q.shape
    nb = S // Q_BLOCK
    scale = QK_HEAD ** -0.5
    qb = q.reshape(B, nb, Q_BLOCK, H, Dk).transpose(1, 0, 2, 3, 4)
    k_idx = jnp.arange(S)

    def one_block(args):
        q_blk, blk = args
        s = jnp.einsum('bqhd,bkhd->bhqk', q_blk, k, preferred_element_type=jnp.float32) * scale
        q_idx = blk * Q_BLOCK + jnp.arange(Q_BLOCK)
        s = jnp.where(k_idx[None, :] <= q_idx[:, None], s, -jnp.inf)
        p = jax.nn.softmax(s, axis=-1)
        o = jnp.einsum('bhqk,bkhd->bqhd', p.astype(v.dtype), v, preferred_element_type=jnp.float32)
        return o.astype(v.dtype)

    o = lax.map(one_block, (qb, jnp.arange(nb)))
    return o.transpose(1, 0, 2, 3, 4).reshape(B, S, H, v.shape[-1])


def mla(q_down, kv_down, k_rope, cos, sin, q_norm_g, kv_norm_g, w_uq, w_ukv):
    B, S, _ = q_down.shape
    c_q = rms_norm(q_down, q_norm_g)
    q = jnp.einsum('bsr,rhd->bshd', c_q, w_uq)
    q = jnp.concatenate([q[..., :QK_NOPE],
                         apply_rope(q[..., QK_NOPE:], cos[:, :, None, :], sin[:, :, None, :])], axis=-1)
    c_kv = rms_norm(kv_down, kv_norm_g)
    kv = jnp.einsum('bsr,rhd->bshd', c_kv, w_ukv)
    k_pe = apply_rope(k_rope, cos, sin)
    k = jnp.concatenate([kv[..., :QK_NOPE],
                         jnp.broadcast_to(k_pe[:, :, None, :], (B, S, MLA_HEADS, QK_ROPE))], axis=-1)
    v = kv[..., QK_NOPE:]
    o = causal_block_attention(q, k, v)
    return o.reshape(B, S, MLA_HEADS * V_HEAD)


def hybrid_layer(x, c, positions, cos, sin, w_ada, b_ada, w_in, conv_w, conv_b,
                 lru_wa, lru_ba, lru_wx, lru_bx, lru_a_param, q_norm_g, kv_norm_g,
                 w_uq, w_ukv, w_out, w_ffn_in, w_ffn_out):
    mod = (c @ w_ada + b_ada)[:, None, :]
    sh_m, sc_m, g_m, sh_f, sc_f, g_f = jnp.split(mod, 6, axis=-1)
    h = rms_norm(x) * (1 + sc_m) + sh_m
    proj = h @ w_in
    x_lru, q_down, kv_down, k_rope, gate_a, gate_b = jnp.split(proj, IN_SPLIT_POINTS, axis=-1)
    y_a = rg_lru(causal_depthwise_conv(x_lru, conv_w, conv_b), positions,
                 lru_wa, lru_ba, lru_wx, lru_bx, lru_a_param)
    y_b = mla(q_down, kv_down, k_rope, cos, sin, q_norm_g, kv_norm_g, w_uq, w_ukv)
    y = jax.nn.sigmoid(gate_a) * y_a + jax.nn.sigmoid(gate_b) * y_b
    x = x + g_m * (y @ w_out)
    h = rms_norm(x) * (1 + sc_f) + sh_f
    gate, up = jnp.split(h @ w_ffn_in, 2, axis=-1)
    x = x + g_f * ((jax.nn.silu(gate) * up) @ w_ffn_out)
    return x


def setup_inputs(seed: int = 0) -> dict:
    key = jax.random.key(seed)
    ks = jax.random.split(key, 24)
    f32 = jnp.float32
    x = jax.random.normal(ks[0], (BATCH, SEQ, D_MODEL), f32)
    c = jax.random.normal(ks[1], (BATCH, D_MODEL), f32)
    positions = jnp.broadcast_to(jnp.arange(SEQ, dtype=jnp.int32)[None, :], (BATCH, SEQ))
    w_ada = jax.random.normal(ks[2], (DEPTH, D_MODEL, 6 * D_MODEL), f32) * (0.3 * D_MODEL ** -0.5)
    b_ada = jax.random.normal(ks[3], (DEPTH, 6 * D_MODEL), f32) * 0.02
    w_in = jax.random.normal(ks[4], (DEPTH, D_MODEL, D_IN), f32) * D_MODEL ** -0.5
    conv_w = jax.random.normal(ks[5], (DEPTH, CONV_W, LRU_WIDTH), f32) * CONV_W ** -0.5
    conv_b = jax.random.normal(ks[6], (DEPTH, LRU_WIDTH), f32) * 0.01
    lru_wa = jax.random.normal(ks[7], (DEPTH, LRU_BLOCKS, LRU_BLOCK_W, LRU_BLOCK_W), f32) * LRU_BLOCK_W ** -0.5
    lru_ba = jax.random.normal(ks[8], (DEPTH, LRU_BLOCKS, LRU_BLOCK_W), f32) * 0.01
    lru_wx = jax.random.normal(ks[9], (DEPTH, LRU_BLOCKS, LRU_BLOCK_W, LRU_BLOCK_W), f32) * LRU_BLOCK_W ** -0.5
    lru_bx = jax.random.normal(ks[10], (DEPTH, LRU_BLOCKS, LRU_BLOCK_W), f32) * 0.01
    rad = jax.random.uniform(ks[11], (DEPTH, LRU_WIDTH), f32, minval=0.9, maxval=0.999)
    a0 = rad ** (1.0 / LRU_C)
    lru_a_param = jnp.log(a0) - jnp.log1p(-a0)
    q_norm_g = 1.0 + 0.01 * jax.random.normal(ks[12], (DEPTH, Q_RANK), f32)
    kv_norm_g = 1.0 + 0.01 * jax.random.normal(ks[13], (DEPTH, KV_RANK), f32)
    w_uq = jax.random.normal(ks[14], (DEPTH, Q_RANK, MLA_HEADS, QK_HEAD), f32) * Q_RANK ** -0.5
    w_ukv = jax.random.normal(ks[15], (DEPTH, KV_RANK, MLA_HEADS, QK_NOPE + V_HEAD), f32) * KV_RANK ** -0.5
    w_out = jax.random.normal(ks[16], (DEPTH, D_MODEL, D_MODEL), f32) * D_MODEL ** -0.5
    w_ffn_in = jax.random.normal(ks[17], (DEPTH, D_MODEL, 2 * D_FF), f32) * D_MODEL ** -0.5
    w_ffn_out = jax.random.normal(ks[18], (DEPTH, D_FF, D_MODEL), f32) * D_FF ** -0.5
    final_norm_g = 1.0 + 0.01 * jax.random.normal(ks[19], (D_MODEL,), f32)
    return {'x': x, 'c': c, 'positions': positions, 'w_ada': w_ada, 'b_ada': b_ada,
            'w_in': w_in, 'conv_w': conv_w, 'conv_b': conv_b, 'lru_wa': lru_wa,
            'lru_ba': lru_ba, 'lru_wx': lru_wx, 'lru_bx': lru_bx, 'lru_a_param': lru_a_param,
            'q_norm_g': q_norm_g, 'kv_norm_g': kv_norm_g, 'w_uq': w_uq, 'w_ukv': w_ukv,
            'w_out': w_out, 'w_ffn_in': w_ffn_in, 'w_ffn_out': w_ffn_out,
            'final_norm_g': final_norm_g}


def reference(x, c, positions, w_ada, b_ada, w_in, conv_w, conv_b, lru_wa, lru_ba, lru_wx,
              lru_bx, lru_a_param, q_norm_g, kv_norm_g, w_uq, w_ukv, w_out, w_ffn_in,
              w_ffn_out, final_norm_g):
    cos, sin = rope_tables(positions)
    for l in range(DEPTH):
        x = hybrid_layer(x, c, positions, cos, sin, w_ada[l], b_ada[l], w_in[l], conv_w[l],
                         conv_b[l], lru_wa[l], lru_ba[l], lru_wx[l], lru_bx[l], lru_a_param[l],
                         q_norm_g[l], kv_norm_g[l], w_uq[l], w_ukv[l], w_out[l],
                         w_ffn_in[l], w_ffn_out[l])
    return rms_norm(x, final_norm_g)
```

```cpp
#include <hip/hip_runtime.h>
#include <hip/hip_cooperative_groups.h>
#include <hip/hip_bf16.h>
#include <cstdio>
#include <cstdint>
namespace cg = cooperative_groups;
namespace pg8 {
#define PG8_LAS __attribute__((address_space(3)))
typedef unsigned short bf16_t;
typedef short bf16x8 __attribute__((ext_vector_type(8)));
typedef float f32x4 __attribute__((ext_vector_type(4)));
typedef unsigned u32x4 __attribute__((ext_vector_type(4)));
constexpr int BM = 256, BK = 64, HALF = 128, HTB = HALF * BK * 2  , STAGE_BYTES = 8 * HTB, NXCD = 8, WGM = 8;

__host__ __device__ __forceinline__ int lds_byte(int r, int c) { const int st = (r >> 4) * 2 + (c >> 5), rr = r & 15, cc = c & 31, ob = rr * 64 + cc * 2; return st * 1024 + (ob ^ (((ob >> 9) & 1) << 5)); }
__host__ __device__ __forceinline__ void stage_rc(int b, int& R, int& C) { const int st = b / 1024, sb = b % 1024, swz = sb ^ (((sb >> 9) & 1) << 5); R = (st >> 1) * 16 + swz / 64; C = (st & 1) * 32 + (swz % 64) / 2; }
__host__ __device__ __forceinline__ int perm32(int rho) { const int n = rho >> 4, i = rho & 15; return 8 * (i >> 2) + 4 * n + (i & 3); }

struct Unit { int pm, pn; };
struct Gemm { const bf16_t* A; const bf16_t* Bt; int M, N, K; };

struct StaticOrder {
    int nM, nN, nwg, G, c;
    __host__ __device__ void init(int M, int N, int G_, int c_) { nM = M / BM; nN = N / BM; nwg = nM * nN; G = G_; c = c_; }
    __host__ __device__ bool next(int i, Unit& u) const {
        const long L = (long)i * G + c; if (L >= nwg) return false;
        int wgid = (int)L; { const int q = nwg / NXCD, r = nwg % NXCD, xcd = wgid % NXCD, off = wgid / NXCD; wgid = (xcd < r ? xcd * (q + 1) : r * (q + 1) + (xcd - r) * q) + off; }
        const int nig = WGM * nN, gid = wgid / nig, fm = gid * WGM, gsz = (nM - fm) < WGM ? (nM - fm) : WGM;
        u.pm = fm + ((wgid % nig) % gsz); u.pn = (wgid % nig) / gsz; return true;
    }
    __device__ __forceinline__ void a_ready(const Unit&) const {}
    __device__ __forceinline__ void done(const Unit&) const {}
};

typedef float cvt_f32x2_t __attribute__((ext_vector_type(2))); typedef __bf16 cvt_bf16x2_t __attribute__((ext_vector_type(2)));
__device__ __forceinline__ unsigned cvt_pk_bf16(float lo, float hi) { cvt_f32x2_t v = {lo, hi}; cvt_bf16x2_t b = __builtin_convertvector(v, cvt_bf16x2_t); return __builtin_bit_cast(unsigned, b); }
typedef float f32x2 __attribute__((ext_vector_type(2)));
template <class Epi, class Sched, bool ALIGN_EPI = false, bool SP2 = false>
__device__ __forceinline__ void gemm_phase(PG8_LAS unsigned char* lds, const Gemm g, const Sched& S, const Epi& E) {
    int tid_ = threadIdx.x; asm volatile("" : "+v"(tid_));
    const int tid = tid_, wid = __builtin_amdgcn_readfirstlane(tid >> 6), lane = tid & 63, wr = wid >> 2, wc = wid & 3, fr = lane & 15, fq = lane >> 4;
    const int K = g.K, nt = K / BK;
    unsigned voffA[2], voffB[2];
#pragma unroll
    for (int i = 0; i < 2; ++i) { int R, C; stage_rc(tid * 16 + i * 8192, R, C); const int Rb = Epi::PERM ? ((R & ~31) + perm32(R & 31)) : R;
        voffA[i] = (unsigned)(R * K + C) * 2u; voffB[i] = (unsigned)(Rb * K + C) * 2u; }
    const size_t kstep = (size_t)(BK * 2);
    const size_t hstep = (size_t)HALF * K * 2;
    const size_t tstep = 2 * hstep;
    const unsigned ldsw = (unsigned)wid * 1024u;
    const int aoff = lds_byte(wr * 64 + fr, fq * 8), boff = lds_byte(wc * 32 + fr, fq * 8);
#define PG8_SA(b, h) (((b) * 2 + (h)) * HTB)
#define PG8_SB(b, h) ((4 + (b) * 2 + (h)) * HTB)
#define PG8_STAGE(bufoff, gbase, voff) do { _Pragma("unroll") for (int _i = 0; _i < 2; ++_i) \
        __builtin_amdgcn_global_load_lds((const unsigned*)((const char*)(gbase) + (voff)[_i]), (PG8_LAS unsigned*)(lds + (bufoff) + ldsw + _i * 8192), 16, 0, 0); } while (0)
#define PG8_LDA(dst, b, h) do { _Pragma("unroll") for (int m = 0; m < 4; ++m) _Pragma("unroll") for (int k = 0; k < 2; ++k) dst[m][k] = *(const PG8_LAS bf16x8*)(lds + PG8_SA(b, h) + aoff + m * 2048 + k * 1024); } while (0)
#define PG8_LDB(dst, b, h) do { _Pragma("unroll") for (int n = 0; n < 2; ++n) _Pragma("unroll") for (int k = 0; k < 2; ++k) dst[n][k] = *(const PG8_LAS bf16x8*)(lds + PG8_SB(b, h) + boff + n * 2048 + k * 1024); } while (0)
#define PG8_MMA(ai, bj, At, Bt) do { __builtin_amdgcn_s_setprio(1); _Pragma("unroll") for (int m = 0; m < 4; ++m) _Pragma("unroll") for (int n = 0; n < 2; ++n) _Pragma("unroll") for (int k = 0; k < 2; ++k) \
        acc[ai][bj][m][n] = __builtin_amdgcn_mfma_f32_16x16x32_bf16(Bt[n][k], At[m][k], acc[ai][bj][m][n], 0, 0, 0); __builtin_amdgcn_s_setprio(0); } while (0)
#define PG8_WAIT_V(n) asm volatile("s_waitcnt vmcnt(" #n ")" ::: "memory")
#define PG8_WAIT_L(n) asm volatile("s_waitcnt lgkmcnt(" #n ")" ::: "memory")
#define PG8_BAR __builtin_amdgcn_s_barrier()
#define PG8_SCHED __builtin_amdgcn_sched_barrier(0)
    Unit cur, nxt; int ui = 0;
    if (!S.next(0, cur)) return;
    f32x4 acc[2][2][4][2];
#pragma unroll
    for (int a = 0; a < 2; ++a)
#pragma unroll
        for (int b = 0; b < 2; ++b)
#pragma unroll
            for (int m = 0; m < 4; ++m)
#pragma unroll
                for (int n = 0; n < 2; ++n) acc[a][b][m][n] = (f32x4){0.f, 0.f, 0.f, 0.f};
    bf16x8 At[4][2], B0[2][2], B1[2][2];
    const char* cA = (const char*)g.A + (size_t)cur.pm * tstep; const char* cB = (const char*)g.Bt + (size_t)cur.pn * tstep;
    S.a_ready(cur);
    if constexpr (SP2) {
        PG8_STAGE(PG8_SB(0, 0), cB, voffB); PG8_STAGE(PG8_SB(0, 1), cB + hstep, voffB); PG8_STAGE(PG8_SA(0, 0), cA, voffA); PG8_STAGE(PG8_SA(0, 1), cA + hstep, voffA);
        if (wr == 1) PG8_BAR;
        PG8_WAIT_V(2); PG8_BAR;
        PG8_STAGE(PG8_SB(1, 0), cB + kstep, voffB); PG8_STAGE(PG8_SA(1, 0), cA + kstep, voffA); PG8_STAGE(PG8_SB(1, 1), cB + hstep + kstep, voffB);
        PG8_WAIT_V(6); PG8_BAR;
    } else {
        PG8_STAGE(PG8_SB(0, 0), cB, voffB); PG8_STAGE(PG8_SA(0, 0), cA, voffA); PG8_STAGE(PG8_SB(0, 1), cB + hstep, voffB); PG8_STAGE(PG8_SA(0, 1), cA + hstep, voffA);
        if (wr == 1) PG8_BAR;
        PG8_WAIT_V(4); PG8_BAR;
        PG8_STAGE(PG8_SB(1, 0), cB + kstep, voffB); PG8_STAGE(PG8_SA(1, 0), cA + kstep, voffA); PG8_STAGE(PG8_SB(1, 1), cB + hstep + kstep, voffB);
        PG8_WAIT_V(6); PG8_BAR;
    }
    for (;;) {
        const bool has_next = S.next(ui + 1, nxt);
        const char* nA = has_next ? (const char*)g.A + (size_t)nxt.pm * tstep : cA; const char* nB = has_next ? (const char*)g.Bt + (size_t)nxt.pn * tstep : cB;
        for (int t = 0; t < nt; t += 2) {
            const bool last = (t == nt - 2);
            const char* a1 = cA + (size_t)(t + 1) * kstep;
            const char* a2 = last ? nA : cA + (size_t)(t + 2) * kstep; const char* b2 = last ? nB : cB + (size_t)(t + 2) * kstep;
            const char* a3 = a2 + kstep; const char* b3 = b2 + kstep;
            if (last && has_next) S.a_ready(nxt);
            if constexpr (SP2) {
            PG8_LDB(B0, 0, 0); PG8_LDB(B1, 0, 1); PG8_SCHED; PG8_LDA(At, 0, 0); PG8_STAGE(PG8_SA(1, 1), a1 + hstep, voffA);
            PG8_WAIT_V(8); PG8_WAIT_L(0); PG8_BAR; PG8_MMA(0, 0, At, B0); PG8_MMA(0, 1, At, B1); PG8_BAR; PG8_SCHED;
            PG8_LDA(At, 0, 1); PG8_STAGE(PG8_SB(0, 0), b2, voffB); PG8_STAGE(PG8_SB(0, 1), b2 + hstep, voffB); PG8_STAGE(PG8_SA(0, 0), a2, voffA);
            PG8_WAIT_V(8); PG8_WAIT_L(0); PG8_BAR; PG8_MMA(1, 0, At, B0); PG8_MMA(1, 1, At, B1); PG8_BAR; PG8_SCHED;
            PG8_LDB(B0, 1, 0); PG8_LDB(B1, 1, 1); PG8_SCHED; PG8_LDA(At, 1, 0); PG8_STAGE(PG8_SA(0, 1), a2 + hstep, voffA);
            PG8_WAIT_V(8); PG8_WAIT_L(0); PG8_BAR; PG8_MMA(0, 0, At, B0); PG8_MMA(0, 1, At, B1); PG8_BAR; PG8_SCHED;
            PG8_LDA(At, 1, 1); PG8_STAGE(PG8_SB(1, 0), b3, voffB); PG8_STAGE(PG8_SB(1, 1), b3 + hstep, voffB); PG8_STAGE(PG8_SA(1, 0), a3, voffA);
            PG8_WAIT_V(8); PG8_WAIT_L(0); PG8_BAR; PG8_MMA(1, 0, At, B0); PG8_MMA(1, 1, At, B1); PG8_BAR; PG8_SCHED;
            } else {
            PG8_LDB(B0, 0, 0); PG8_SCHED; PG8_LDA(At, 0, 0); PG8_STAGE(PG8_SA(1, 1), a1 + hstep, voffA);
            PG8_WAIT_L(8); PG8_BAR; PG8_WAIT_L(0); PG8_MMA(0, 0, At, B0); PG8_BAR; PG8_SCHED;
            PG8_LDB(B1, 0, 1); PG8_STAGE(PG8_SB(0, 0), b2, voffB);
            PG8_BAR; PG8_WAIT_L(0); PG8_MMA(0, 1, At, B1); PG8_BAR;
            PG8_LDA(At, 0, 1); PG8_STAGE(PG8_SA(0, 0), a2, voffA);
            PG8_BAR; PG8_WAIT_L(0); PG8_MMA(1, 0, At, B0); PG8_BAR; PG8_SCHED;
            PG8_STAGE(PG8_SB(0, 1), b2 + hstep, voffB);
            PG8_WAIT_V(6); PG8_BAR; PG8_MMA(1, 1, At, B1); PG8_BAR;
            PG8_LDB(B0, 1, 0); PG8_SCHED; PG8_LDA(At, 1, 0); PG8_STAGE(PG8_SA(0, 1), a2 + hstep, voffA);
            PG8_WAIT_L(8); PG8_BAR; PG8_WAIT_L(0); PG8_MMA(0, 0, At, B0); PG8_BAR; PG8_SCHED;
            PG8_LDB(B1, 1, 1); PG8_STAGE(PG8_SB(1, 0), b3, voffB);
            PG8_BAR; PG8_WAIT_L(0); PG8_MMA(0, 1, At, B1); PG8_BAR;
            PG8_LDA(At, 1, 1); PG8_STAGE(PG8_SA(1, 0), a3, voffA);
            PG8_BAR; PG8_WAIT_L(0); PG8_MMA(1, 0, At, B0); PG8_BAR; PG8_SCHED;
            PG8_STAGE(PG8_SB(1, 1), b3 + hstep, voffB);
            PG8_WAIT_V(6); PG8_BAR; PG8_MMA(1, 1, At, B1); PG8_BAR;
            }
        }
        if constexpr (ALIGN_EPI) { if (wr == 0) PG8_BAR; }
        if constexpr (!Epi::AFTER_DRAIN) { E(acc, cur, wr, wc, fr, fq); S.done(cur); }
        if (!has_next) break;
#pragma unroll
        for (int a = 0; a < 2; ++a)
#pragma unroll
            for (int b = 0; b < 2; ++b)
#pragma unroll
                for (int m = 0; m < 4; ++m)
#pragma unroll
                    for (int n = 0; n < 2; ++n) acc[a][b][m][n] = (f32x4){0.f, 0.f, 0.f, 0.f};
        cur = nxt; cA = nA; cB = nB; ++ui;
        if constexpr (ALIGN_EPI) { if (wr == 1) PG8_BAR; }
    }
    PG8_WAIT_V(0);
    if constexpr (!ALIGN_EPI) { if (wr == 0) PG8_BAR; }
    PG8_BAR;
    if constexpr (Epi::AFTER_DRAIN) { E.fused(acc, cur, wr, wc, fr, fq, lds, wid, lane); S.done(cur); }
#undef PG8_SA
#undef PG8_SB
#undef PG8_STAGE
#undef PG8_LDA
#undef PG8_LDB
#undef PG8_MMA
#undef PG8_WAIT_V
#undef PG8_WAIT_L
#undef PG8_BAR
#undef PG8_SCHED
}
}
#define LAS __attribute__((address_space(3)))
typedef unsigned short bf16;
typedef float f32x4 __attribute__((ext_vector_type(4)));
typedef float f32x2 __attribute__((ext_vector_type(2)));
typedef float f32x16 __attribute__((ext_vector_type(16)));
typedef unsigned u32x4 __attribute__((ext_vector_type(4)));
typedef unsigned u32x2 __attribute__((ext_vector_type(2)));
typedef short bf16x8 __attribute__((ext_vector_type(8)));
typedef short s16x4 __attribute__((ext_vector_type(4)));
using pg8::Unit; using pg8::cvt_pk_bf16;

constexpr int NB = 4, SEQ = 8192, T = NB * SEQ, DM = 1024, DEPTH = 2, DINP = 3584, DFF = 2816, NMOD = 6144;
constexpr float EPS = 1e-6f;
constexpr size_t MiB = 1u << 20;
constexpr size_t WS_MOD = 0, WS_SHWIN = 256 * 1024, WS_SHWF = 512 * 1024, WS_SS = 1 * MiB, WS_SUMP = 3 * MiB, WS_SUMH = 4 * MiB, WS_CS = 8 * MiB, WS_W = 16 * MiB;
constexpr size_t WL_STRIDE = 28 * MiB, WL_IN = 0, WL_OUT = 7 * MiB, WL_FFI = 9 * MiB, WL_FFO = 20 * MiB, WL_UQ = 25 * MiB + 512 * 1024, WL_UKV = 26 * MiB + 256 * 1024, WL_LRU = 26 * MiB + 768 * 1024;
constexpr size_t WS_XS = 72 * MiB, WS_XL = 136 * MiB, WS_SGA = 200 * MiB, WS_SGB = 264 * MiB, WS_UU = 136 * MiB, WS_QD = 328 * MiB, WS_KVD = 344 * MiB, WS_KROPE = 352 * MiB,
                 WS_KR = 360 * MiB, WS_QN = 364 * MiB, WS_QR = 396 * MiB, WS_KN = 412 * MiB, WS_V = 444 * MiB, WS_END = 476 * MiB;
constexpr size_t WS_BAR = 5 * MiB;
constexpr int LDS_BYTES = 147456, LDS_XB = 144384;

__device__ const float INV_FREQ[32] = {1.0f, 0.7498942613601685f, 0.5623413324356079f, 0.4216965138912201f, 0.3162277638912201f, 0.23713737726211548f, 0.17782793939113617f, 0.133352130651474f, 0.10000000149011612f, 0.07498941570520401f, 0.05623413249850273f, 0.04216965287923813f, 0.03162277489900589f, 0.023713737726211548f, 0.017782794311642647f, 0.01333521492779255f, 0.009999999776482582f, 0.007498941849917173f, 0.005623413249850273f, 0.0042169648222625256f, 0.003162277629598975f, 0.00237137358635664f, 0.0017782794311642647f, 0.0013335214462131262f, 0.0010000000474974513f, 0.0007498942431993783f, 0.000562341301701963f, 0.0004216965171508491f, 0.0003162277571391314f, 0.00023713737027719617f, 0.00017782794020604342f, 0.0001333521504420787f};

struct Args {
    const float* x; const float* c; const int* pos; const float* w_ada; const float* b_ada; const float* w_in; const float* conv_w; const float* conv_b;
    const float* lru_wa; const float* lru_ba; const float* lru_wx; const float* lru_bx; const float* lru_a; const float* qg; const float* kvg;
    const float* w_uq; const float* w_ukv; const float* w_out; const float* w_ffi; const float* w_ffo; const float* fg;
    float* out; unsigned char* ws;
};

__device__ __forceinline__ float bf2f(bf16 u) { return __uint_as_float(((unsigned)u) << 16); }
__device__ __forceinline__ unsigned f2bf(float f) { unsigned u = __float_as_uint(f); return (u + 0x7fffu + ((u >> 16) & 1u)) >> 16; }
__device__ __forceinline__ float sigmoidf_(float x) { return __builtin_amdgcn_rcpf(1.0f + __builtin_amdgcn_exp2f(-1.4426950408889634f * x)); }
__device__ __forceinline__ void store8bf(bf16* p, f32x4 a, f32x4 b) { u32x4 w; w.x = cvt_pk_bf16(a[0], a[1]); w.y = cvt_pk_bf16(a[2], a[3]); w.z = cvt_pk_bf16(b[0], b[1]); w.w = cvt_pk_bf16(b[2], b[3]); *(u32x4*)p = w; }
__device__ __forceinline__ float sumsq4(f32x4 v) { return (v[0] * v[0] + v[1] * v[1]) + (v[2] * v[2] + v[3] * v[3]); }
__device__ __forceinline__ void atomic_addf(float* p, float v) { (void)__hip_atomic_fetch_add(p, v, __ATOMIC_RELAXED, __HIP_MEMORY_SCOPE_AGENT); }
__device__ __forceinline__ float wave_sum(float v) {
#pragma unroll
    for (int o = 1; o < 64; o <<= 1) v += __shfl_xor(v, o);
    return v;
}
#define LDS_WAIT() asm volatile("s_waitcnt lgkmcnt(0)" ::: "memory")

struct EpiIn {
    static constexpr bool PERM = true, AFTER_DRAIN = false;
    const float* ss; const float* shw; bf16* XL; bf16* QD; bf16* KVD; float* KROPE; bf16* SGA; bf16* SGB; float* ssq; float* sskv;
    __device__ __forceinline__ void operator()(const f32x4 (&acc)[2][2][4][2], const Unit& u, int wr, int wc, int fr, int fq) const {
        const int row0 = u.pm * 256 + wr * 64 + fr, b = u.pm >> 5, pn = u.pn, c8 = wc * 32 + 8 * fq;
        f32x4 sv[2][2];
#pragma unroll
        for (int bj = 0; bj < 2; ++bj)
#pragma unroll
            for (int n = 0; n < 2; ++n) sv[bj][n] = *(const f32x4*)(shw + b * DINP + pn * 256 + bj * 128 + c8 + 4 * n);
        float ssv[2][4];
#pragma unroll
        for (int ai = 0; ai < 2; ++ai)
#pragma unroll
            for (int m = 0; m < 4; ++m) ssv[ai][m] = ss[row0 + ai * 128 + m * 16];
#pragma unroll
        for (int ai = 0; ai < 2; ++ai)
#pragma unroll
            for (int m = 0; m < 4; ++m) {
                const size_t row = (size_t)(row0 + ai * 128 + m * 16);
                const float rstd = __builtin_amdgcn_rsqf(ssv[ai][m] * (1.0f / 1024.0f) + EPS);
                f32x4 v[2][2];
#pragma unroll
                for (int bj = 0; bj < 2; ++bj)
#pragma unroll
                    for (int n = 0; n < 2; ++n) v[bj][n] = acc[ai][bj][m][n] * rstd + sv[bj][n];
                if (pn < 4) {
#pragma unroll
                    for (int bj = 0; bj < 2; ++bj) store8bf(XL + row * 1024 + pn * 256 + bj * 128 + c8, v[bj][0], v[bj][1]);
                } else if (pn == 4) {
#pragma unroll
                    for (int bj = 0; bj < 2; ++bj) store8bf(QD + row * 256 + bj * 128 + c8, v[bj][0], v[bj][1]);
                    float s = (sumsq4(v[0][0]) + sumsq4(v[0][1])) + (sumsq4(v[1][0]) + sumsq4(v[1][1]));
                    s += __shfl_xor(s, 16); s += __shfl_xor(s, 32);
                    if (fq == 0) atomic_addf(ssq + row, s);
                } else if (pn == 5) {
                    store8bf(KVD + row * 128 + c8, v[0][0], v[0][1]);
                    float s = sumsq4(v[0][0]) + sumsq4(v[0][1]);
                    s += __shfl_xor(s, 16); s += __shfl_xor(s, 32);
                    if (fq == 0) atomic_addf(sskv + row, s);
                    if (wc < 2) { *(f32x4*)(KROPE + row * 64 + c8) = v[1][0]; *(f32x4*)(KROPE + row * 64 + c8 + 4) = v[1][1]; }
                } else {
                    bf16* G = (pn < 10) ? SGA + (pn - 6) * 256 : SGB + (pn - 10) * 256;
#pragma unroll
                    for (int bj = 0; bj < 2; ++bj) {
                        f32x4 a, c;
#pragma unroll
                        for (int j = 0; j < 4; ++j) { a[j] = sigmoidf_(v[bj][0][j]); c[j] = sigmoidf_(v[bj][1][j]); }
                        store8bf(G + row * 1024 + bj * 128 + c8, a, c);
                    }
                }
            }
    }
};
struct EpiQ {
    static constexpr bool PERM = true, AFTER_DRAIN = false;
    const float* ssq; const float* cs; bf16* QN; bf16* QR;
    __device__ __forceinline__ void operator()(const f32x4 (&acc)[2][2][4][2], const Unit& u, int wr, int wc, int fr, int fq) const {
        const int row0 = u.pm * 256 + wr * 64 + fr, pn = u.pn, c8 = wc * 32 + 8 * fq;
        float ssv[2][4];
#pragma unroll
        for (int ai = 0; ai < 2; ++ai)
#pragma unroll
            for (int m = 0; m < 4; ++m) ssv[ai][m] = ssq[row0 + ai * 128 + m * 16];
#pragma unroll
        for (int ai = 0; ai < 2; ++ai)
#pragma unroll
            for (int m = 0; m < 4; ++m) {
                const size_t row = (size_t)(row0 + ai * 128 + m * 16);
                const float rstd = __builtin_amdgcn_rsqf(ssv[ai][m] * (1.0f / 256.0f) + EPS);
                if (pn < 2) {
#pragma unroll
                    for (int bj = 0; bj < 2; ++bj) store8bf(QN + row * 512 + pn * 256 + bj * 128 + c8, acc[ai][bj][m][0] * rstd, acc[ai][bj][m][1] * rstd);
                } else {
                    const int i0 = (wc & 1) * 16 + 4 * fq;
                    const f32x4 cs0 = *(const f32x4*)(cs + row * 64 + 2 * i0), cs1 = *(const f32x4*)(cs + row * 64 + 2 * i0 + 4);
#pragma unroll
                    for (int bj = 0; bj < 2; ++bj) {
                        const f32x4 a = acc[ai][bj][m][0] * rstd, c = acc[ai][bj][m][1] * rstd; f32x4 oa, oc;
                        oa[0] = a[0] * cs0[0] - a[1] * cs0[1]; oa[1] = a[1] * cs0[0] + a[0] * cs0[1];
                        oa[2] = a[2] * cs0[2] - a[3] * cs0[3]; oa[3] = a[3] * cs0[2] + a[2] * cs0[3];
                        oc[0] = c[0] * cs1[0] - c[1] * cs1[1]; oc[1] = c[1] * cs1[0] + c[0] * cs1[1];
                        oc[2] = c[2] * cs1[2] - c[3] * cs1[3]; oc[3] = c[3] * cs1[2] + c[2] * cs1[3];
                        store8bf(QR + row * 256 + bj * 128 + c8, oa, oc);
                    }
                }
            }
    }
};
struct EpiKV {
    static constexpr bool PERM = true, AFTER_DRAIN = false;
    const float* sskv; bf16* KN; bf16* V;
    __device__ __forceinline__ void operator()(const f32x4 (&acc)[2][2][4][2], const Unit& u, int wr, int wc, int fr, int fq) const {
        const int row0 = u.pm * 256 + wr * 64 + fr, pn = u.pn, c8 = wc * 32 + 8 * fq;
        bf16* O = (pn < 2) ? KN + pn * 256 : V + (pn - 2) * 256;
        float ssv[2][4];
#pragma unroll
        for (int ai = 0; ai < 2; ++ai)
#pragma unroll
            for (int m = 0; m < 4; ++m) ssv[ai][m] = sskv[row0 + ai * 128 + m * 16];
#pragma unroll
        for (int ai = 0; ai < 2; ++ai)
#pragma unroll
            for (int m = 0; m < 4; ++m) {
                const size_t row = (size_t)(row0 + ai * 128 + m * 16);
                const float rstd = __builtin_amdgcn_rsqf(ssv[ai][m] * (1.0f / 128.0f) + EPS);
#pragma unroll
                for (int bj = 0; bj < 2; ++bj) store8bf(O + row * 512 + bj * 128 + c8, acc[ai][bj][m][0] * rstd, acc[ai][bj][m][1] * rstd);
            }
    }
};
struct EpiRes {
    static constexpr bool PERM = false, AFTER_DRAIN = false;
    const float* xres; float* xout; const float* g; const float* sc; bf16* XS; float* ssn;
    __device__ __forceinline__ void operator()(const f32x4 (&acc)[2][2][4][2], const Unit& u, int wr, int wc, int fr, int fq) const {
        const int row0 = u.pm * 256 + wr * 64 + fr, b = u.pm >> 5, col0 = u.pn * 256 + wc * 32 + 4 * fq;
        f32x4 gv[2][2], scv[2][2];
#pragma unroll
        for (int bj = 0; bj < 2; ++bj)
#pragma unroll
            for (int n = 0; n < 2; ++n) { gv[bj][n] = *(const f32x4*)(g + b * NMOD + col0 + bj * 128 + n * 16);
                scv[bj][n] = sc ? *(const f32x4*)(sc + b * NMOD + col0 + bj * 128 + n * 16) + 1.0f : (f32x4){1.f, 1.f, 1.f, 1.f}; }
#pragma unroll
        for (int ai = 0; ai < 2; ++ai)
#pragma unroll
        for (int mp = 0; mp < 2; ++mp) {
            f32x4 pre[2][2][2];
#pragma unroll
            for (int mm = 0; mm < 2; ++mm)
#pragma unroll
                for (int bj = 0; bj < 2; ++bj)
#pragma unroll
                    for (int n = 0; n < 2; ++n) pre[mm][bj][n] = *(const f32x4*)(xres + (size_t)(row0 + ai * 128 + (2 * mp + mm) * 16) * 1024 + col0 + bj * 128 + n * 16);
#pragma unroll
            for (int mm = 0; mm < 2; ++mm) { const int m = 2 * mp + mm;
                const size_t row = (size_t)(row0 + ai * 128 + m * 16); float s = 0.f;
#pragma unroll
                for (int bj = 0; bj < 2; ++bj)
#pragma unroll
                    for (int n = 0; n < 2; ++n) { const size_t off = row * 1024 + col0 + bj * 128 + n * 16;
                        const f32x4 xv = pre[mm][bj][n] + gv[bj][n] * acc[ai][bj][m][n];
                        *(f32x4*)(xout + off) = xv; s += sumsq4(xv);
                        if (sc) { const f32x4 y = xv * scv[bj][n]; u32x2 w; w.x = cvt_pk_bf16(y[0], y[1]); w.y = cvt_pk_bf16(y[2], y[3]); *(u32x2*)(XS + off) = w; } }
                s += __shfl_xor(s, 16); s += __shfl_xor(s, 32);
                if (fq == 0) atomic_addf(ssn + row, s);
            }
        }
    }
};
struct EpiFfi {
    static constexpr bool PERM = true, AFTER_DRAIN = false;
    const float* ss; const float* shw; bf16* UU;
    __device__ __forceinline__ void operator()(const f32x4 (&acc)[2][2][4][2], const Unit& u, int wr, int wc, int fr, int fq) const {
        const int row0 = u.pm * 256 + wr * 64 + fr, b = u.pm >> 5, pn = u.pn, c8 = wc * 32 + 8 * fq;
        f32x4 sv[2][2];
#pragma unroll
        for (int bj = 0; bj < 2; ++bj)
#pragma unroll
            for (int n = 0; n < 2; ++n) sv[bj][n] = *(const f32x4*)(shw + b * (2 * DFF) + pn * 256 + bj * 128 + c8 + 4 * n);
        float ssv[2][4];
#pragma unroll
        for (int ai = 0; ai < 2; ++ai)
#pragma unroll
            for (int m = 0; m < 4; ++m) ssv[ai][m] = ss[row0 + ai * 128 + m * 16];
#pragma unroll
        for (int ai = 0; ai < 2; ++ai)
#pragma unroll
            for (int m = 0; m < 4; ++m) {
                const size_t row = (size_t)(row0 + ai * 128 + m * 16);
                const float rstd = __builtin_amdgcn_rsqf(ssv[ai][m] * (1.0f / 1024.0f) + EPS);
                f32x4 h[2];
#pragma unroll
                for (int n = 0; n < 2; ++n) { const f32x4 gt = acc[ai][0][m][n] * rstd + sv[0][n], up = acc[ai][1][m][n] * rstd + sv[1][n];
#pragma unroll
                    for (int j = 0; j < 4; ++j) h[n][j] = gt[j] * sigmoidf_(gt[j]) * up[j]; }
                store8bf(UU + row * DFF + pn * 128 + c8, h[0], h[1]);
            }
    }
};
#define XB_TMO      128
#define XB_XCNT(j)  (256  + 64 * (j))
#define XB_XSUB(j)  (1280 + 64 * (j))
#define XB_XGEN(j)  (2304 + 64 * (j))
#define XB_TOP      3328
#define XB_TOPGEN   3392
#define XCD_BAR_WORDS 3456
#define XB_SPIN_CAP (1u << 18)

__device__ __forceinline__ unsigned xb_ld(unsigned* p)              { return __hip_atomic_load(p, __ATOMIC_RELAXED, __HIP_MEMORY_SCOPE_AGENT); }
__device__ __forceinline__ unsigned xb_add(unsigned* p, unsigned v) { return __hip_atomic_fetch_add(p, v, __ATOMIC_RELAXED, __HIP_MEMORY_SCOPE_AGENT); }
__device__ __forceinline__ unsigned xb_xcc_id() { return (unsigned)__builtin_amdgcn_s_getreg((3 << 11) | 20) & 0xFu; }
#define XB_SPIN(cond, bar) do { unsigned _sp = 0; while (cond) { __builtin_amdgcn_s_sleep(1); \
    if ((++_sp & 255u) == 0u) { if (xb_ld(&(bar)[XB_TMO])) break; if (_sp > XB_SPIN_CAP) { atomicAdd(&(bar)[XB_TMO], 1u); break; } } } } while (0)

struct XcdBarrier {
    unsigned* bar; unsigned x;
    volatile LAS unsigned* st;
};

__device__ __forceinline__ XcdBarrier xcd_barrier_post(unsigned* bar, volatile LAS unsigned* st) {
    XcdBarrier b; b.bar = bar; b.x = xb_xcc_id(); b.st = st;
    if (threadIdx.x == 0) (void)xb_add(&bar[XB_XCNT(b.x)], 1u);
    return b;
}
__device__ __forceinline__ void xcd_barrier_complete(unsigned* bar, unsigned x, unsigned& nloc, unsigned& nx) {
    const unsigned G = gridDim.x * gridDim.y * gridDim.z;
    unsigned sum, cnt, mine, sp = 0u;
    for (;;) {
        sum = 0u; cnt = 0u; mine = 0u;
#pragma unroll
        for (unsigned j = 0; j < 16; ++j) { const unsigned c = xb_ld(&bar[XB_XCNT(j)]); sum += c; cnt += (c > 0u) ? 1u : 0u; mine = (j == x) ? c : mine; }
        if (sum == G) break;
        __builtin_amdgcn_s_sleep(1);
        if ((++sp & 255u) == 0u) { if (xb_ld(&bar[XB_TMO])) break; if (sp > XB_SPIN_CAP) { atomicAdd(&bar[XB_TMO], 1u); break; } }
    }
    nloc = mine > 0u ? mine : 1u; nx = cnt > 0u ? cnt : 1u;
}

__device__ __forceinline__ void xcd_barrier(const XcdBarrier& b) {
    asm volatile("s_waitcnt vmcnt(0)" ::: "memory");
    __syncthreads();
    if (threadIdx.x == 0) {
        unsigned* bar = b.bar;
        __builtin_amdgcn_s_waitcnt(0);
        unsigned nloc = b.st[0], nx = b.st[1];
        if (nloc == 0u) { xcd_barrier_complete(bar, b.x, nloc, nx); b.st[0] = nloc; b.st[1] = nx; }
        const unsigned old = xb_add(&bar[XB_XSUB(b.x)], 1u);
        const unsigned gen = old / nloc;
        if (old + 1u == (gen + 1u) * nloc) {
            __builtin_amdgcn_fence(__ATOMIC_RELEASE, "agent");
            asm volatile("s_waitcnt vmcnt(0)" ::: "memory");
            const unsigned og = xb_add(&bar[XB_TOP], 1u);
            const unsigned tg = og / nx;
            if (og + 1u == (tg + 1u) * nx) xb_add(&bar[XB_TOPGEN], 1u);
            else XB_SPIN(xb_ld(&bar[XB_TOPGEN]) == tg, bar);
            __builtin_amdgcn_fence(__ATOMIC_ACQUIRE, "agent");
            xb_add(&bar[XB_XGEN(b.x)], 1u);
            asm volatile("s_waitcnt vmcnt(0)" ::: "memory");
        } else {
            XB_SPIN(xb_ld(&bar[XB_XGEN(b.x)]) == gen, bar);
            __builtin_amdgcn_fence(__ATOMIC_ACQUIRE, "agent");
            asm volatile("s_waitcnt vmcnt(0)" ::: "memory");
        }
    }
    __syncthreads();
}
__device__ __forceinline__ int map_col(int id, int n) {
    switch (id) {
        case 0: return n < 1472 ? n : (n < 1536 ? -1 : n - 64);
        case 2: { const int pn = n >> 8, w = n & 255; return w < 128 ? pn * 128 + w : DFF + pn * 128 + (w - 128); }
        case 3: { const int hh = n / 768; int r = n % 768;
                  if (r < 512) return (4 * hh + (r >> 7)) * 192 + (r & 127);
                  r -= 512; const int e = r & 63; return (4 * hh + (r >> 6)) * 192 + 128 + (e >> 1) + 32 * (e & 1); }
        case 4: { const int hh = n >> 10; int r = n & 1023;
                  if (r < 512) return (4 * hh + (r >> 7)) * 256 + (r & 127);
                  r -= 512; return (4 * hh + (r >> 7)) * 256 + 128 + (r & 127); }
        default: return n;
    }
}
__device__ __forceinline__ void transpose_item(const float* W, int ldw, int K, bf16* WT, int id, const float* kscale, int nblk, int item, LAS float* scr, int lane) {
    const int kb = item / nblk, nb = item % nblk, k0 = 64 * kb, n0 = 32 * nb;
    const int sc = map_col(id, n0 + (lane & 31));
#pragma unroll 16
    for (int i = 0; i < 32; ++i) { const int kk = 2 * i + (lane >> 5); float v = sc >= 0 ? W[(size_t)(k0 + kk) * ldw + sc] : 0.f; if (kscale) v *= kscale[k0 + kk]; scr[kk * 33 + (lane & 31)] = v; }
    LDS_WAIT(); asm volatile("" ::: "memory");
    const int c = lane & 7;
#pragma unroll
    for (int j = 0; j < 4; ++j) { const int n = (lane >> 3) + 8 * j; const LAS float* s = scr + (8 * c) * 33 + n;
        u32x4 o; o.x = cvt_pk_bf16(s[0 * 33], s[1 * 33]); o.y = cvt_pk_bf16(s[2 * 33], s[3 * 33]); o.z = cvt_pk_bf16(s[4 * 33], s[5 * 33]); o.w = cvt_pk_bf16(s[6 * 33], s[7 * 33]);
        *(u32x4*)(WT + (size_t)(n0 + n) * K + k0 + 8 * c) = o; }
    LDS_WAIT(); asm volatile("" ::: "memory");
}
#define OPAQUE_TID() int tid_ = threadIdx.x; asm volatile("" : "+v"(tid_)); const int lane = tid_ & 63, wave = __builtin_amdgcn_readfirstlane(tid_ >> 6), NGW = gridDim.x * 8, gw = blockIdx.x * 8 + wave; (void)lane; (void)wave; (void)NGW; (void)gw
__device__ __forceinline__ void phase0(const Args& a, LAS unsigned char* lds) {
    OPAQUE_TID();
    LAS float* scr = (LAS float*)(lds + wave * 16384);
    float* mod = (float*)(a.ws + WS_MOD);
    for (int it = blockIdx.x; it < DEPTH * (NMOD / 64); it += gridDim.x) {
        const int l = it / (NMOD / 64), n = (it % (NMOD / 64)) * 64 + lane;
        float a0 = 0.f, a1 = 0.f, a2 = 0.f, a3 = 0.f;
        const float* w = a.w_ada + (size_t)l * DM * NMOD + (size_t)(wave * 128) * NMOD + n; const float* cc = a.c + wave * 128;
#pragma unroll 16
        for (int k = 0; k < 128; ++k) { const float wv = w[(size_t)k * NMOD]; a0 += cc[k] * wv; a1 += cc[DM + k] * wv; a2 += cc[2 * DM + k] * wv; a3 += cc[3 * DM + k] * wv; }
        LAS float* red = (LAS float*)(lds + 73728);
        red[(wave * 4 + 0) * 64 + lane] = a0; red[(wave * 4 + 1) * 64 + lane] = a1; red[(wave * 4 + 2) * 64 + lane] = a2; red[(wave * 4 + 3) * 64 + lane] = a3;
        __syncthreads();
        if (wave < 4) { float s = a.b_ada[l * NMOD + n];
#pragma unroll
            for (int q = 0; q < 8; ++q) s += red[(q * 4 + wave) * 64 + lane];
            mod[(l * 4 + wave) * NMOD + n] = s; }
        __syncthreads();
    }
    constexpr int I_IN = 16 * (DINP / 32), I_OUT = 16 * 32, I_FFI = 16 * (2 * DFF / 32), I_FFO = (DFF / 64) * 32, I_UQ = 4 * 48, I_UKV = 2 * 64, I_LRU = 16 * 8;
    constexpr int I_L = I_IN + I_OUT + I_FFI + I_FFO + I_UQ + I_UKV + I_LRU;
    for (int it = gw; it < DEPTH * I_L; it += NGW) {
        const int l = it / I_L; int r = it % I_L; unsigned char* wl = a.ws + WS_W + (size_t)l * WL_STRIDE;
        if (r < I_IN) { transpose_item(a.w_in + (size_t)l * DM * 3520, 3520, DM, (bf16*)(wl + WL_IN), 0, nullptr, DINP / 32, r, scr, lane); continue; } r -= I_IN;
        if (r < I_OUT) { transpose_item(a.w_out + (size_t)l * DM * DM, DM, DM, (bf16*)(wl + WL_OUT), 1, nullptr, 32, r, scr, lane); continue; } r -= I_OUT;
        if (r < I_FFI) { transpose_item(a.w_ffi + (size_t)l * DM * 2 * DFF, 2 * DFF, DM, (bf16*)(wl + WL_FFI), 2, nullptr, 2 * DFF / 32, r, scr, lane); continue; } r -= I_FFI;
        if (r < I_FFO) { transpose_item(a.w_ffo + (size_t)l * DFF * DM, DM, DFF, (bf16*)(wl + WL_FFO), 1, nullptr, 32, r, scr, lane); continue; } r -= I_FFO;
        if (r < I_UQ) { transpose_item(a.w_uq + (size_t)l * 256 * 1536, 1536, 256, (bf16*)(wl + WL_UQ), 3, a.qg + l * 256, 48, r, scr, lane); continue; } r -= I_UQ;
        if (r < I_UKV) { transpose_item(a.w_ukv + (size_t)l * 128 * 2048, 2048, 128, (bf16*)(wl + WL_UKV), 4, a.kvg + l * 128, 64, r, scr, lane); continue; } r -= I_UKV;
        { const int mtx = r >> 3, nb = mtx >> 1, which = mtx & 1;
          const float* src = (which ? a.lru_wx : a.lru_wa) + (size_t)l * 8 * 16384 + (size_t)nb * 16384;
          transpose_item(src, 128, 128, (bf16*)(wl + WL_LRU) + (size_t)(nb * 256 + which * 128) * 128, 1, nullptr, 4, r & 7, scr, lane); }
    }
    f32x2* cs = (f32x2*)(a.ws + WS_CS);
    for (int e = gw * 64 + lane; e < T * 32; e += NGW * 64) {
        const int t = e >> 5, i = e & 31;
        const float ang = (float)a.pos[t] * INV_FREQ[i];
        const double q = rint((double)ang * 0.15915494309189535);
        const float rr = (float)((double)ang - q * 6.283185307179586);
        cs[e] = (f32x2){__cosf(rr), __sinf(rr)};
    }
}
__device__ __forceinline__ void phase1(const Args& a) {
    OPAQUE_TID();
    const float* mod = (const float*)(a.ws + WS_MOD);
    float* ss = (float*)(a.ws + WS_SS); bf16* XS = (bf16*)(a.ws + WS_XS);
    for (int row0 = gw; row0 < T; row0 += 4 * NGW) {
        f32x4 v[4][4]; float s[4];
#pragma unroll
        for (int q = 0; q < 4; ++q) { const int row = row0 + q * NGW; const f32x4* xr = (const f32x4*)(a.x + (size_t)row * DM) + lane; s[q] = 0.f;
#pragma unroll
            for (int j = 0; j < 4; ++j) { v[q][j] = xr[64 * j]; } }
#pragma unroll
        for (int q = 0; q < 4; ++q) { const int row = row0 + q * NGW, b = row >> 13; const f32x4* scp = (const f32x4*)(mod + b * NMOD + 1024) + lane;
#pragma unroll
            for (int j = 0; j < 4; ++j) s[q] += sumsq4(v[q][j]);
            s[q] = wave_sum(s[q]);
            u32x2* o = (u32x2*)(XS + (size_t)row * DM) + lane;
#pragma unroll
            for (int j = 0; j < 4; ++j) { const f32x4 y = v[q][j] * (scp[64 * j] + 1.0f); u32x2 w; w.x = cvt_pk_bf16(y[0], y[1]); w.y = cvt_pk_bf16(y[2], y[3]); o[64 * j] = w; }
            if (lane == 0) ss[row] = s[q];
            if (lane >= 1 && lane <= 8) ss[(size_t)lane * T + row] = 0.f; }
    }
    constexpr int NI = DINP + 2 * DFF;
    for (int it = gw; it < DEPTH * NI; it += NGW) {
        const int l = it / NI; int n = it % NI; const bool isf = n >= DINP; if (isf) n -= DINP;
        const bf16* wrow = (const bf16*)(a.ws + WS_W + (size_t)l * WL_STRIDE + (isf ? WL_FFI : WL_IN)) + (size_t)n * DM;
        const float* sh = mod + (size_t)l * 4 * NMOD + (isf ? 3072 : 0);
        float s0 = 0.f, s1 = 0.f, s2 = 0.f, s3 = 0.f;
#pragma unroll
        for (int h = 0; h < 2; ++h) { const int k0 = h * 512 + lane * 8; const bf16x8 wv = *(const bf16x8*)(wrow + k0);
#pragma unroll
            for (int j = 0; j < 8; ++j) { const float w = bf2f((bf16)wv[j]); s0 += w * sh[k0 + j]; s1 += w * sh[NMOD + k0 + j]; s2 += w * sh[2 * NMOD + k0 + j]; s3 += w * sh[3 * NMOD + k0 + j]; } }
        s0 = wave_sum(s0); s1 = wave_sum(s1); s2 = wave_sum(s2); s3 = wave_sum(s3);
        if (lane == 0) { float* o = (float*)(a.ws + (isf ? WS_SHWF : WS_SHWIN)) + (size_t)l * 4 * (isf ? 2 * DFF : DINP) + n; const int st = isf ? 2 * DFF : DINP; o[0] = s0; o[st] = s1; o[2 * st] = s2; o[3 * st] = s3; }
    }
}
__device__ __forceinline__ void lru_phase(const Args& a, int l, char* lds, bool dummy = false) {
    int tid_ = threadIdx.x; asm volatile("" : "+v"(tid_));
    const int tid = tid_, lane = tid & 63, wave = tid >> 6, fq = lane >> 4, fc = lane & 15;
    const bf16* XL = (const bf16*)(a.ws + WS_XL); bf16* SGA = (bf16*)(a.ws + WS_SGA); bf16* WC = (bf16*)(a.ws + WS_XS);
    float* sumP = (float*)(a.ws + WS_SUMP); float* sumH = (float*)(a.ws + WS_SUMH);
    const bf16* Wl = (const bf16*)(a.ws + WS_W + (size_t)l * WL_STRIDE + WL_LRU);
    const float* cw = a.conv_w + (size_t)l * 4 * DM; const float* cb = a.conv_b + (size_t)l * DM;
    constexpr int PITCH = 272, TILE = 128 * PITCH, OFF_SG = TILE, OFF_WC = 2 * TILE, OFF_PF = 3 * TILE;
    const int cgp = tid & 15, rr = tid >> 4;
    f32x4 w[4][2], bb[2]; bf16x8 bwa[4], bwx[4]; float ba = 0.f, bx = 0.f, c8 = 0.f; int nb_cur = -1;
    for (int unit = blockIdx.x; unit < (T / 128) * 8; unit += gridDim.x) {
        const int chunk = unit >> 3, nb = unit & 7, t0 = chunk * 128; const bool first = (t0 & (SEQ - 1)) == 0;
        const int ch = nb * 128 + cgp * 8;
        if (nb != nb_cur) { nb_cur = nb;
#pragma unroll
            for (int j = 0; j < 4; ++j) { w[j][0] = *(const f32x4*)(cw + j * DM + ch); w[j][1] = *(const f32x4*)(cw + j * DM + ch + 4); }
            bb[0] = *(const f32x4*)(cb + ch); bb[1] = *(const f32x4*)(cb + ch + 4);
            const bf16* wr_ = Wl + (size_t)(nb * 256 + 16 * wave + fc) * 128 + fq * 8;
#pragma unroll
            for (int ks = 0; ks < 4; ++ks) { bwa[ks] = *(const bf16x8*)(wr_ + ks * 32); bwx[ks] = *(const bf16x8*)(wr_ + 128 * 128 + ks * 32); }
            const int c_ = nb * 128 + 16 * wave + fc;
            ba = a.lru_ba[l * DM + c_]; bx = a.lru_bx[l * DM + c_]; c8 = -8.0f * log1pf(__expf(-a.lru_a[l * DM + c_])); }
        {
            bf16x8 sgv[4];
#pragma unroll
            for (int p = 0; p < 4; ++p) sgv[p] = *(const bf16x8*)(SGA + (size_t)(t0 + p * 32 + rr) * DM + ch);
            int pf = 0; if (tid < 128) pf = a.pos[t0 + tid];
#pragma unroll
            for (int p = 0; p < 4; ++p) { const int row = p * 32 + rr; f32x4 o0 = bb[0], o1 = bb[1];
#pragma unroll
                for (int j = 0; j < 4; ++j) { const int rj = row - 3 + j;
                    if (!(first && rj < 0)) { const bf16x8 xv = *(const bf16x8*)(XL + (size_t)(t0 + rj) * DM + ch);
#pragma unroll
                        for (int e = 0; e < 4; ++e) { o0[e] += w[j][0][e] * bf2f((bf16)xv[e]); o1[e] += w[j][1][e] * bf2f((bf16)xv[4 + e]); } } }
                u32x4 pk; pk.x = cvt_pk_bf16(o0[0], o0[1]); pk.y = cvt_pk_bf16(o0[2], o0[3]); pk.z = cvt_pk_bf16(o1[0], o1[1]); pk.w = cvt_pk_bf16(o1[2], o1[3]);
                *(u32x4*)(lds + row * PITCH + cgp * 16) = pk; }
#pragma unroll
            for (int p = 0; p < 4; ++p) *(bf16x8*)(lds + OFF_SG + (p * 32 + rr) * PITCH + cgp * 16) = sgv[p];
            if (tid < 128) *(int*)(lds + OFF_PF + tid * 4) = pf;
        }
        __syncthreads();
        f32x4 accA[8], accX[8];
        {
#pragma unroll
            for (int m = 0; m < 8; ++m) { accA[m] = (f32x4){0.f, 0.f, 0.f, 0.f}; accX[m] = (f32x4){0.f, 0.f, 0.f, 0.f};
#pragma unroll
                for (int ks = 0; ks < 4; ++ks) { const bf16x8 av = *(const bf16x8*)(lds + (16 * m + fc) * PITCH + ks * 64 + fq * 16);
                    accA[m] = __builtin_amdgcn_mfma_f32_16x16x32_bf16(av, bwa[ks], accA[m], 0, 0, 0);
                    accX[m] = __builtin_amdgcn_mfma_f32_16x16x32_bf16(av, bwx[ks], accX[m], 0, 0, 0); } }
        }
        const int cl = 16 * wave + fc, c = nb * 128 + cl;
        float Pm = 1.f, Hm = 0.f;
#pragma unroll
        for (int m = 0; m < 8; ++m) {
            float P[4], Hh[4], sg[4];
#pragma unroll
            for (int j = 0; j < 4; ++j) { const int tl = 16 * m + 4 * fq + j;
                const float r = sigmoidf_(accA[m][j] + ba), ig = sigmoidf_(accX[m][j] + bx);
                const float la = c8 * r, x2 = 2.0f * la;
                float av = __expf(la);
                float om = (x2 > -0.1f) ? -(x2 * (1.0f + x2 * (0.5f + x2 * (0.16666667f + x2 * 0.041666668f)))) : 1.0f - __expf(x2);
                float mult = __builtin_amdgcn_sqrtf(om);
                if (*(const int*)(lds + OFF_PF + tl * 4) == 0) { av = 0.f; mult = 1.f; }
                const float xc = bf2f(*(const bf16*)(lds + tl * PITCH + cl * 2));
                const float bv = xc * ig * mult;
                sg[j] = bf2f(*(const bf16*)(lds + OFF_SG + tl * PITCH + cl * 2));
                if (j == 0) { P[0] = av; Hh[0] = bv; } else { P[j] = P[j - 1] * av; Hh[j] = av * Hh[j - 1] + bv; } }
            float Pa = P[3], Ha = Hh[3];
            { const float Pp = __shfl_up(Pa, 16), Hp = __shfl_up(Ha, 16); if (fq >= 1) { Ha = Pa * Hp + Ha; Pa = Pp * Pa; } }
            { const float Pp = __shfl_up(Pa, 32), Hp = __shfl_up(Ha, 32); if (fq >= 2) { Ha = Pa * Hp + Ha; Pa = Pp * Pa; } }
            float Pex = __shfl_up(Pa, 16), Hex = __shfl_up(Ha, 16); if (fq == 0) { Pex = 1.f; Hex = 0.f; }
            const float Pt = __shfl(Pa, 48 + fc), Ht = __shfl(Ha, 48 + fc);
            const float Pin = Pm * Pex, Hin = Pex * Hm + Hex;
#pragma unroll
            for (int j = 0; j < 4; ++j) { const int tl = 16 * m + 4 * fq + j;
                const float cp = P[j] * Pin, hl = Hh[j] + P[j] * Hin;
                const unsigned pk = cvt_pk_bf16(sg[j] * hl, sg[j] * cp);
                *(bf16*)(lds + OFF_SG + tl * PITCH + cl * 2) = (bf16)(pk & 0xffffu); *(bf16*)(lds + OFF_WC + tl * PITCH + cl * 2) = (bf16)(pk >> 16); }
            Hm = Pt * Hm + Ht; Pm = Pm * Pt;
        }
        if (fq == 0) { sumP[(size_t)chunk * DM + c] = Pm; sumH[(size_t)chunk * DM + c] = Hm; }
        __syncthreads();
#pragma unroll
        for (int p = 0; p < 4; ++p) { const int row = p * 32 + rr; const size_t gi = (size_t)(t0 + row) * DM + ch;
            *(bf16x8*)((dummy ? (bf16*)a.out : SGA) + gi) = *(const bf16x8*)(lds + OFF_SG + row * PITCH + cgp * 16);
            *(bf16x8*)((dummy ? (bf16*)a.out + (size_t)T * DM : WC) + gi) = *(const bf16x8*)(lds + OFF_WC + row * PITCH + cgp * 16); }
        __syncthreads();
    }
}
__device__ __forceinline__ void krope_phase(const Args& a) {
    const float* KROPE = (const float*)(a.ws + WS_KROPE); unsigned* KR = (unsigned*)(a.ws + WS_KR); const f32x2* cs = (const f32x2*)(a.ws + WS_CS);
    int tid_ = threadIdx.x; asm volatile("" : "+v"(tid_));
    for (int e = blockIdx.x * 512 + tid_; e < T * 32; e += gridDim.x * 512) {
        const int t = e >> 5, i = e & 31; const float x1 = KROPE[t * 64 + i], x2 = KROPE[t * 64 + 32 + i]; const f32x2 v = cs[e];
        KR[e] = cvt_pk_bf16(x1 * v.x - x2 * v.y, x2 * v.x + x1 * v.y);
    }
}
__device__ __forceinline__ void final_phase(const Args& a) {
    OPAQUE_TID();
    for (int row0 = gw; row0 < T; row0 += 2 * NGW) {
        f32x4 v[2][4];
#pragma unroll
        for (int q = 0; q < 2; ++q) { const f32x4* xr = (const f32x4*)(a.out + (size_t)(row0 + q * NGW) * DM) + lane;
#pragma unroll
            for (int j = 0; j < 4; ++j) v[q][j] = xr[64 * j]; }
#pragma unroll
        for (int q = 0; q < 2; ++q) { float s = 0.f;
#pragma unroll
            for (int j = 0; j < 4; ++j) s += sumsq4(v[q][j]);
            const float rstd = __builtin_amdgcn_rsqf(wave_sum(s) * (1.0f / 1024.0f) + EPS);
            f32x4* xr = (f32x4*)(a.out + (size_t)(row0 + q * NGW) * DM) + lane; const f32x4* g = (const f32x4*)a.fg + lane;
#pragma unroll
            for (int j = 0; j < 4; ++j) xr[64 * j] = v[q][j] * rstd * g[64 * j]; }
    }
}
namespace att {
constexpr int KVBLK = 64, QB = 256;
constexpr int KP = 272, RP = 144;
constexpr int SHM_V = 16384, SHM_K = 64 * KP, SHM_R = 64 * RP;
constexpr int OFF_V = 0, OFF_K = 3 * SHM_V, OFF_R = OFF_K + 2 * SHM_K, OFF_QR = OFF_R + 2 * SHM_R  , OFF_WS = OFF_QR + 32768, OFF_CARRY = OFF_WS + 2048, ATT_LDS = OFF_CARRY + 1024;
static_assert(OFF_WS >= 131072 && ATT_LDS <= LDS_XB, "attention LDS map");
constexpr float SCALE = 0.07216878364870322f;
constexpr float THR = 8.f;
#define SBAR() __builtin_amdgcn_sched_barrier(0)
__device__ __forceinline__ int v_st(int k, int c) { const int kk = (k & ~0xC) | ((k & 4) << 1) | ((k & 8) >> 1); return ((kk >> 3) * 4 + (c >> 5)) * 512 + ((kk & 7) * 32 + (c & 31)) * 2; }
__device__ __forceinline__ int v_rd_base(int lane) { return ((lane & 3) << 3) | (((lane >> 2) & 3) << 6) | (((lane >> 4) & 1) << 5) | (((lane >> 5) & 1) << 8); }
constexpr int v_rd_off(int d0, int ks, int half) { return d0 * 512 + ks * 4096 + half * 2048; }
__device__ __forceinline__ int crow(int r, int hi) { return (r & 3) + 8 * (r >> 2) + 4 * hi; }
__device__ __forceinline__ unsigned cvtpk(float lo, float hi) { return pg8::cvt_pk_bf16(lo, hi); }
__device__ __forceinline__ void mask_tile(f32x16& p0, f32x16& p1, int dq) {
    const float NEG = -__builtin_inff();
#pragma unroll
    for (int r = 0; r < 16; ++r) { const int c = (r & 3) + 8 * (r >> 2);
        if (dq - c < 0) p0[r] = NEG;
        if (dq - c - 32 < 0) p1[r] = NEG; }
}
__device__ __forceinline__ void partialSM(f32x16& p0, f32x16& p1, float& m_reg, float& mn, float& alpha) {
    float pmax = p0[0];
#pragma unroll
    for (int r = 1; r < 16; ++r) pmax = fmaxf(pmax, p0[r]);
#pragma unroll
    for (int r = 0; r < 16; ++r) pmax = fmaxf(pmax, p1[r]);
    { auto rr = __builtin_amdgcn_permlane32_swap(__float_as_uint(pmax), __float_as_uint(pmax), false, false);
      pmax = fmaxf(__uint_as_float(rr[0]), __uint_as_float(rr[1])); }
    constexpr float C2 = 1.4426950408889634f * SCALE;
    if (__builtin_expect(__all((pmax - m_reg) * SCALE <= THR), 1)) { mn = m_reg; alpha = 1.f; }
    else { mn = fmaxf(m_reg, pmax); alpha = __builtin_amdgcn_exp2f((m_reg - mn) * C2); m_reg = mn; }
    const float mnL = -mn * C2;
#pragma unroll
    for (int r = 0; r < 16; ++r) p0[r] = fmaf(p0[r], C2, mnL);
#pragma unroll
    for (int r = 0; r < 16; ++r) p1[r] = fmaf(p1[r], C2, mnL);
#pragma unroll
    for (int r = 0; r < 16; ++r) p0[r] = __builtin_amdgcn_exp2f(p0[r]);
}
__device__ __forceinline__ void finishSM(f32x16& p0, f32x16& p1, float alpha, float& l_reg, bf16x8& pa0, bf16x8& pa1, bf16x8& pa2, bf16x8& pa3) {
#pragma unroll
    for (int r = 0; r < 16; ++r) p1[r] = __builtin_amdgcn_exp2f(p1[r]);
    float ps = 0;
#pragma unroll
    for (int r = 0; r < 16; ++r) ps += p0[r];
#pragma unroll
    for (int r = 0; r < 16; ++r) ps += p1[r];
    { auto rr = __builtin_amdgcn_permlane32_swap(__float_as_uint(ps), __float_as_uint(ps), false, false);
      ps = __uint_as_float(rr[0]) + __uint_as_float(rr[1]); }
    l_reg = l_reg * alpha + ps;
#define PK4(P, B_, OUT) do { unsigned a0 = cvtpk(P[B_+0], P[B_+1]), a1 = cvtpk(P[B_+2], P[B_+3]);                          \
        unsigned b0 = cvtpk(P[B_+4], P[B_+5]), b1 = cvtpk(P[B_+6], P[B_+7]);                                             \
        auto r0 = __builtin_amdgcn_permlane32_swap(a0, b0, false, false); auto r1 = __builtin_amdgcn_permlane32_swap(a1, b1, false, false); \
        u32x4 w = {r0[0], r1[0], r0[1], r1[1]}; OUT = *reinterpret_cast<bf16x8*>(&w); } while (0)
    PK4(p0, 0, pa0); PK4(p0, 8, pa1); PK4(p1, 0, pa2); PK4(p1, 8, pa3);
#undef PK4
}
template <int KB>
__device__ __forceinline__ void qkt(f32x16& p0, f32x16& p1, const char* lds, int r32, int hi, const bf16x8* qn, const char* qrr) {
    p0 = f32x16{}; p1 = f32x16{};
    bf16x8 qr[4];
#pragma unroll
    for (int d0 = 0; d0 < 4; ++d0) qr[d0] = *(const bf16x8*)(qrr + d0 * 1024);
    const char* ka = lds + OFF_K + KB * SHM_K + r32 * KP + hi * 16;
#pragma unroll
    for (int d0 = 0; d0 < 8; ++d0) {
        bf16x8 b0 = *reinterpret_cast<const bf16x8*>(ka + d0 * 32);
        bf16x8 b1 = *reinterpret_cast<const bf16x8*>(ka + d0 * 32 + 32 * KP);
        p0 = __builtin_amdgcn_mfma_f32_32x32x16_bf16(b0, qn[d0], p0, 0, 0, 0);
        p1 = __builtin_amdgcn_mfma_f32_32x32x16_bf16(b1, qn[d0], p1, 0, 0, 0); }
    const char* ra = lds + OFF_R + KB * SHM_R + r32 * RP + hi * 16;
#pragma unroll
    for (int d0 = 0; d0 < 4; ++d0) {
        bf16x8 b0 = *reinterpret_cast<const bf16x8*>(ra + d0 * 32);
        bf16x8 b1 = *reinterpret_cast<const bf16x8*>(ra + d0 * 32 + 32 * RP);
        p0 = __builtin_amdgcn_mfma_f32_32x32x16_bf16(b0, qr[d0], p0, 0, 0, 0);
        p1 = __builtin_amdgcn_mfma_f32_32x32x16_bf16(b1, qr[d0], p1, 0, 0, 0); }
}
template <int KB>
__device__ __forceinline__ void qkt_fin(f32x16& p0, f32x16& p1, f32x16& y0, f32x16& y1, float alpha, float& l_reg, bf16x8& pa0, bf16x8& pa1, bf16x8& pa2, bf16x8& pa3,
                                        const char* lds, int r32, int hi, const bf16x8* qn, const char* qrr) {
    p0 = f32x16{}; p1 = f32x16{};
    const char* ka = lds + OFF_K + KB * SHM_K + r32 * KP + hi * 16;
    const char* ra = lds + OFF_R + KB * SHM_R + r32 * RP + hi * 16;
#define QK_LD(i, X0, X1) do { if ((i) < 8) { X0 = *reinterpret_cast<const bf16x8*>(ka + (i) * 32); X1 = *reinterpret_cast<const bf16x8*>(ka + (i) * 32 + 32 * KP); } \
                              else { X0 = *reinterpret_cast<const bf16x8*>(ra + ((i) - 8) * 32); X1 = *reinterpret_cast<const bf16x8*>(ra + ((i) - 8) * 32 + 32 * RP); \
                                     Q##X0 = *(const bf16x8*)(qrr + ((i) - 8) * 1024); } } while (0)
#define QK_MM(i, X0, X1) do { const bf16x8 q_ = (i) < 8 ? qn[(i) < 8 ? (i) : 0] : Q##X0; \
        p0 = __builtin_amdgcn_mfma_f32_32x32x16_bf16(X0, q_, p0, 0, 0, 0); p1 = __builtin_amdgcn_mfma_f32_32x32x16_bf16(X1, q_, p1, 0, 0, 0); } while (0)
#define QK_PK4(P, B_, OUT) do { unsigned a0_ = cvtpk(P[B_+0], P[B_+1]), a1_ = cvtpk(P[B_+2], P[B_+3]); unsigned b0_ = cvtpk(P[B_+4], P[B_+5]), b1_ = cvtpk(P[B_+6], P[B_+7]); \
        auto r0_ = __builtin_amdgcn_permlane32_swap(a0_, b0_, false, false); auto r1_ = __builtin_amdgcn_permlane32_swap(a1_, b1_, false, false); \
        u32x4 w_ = {r0_[0], r1_[0], r0_[1], r1_[1]}; OUT = *reinterpret_cast<bf16x8*>(&w_); } while (0)
    bf16x8 A0, A1, B0, B1, C0, C1, QA0, QB0, QC0; float ps = 0.f;
    QK_LD(0, A0, A1); QK_LD(1, B0, B1); SBAR();
    QK_LD(2, C0, C1); QK_MM(0, A0, A1);
#pragma unroll
    for (int r = 0; r < 4; ++r) y1[r] = __builtin_amdgcn_exp2f(y1[r]);
    QK_PK4(y0, 0, pa0); SBAR();
    QK_LD(3, A0, A1); QK_MM(1, B0, B1);
#pragma unroll
    for (int r = 4; r < 8; ++r) y1[r] = __builtin_amdgcn_exp2f(y1[r]);
    QK_PK4(y0, 8, pa1); SBAR();
    QK_LD(4, B0, B1); QK_MM(2, C0, C1);
#pragma unroll
    for (int r = 8; r < 12; ++r) y1[r] = __builtin_amdgcn_exp2f(y1[r]);
#pragma unroll
    for (int r = 0; r < 8; ++r) ps += y0[r];
    SBAR();
    QK_LD(5, C0, C1); QK_MM(3, A0, A1);
#pragma unroll
    for (int r = 12; r < 16; ++r) y1[r] = __builtin_amdgcn_exp2f(y1[r]);
#pragma unroll
    for (int r = 8; r < 16; ++r) ps += y0[r];
    SBAR();
    QK_LD(6, A0, A1); QK_MM(4, B0, B1);
    QK_PK4(y1, 0, pa2);
#pragma unroll
    for (int r = 0; r < 8; ++r) ps += y1[r];
    SBAR();
    QK_LD(7, B0, B1); QK_MM(5, C0, C1);
    QK_PK4(y1, 8, pa3);
#pragma unroll
    for (int r = 8; r < 16; ++r) ps += y1[r];
    SBAR();
    QK_LD(8, C0, C1); QK_MM(6, A0, A1);
    { auto rr = __builtin_amdgcn_permlane32_swap(__float_as_uint(ps), __float_as_uint(ps), false, false); ps = __uint_as_float(rr[0]) + __uint_as_float(rr[1]); }
    l_reg = l_reg * alpha + ps;
    SBAR();
    QK_LD(9, A0, A1); QK_MM(7, B0, B1); SBAR();
    QK_LD(10, B0, B1); QK_MM(8, C0, C1); SBAR();
    QK_LD(11, C0, C1); QK_MM(9, A0, A1); SBAR();
    QK_MM(10, B0, B1); SBAR();
    QK_MM(11, C0, C1);
#undef QK_LD
#undef QK_MM
#undef QK_PK4
}
__device__ __forceinline__ void pv_tile(f32x16* o, int vb0, bf16x8 pa0, bf16x8 pa1, bf16x8 pa2, bf16x8 pa3) {
#define TRRD(dst, off) asm volatile("ds_read_b64_tr_b16 %0, %1 offset:%2" : "=&v"(dst) : "v"(vb0), "i"(off) : "memory")
#define PV_D0(d0) do { s16x4 l0, l1, l2, l3, h0, h1, h2, h3; constexpr int b_ = v_rd_off(d0, 0, 0); \
        TRRD(l0, b_); TRRD(h0, b_ + 2048); TRRD(l1, b_ + 4096); TRRD(h1, b_ + 6144); TRRD(l2, b_ + 8192); TRRD(h2, b_ + 10240); TRRD(l3, b_ + 12288); TRRD(h3, b_ + 14336); \
        asm volatile("s_waitcnt lgkmcnt(0)" ::: "memory"); SBAR();   \
        o[d0] = __builtin_amdgcn_mfma_f32_32x32x16_bf16(pa0, (bf16x8){l0[0], l0[1], l0[2], l0[3], h0[0], h0[1], h0[2], h0[3]}, o[d0], 0, 0, 0);   \
        o[d0] = __builtin_amdgcn_mfma_f32_32x32x16_bf16(pa1, (bf16x8){l1[0], l1[1], l1[2], l1[3], h1[0], h1[1], h1[2], h1[3]}, o[d0], 0, 0, 0);   \
        o[d0] = __builtin_amdgcn_mfma_f32_32x32x16_bf16(pa2, (bf16x8){l2[0], l2[1], l2[2], l2[3], h2[0], h2[1], h2[2], h2[3]}, o[d0], 0, 0, 0);   \
        o[d0] = __builtin_amdgcn_mfma_f32_32x32x16_bf16(pa3, (bf16x8){l3[0], l3[1], l3[2], l3[3], h3[0], h3[1], h3[2], h3[3]}, o[d0], 0, 0, 0); } while (0)
    PV_D0(0); PV_D0(1); PV_D0(2); PV_D0(3);
#undef PV_D0
#undef TRRD
}
__device__ __forceinline__ void attn_unit(int rb, int hh, int hl, int qb, unsigned char* wsb, char* lds, bool do_store = true) {
    const bf16* Qn = (const bf16*)(wsb + WS_QN); const bf16* Qr = (const bf16*)(wsb + WS_QR); const bf16* Kn = (const bf16*)(wsb + WS_KN); const bf16* Kr = (const bf16*)(wsb + WS_KR); const bf16* Vv = (const bf16*)(wsb + WS_V);
    int tid_ = threadIdx.x; asm volatile("" : "+v"(tid_));
    const int tid = tid_, wid = __builtin_amdgcn_readfirstlane(tid >> 6), lane = tid & 63, r32 = lane & 31, hi = lane >> 5;
    const int q0 = qb * QB, NT = (q0 + QB) / KVBLK;
    const int qlo = q0 + wid * 32, qm = qlo + r32 - 4 * hi;
    char* V_lds = lds + OFF_V; char* K_lds = lds + OFF_K; char* R_lds = lds + OFF_R;
    float* ws = (float*)(lds + OFF_WS) + wid * 64; float* li_l = ws; float* al_l = ws + 32;
    float* carry = (float*)(lds + OFF_CARRY);
    const int cb = (4 * hh + hl) * 128;
    const bf16* Kh = Kn + (size_t)rb * 512 + hl * 128; const bf16* Vh = Vv + (size_t)rb * 512 + hl * 128; const bf16* Rh = Kr + (size_t)rb * 64;
    const int sr = tid >> 4, sc = (tid & 15) * 8, vst0 = v_st(sr, sc), vst1 = v_st(32 + sr, sc), kws = sr * KP + sc * 2;
    const int rrow = tid >> 3, rc = (tid & 7) * 8, rws = rrow * RP + rc * 2;
    const int vb0 = (int)(uintptr_t)V_lds + v_rd_base(lane);
    bf16x8 st_v0, st_v1, st_k0, st_k1, st_r;
#define VMW() asm volatile("s_waitcnt vmcnt(0)" ::: "memory")
#define SLOAD(k0) do { st_v0 = *(const bf16x8*)(Vh + (size_t)((k0) + sr) * 512 + sc); st_v1 = *(const bf16x8*)(Vh + (size_t)((k0) + 32 + sr) * 512 + sc); \
                       st_k0 = *(const bf16x8*)(Kh + (size_t)((k0) + sr) * 512 + sc); st_k1 = *(const bf16x8*)(Kh + (size_t)((k0) + 32 + sr) * 512 + sc); \
                       st_r = *(const bf16x8*)(Rh + (size_t)((k0) + rrow) * 64 + rc); } while (0)
#define SWRITE(bf, vs) do { *(bf16x8*)(V_lds + (vs) + vst0) = st_v0; *(bf16x8*)(V_lds + (vs) + vst1) = st_v1; \
                        *(bf16x8*)(K_lds + (bf) * SHM_K + kws) = st_k0; *(bf16x8*)(K_lds + (bf) * SHM_K + kws + 32 * KP) = st_k1; \
                        *(bf16x8*)(R_lds + (bf) * SHM_R + rws) = st_r; } while (0)
    SLOAD(0);
    bf16x8 qn[8];
    const char* qrr = lds + OFF_QR + wid * 4096 + lane * 16;
    { const bf16* qg = Qr + (size_t)(rb + q0 + wid * 32 + r32) * 256 + hl * 64 + hi * 8;
#pragma unroll
      for (int d0 = 0; d0 < 4; ++d0) *(bf16x8*)(lds + OFF_QR + wid * 4096 + lane * 16 + d0 * 1024) = *(const bf16x8*)(qg + d0 * 16); }
    { const bf16* qrow = Qn + (size_t)(rb + q0 + wid * 32 + r32) * 512 + hl * 128 + hi * 8;
#pragma unroll
      for (int d0 = 0; d0 < 8; ++d0) qn[d0] = *(const bf16x8*)(qrow + d0 * 16); }
    if (tid < 256) { const int which = tid >> 7, c = tid & 127, kmax = qb * 2 + which; const size_t base = (size_t)(rb >> 7) * 1024 + cb + c;
        const float* sumP = (const float*)(wsb + WS_SUMP); const float* sumH = (const float*)(wsb + WS_SUMH);
        float H = 0.f;
        for (int j = 0; j < kmax; j += 8) { float hv[8], pw[8];
#pragma unroll
            for (int q = 0; q < 8; ++q) { const bool ok = j + q < kmax; hv[q] = ok ? sumH[base + (size_t)(j + q) * 1024] : 0.f; pw[q] = ok ? sumP[base + (size_t)(j + q) * 1024] : 1.f; }
#pragma unroll
            for (int q = 0; q < 8; ++q) H = hv[q] + pw[q] * H; }
        carry[which * 128 + c] = H; }
    VMW(); SWRITE(0, 0); SBAR();
    SLOAD(KVBLK);
    __syncthreads();
    float m_reg = -1e30f, l_reg = 0; f32x16 o[4] = {};
    f32x16 pA0, pA1, pB0, pB1; float mnA, mnB, alA, alB; bf16x8 pa0, pa1, pa2, pa3;
    int sl_prev = 0, sl_cur = 0, sl_next = SHM_V;
#define ROT() do { sl_prev = sl_cur; sl_cur = sl_next; sl_next = (sl_next == 2 * SHM_V) ? 0 : sl_next + SHM_V; } while (0)
#define RESC(a) do { if (__any((a) < 1.f)) { if (hi == 0) al_l[r32] = (a); asm volatile("s_waitcnt lgkmcnt(0)" ::: "memory");              \
                     for (int d_ = 0; d_ < 4; ++d_) for (int r = 0; r < 16; ++r) o[d_][r] *= al_l[crow(r, hi)]; } } while (0)
#define MASKT(P0_, P1_, t) do { const int kb_ = (t) * KVBLK; if (kb_ + KVBLK - 1 > qlo) mask_tile(P0_, P1_, qm - kb_); } while (0)
    SBAR(); qkt<0>(pA0, pA1, lds, r32, hi, qn, qrr);
    MASKT(pA0, pA1, 0); partialSM(pA0, pA1, m_reg, mnA, alA);
    VMW(); SWRITE(1, SHM_V);
    __syncthreads();
    ROT();
#define STEP(PX0, PX1, mnX, alX, PY0, PY1, alY, t, KB, LAST) do {                                                             \
        SBAR(); qkt_fin<KB>(PX0, PX1, PY0, PY1, alY, l_reg, pa0, pa1, pa2, pa3, lds, r32, hi, qn, qrr); SBAR();               \
        if (!(LAST)) { SLOAD(((t) + 1) * KVBLK); SBAR(); }                                                                    \
        pv_tile(o, vb0 + sl_prev, pa0, pa1, pa2, pa3); MASKT(PX0, PX1, (t)); partialSM(PX0, PX1, m_reg, mnX, alX);            \
        if (!(LAST)) { VMW(); SWRITE(1 - (KB), sl_next); }                                                                    \
        RESC(alX);                                                                                                            \
        if (!(LAST)) { __syncthreads(); ROT(); } } while (0)
    for (int t = 1; t + 1 < NT; t += 2) {
        STEP(pB0, pB1, mnB, alB, pA0, pA1, alA, t, 1, false);
        STEP(pA0, pA1, mnA, alA, pB0, pB1, alB, t + 1, 0, false);
    }
    STEP(pB0, pB1, mnB, alB, pA0, pA1, alA, NT - 1, 1, true);
    finishSM(pB0, pB1, alB, l_reg, pa0, pa1, pa2, pa3); SBAR(); pv_tile(o, vb0 + sl_cur, pa0, pa1, pa2, pa3);
    if (hi == 0) li_l[r32] = l_reg; asm volatile("s_waitcnt lgkmcnt(0)" ::: "memory");
    const size_t gbase = (size_t)(rb + q0 + wid * 32 + (lane >> 4)) * DM + cb + (lane & 15) * 8;
    bf16x8 uu[8], ww[8], gg[8];
    { const bf16* U = (const bf16*)(wsb + WS_SGA) + gbase; const bf16* WC = (const bf16*)(wsb + WS_XS) + gbase; const bf16* SGB = (const bf16*)(wsb + WS_SGB) + gbase;
#pragma unroll
      for (int i = 0; i < 8; ++i) { uu[i] = *(const bf16x8*)(U + (size_t)i * 4 * DM); ww[i] = *(const bf16x8*)(WC + (size_t)i * 4 * DM); gg[i] = *(const bf16x8*)(SGB + (size_t)i * 4 * DM); } }
    __syncthreads();
    {
        float* stg = (float*)lds + wid * 4096;
#pragma unroll
        for (int r = 0; r < 16; ++r) { const int orow = crow(r, hi); const float rl = __builtin_amdgcn_rcpf(li_l[orow]);
#pragma unroll
            for (int d0 = 0; d0 < 4; ++d0) stg[orow * 128 + d0 * 32 + r32] = o[d0][r] * rl; }
        asm volatile("s_waitcnt lgkmcnt(0)" ::: "memory");
        const float* cr = carry + (wid >> 2) * 128 + (lane & 15) * 8;
        const f32x4 h0 = *(const f32x4*)cr, h1 = *(const f32x4*)(cr + 4);
        bf16* Y = (bf16*)(wsb + WS_XL) + gbase;
        const float* sp = stg + (lane >> 4) * 128 + (lane & 15) * 8;
#pragma unroll
        for (int i = 0; i < 8; ++i) {
            const bf16x8 u = uu[i], w = ww[i], g = gg[i];
            const f32x4 v0 = *(const f32x4*)(sp + i * 512), v1 = *(const f32x4*)(sp + i * 512 + 4);
            f32x4 y0, y1;
#pragma unroll
            for (int e = 0; e < 4; ++e) { y0[e] = bf2f((bf16)u[e]) + bf2f((bf16)w[e]) * h0[e] + bf2f((bf16)g[e]) * v0[e];
                                          y1[e] = bf2f((bf16)u[4 + e]) + bf2f((bf16)w[4 + e]) * h1[e] + bf2f((bf16)g[4 + e]) * v1[e]; }
            if (do_store) store8bf(Y + (size_t)i * 4 * DM, y0, y1);
        }
    }
    __syncthreads();
#undef RESC
#undef MASKT
#undef STEP
#undef ROT
#undef SLOAD
#undef SWRITE
#undef VMW
}
#undef SBAR
}
__global__ void __launch_bounds__(512, 2) fwd_megakernel(Args a) {
    extern __shared__ __attribute__((aligned(16))) unsigned char lds[];
    cg::grid_group grid = cg::this_grid();
    {
        if (threadIdx.x < 8) ((LAS unsigned*)(lds + LDS_XB))[threadIdx.x] = 0u;
        __syncthreads();
    }
    grid.sync();
    (void)xcd_barrier_post((unsigned*)(a.ws + WS_BAR), (volatile LAS unsigned*)((LAS unsigned char*)lds + LDS_XB));
#define GSYNC() do { XcdBarrier b_; b_.bar = (unsigned*)(a.ws + WS_BAR); b_.x = xb_xcc_id(); b_.st = (volatile LAS unsigned*)((LAS unsigned char*)lds + LDS_XB); xcd_barrier(b_); } while (0)
    const int G = gridDim.x;
    LAS unsigned char* ldsl = (LAS unsigned char*)lds;
    unsigned char* ws = a.ws;
    float* mod = (float*)(ws + WS_MOD); float* ss = (float*)(ws + WS_SS);
    bf16* XS = (bf16*)(ws + WS_XS); bf16* XL = (bf16*)(ws + WS_XL); bf16* SGA = (bf16*)(ws + WS_SGA); bf16* SGB = (bf16*)(ws + WS_SGB); bf16* UU = (bf16*)(ws + WS_UU);
    bf16* QD = (bf16*)(ws + WS_QD); bf16* KVD = (bf16*)(ws + WS_KVD); float* KROPE = (float*)(ws + WS_KROPE); bf16* KR = (bf16*)(ws + WS_KR);
    bf16* QN = (bf16*)(ws + WS_QN); bf16* QR = (bf16*)(ws + WS_QR); bf16* KN = (bf16*)(ws + WS_KN); bf16* VV = (bf16*)(ws + WS_V);

#ifndef PHM
#define PHM 0xFFFF
#endif
    if (PHM & 1) phase0(a, ldsl);
    GSYNC();
    if (PHM & 2) phase1(a);
    GSYNC();
#ifdef PROBE_P01
    phase0(a, ldsl);
    GSYNC();
    phase1(a);
    GSYNC();
#endif
    for (int l = 0; l < DEPTH; ++l) {
        unsigned char* wl = ws + WS_W + (size_t)l * WL_STRIDE;
        float* ssA = ss + (size_t)(4 * l) * T; float* ssB = ssA + T; float* ssQ = ssA + 2 * T; float* ssKV = ssA + 3 * T; float* ssN = ssA + 4 * T;
        const float* modl = mod + (size_t)l * 4 * NMOD;
        if (PHM & 4) {
            pg8::Gemm g{(const bf16*)XS, (const bf16*)(wl + WL_IN), T, DINP, DM}; pg8::StaticOrder S; S.init(T, DINP, G, (int)blockIdx.x);
            EpiIn E{ssA, (const float*)(ws + WS_SHWIN) + (size_t)l * 4 * DINP, XL, QD, KVD, KROPE, SGA, SGB, ssQ, ssKV};
            pg8::gemm_phase<EpiIn, pg8::StaticOrder, true, true>(ldsl, g, S, E);
        }
        GSYNC();
        for (int hh = 0; hh < 2; ++hh) {
#ifdef PROBE_LRU2
            if (hh == 0 && l == 0) { lru_phase(a, l, (char*)lds, true); lru_phase(a, l, (char*)lds, true); }
#endif
            if ((PHM & 8) && hh == 0) { lru_phase(a, l, (char*)lds); krope_phase(a); }
            if (PHM & 16) {
                int Kq = 256; asm volatile("" : "+s"(Kq));
                pg8::Gemm g{(const bf16*)QD, (const bf16*)(wl + WL_UQ) + (size_t)hh * 768 * 256, T, 768, Kq}; pg8::StaticOrder S; S.init(T, 768, G, (int)blockIdx.x);
                EpiQ E{ssQ, (const float*)(ws + WS_CS), QN, QR};
                pg8::gemm_phase<EpiQ, pg8::StaticOrder, true, true>(ldsl, g, S, E);
            }
            if (PHM & 32) {
                int Kk = 128; asm volatile("" : "+s"(Kk));
                pg8::Gemm g{(const bf16*)KVD, (const bf16*)(wl + WL_UKV) + (size_t)hh * 1024 * 128, T, 1024, Kk}; pg8::StaticOrder S; S.init(T, 1024, G, (int)blockIdx.x);
                EpiKV E{ssKV, KN, VV};
                pg8::gemm_phase<EpiKV, pg8::StaticOrder, true, true>(ldsl, g, S, E);
            }
#ifdef PROBE_QKV2
            {
                int Kq = 256; asm volatile("" : "+s"(Kq));
                pg8::Gemm g{(const bf16*)QD, (const bf16*)(wl + WL_UQ) + (size_t)hh * 768 * 256, T, 768, Kq}; pg8::StaticOrder S; S.init(T, 768, G, (int)blockIdx.x);
                EpiQ E{ssQ, (const float*)(ws + WS_CS), QN, QR};
                pg8::gemm_phase<EpiQ, pg8::StaticOrder, true, true>(ldsl, g, S, E);
            }
            {
                int Kk = 128; asm volatile("" : "+s"(Kk));
                pg8::Gemm g{(const bf16*)KVD, (const bf16*)(wl + WL_UKV) + (size_t)hh * 1024 * 128, T, 1024, Kk}; pg8::StaticOrder S; S.init(T, 1024, G, (int)blockIdx.x);
                EpiKV E{ssKV, KN, VV};
                pg8::gemm_phase<EpiKV, pg8::StaticOrder, true, true>(ldsl, g, S, E);
            }
#endif
            GSYNC();
            const int vcu = (G % 8 == 0) ? (int)(blockIdx.x & 7) * (G / 8) + (int)(blockIdx.x >> 3) : (int)blockIdx.x;
            if (PHM & 64) for (int p2 = 2 * vcu; p2 < 512; p2 += ((p2 & 1) ? 2 * G - 1 : 1)) {
                const int p = p2 >> 1, bh = p >> 4, s = p & 15, b = bh >> 2, hl = bh & 3;
                att::attn_unit(b * SEQ, hh, hl, (p2 & 1) ? s : 31 - s, ws, (char*)lds);
            }
#ifdef PROBE_ATT2
#ifndef PROBE_NOSYNC
            GSYNC();
#endif
            if (hh == PROBE_ATT2 - 1) for (int p2 = 2 * blockIdx.x; p2 < 512; p2 += ((p2 & 1) ? 2 * G - 1 : 1)) {
                const int p = p2 >> 1, bh = p >> 4, s = p & 15, b = bh >> 2, hl = bh & 3;
                att::attn_unit(b * SEQ, hh, hl, (p2 & 1) ? s : 31 - s, ws, (char*)lds, PROBE_STORE);
            }
#endif
            GSYNC();
        }
        if (PHM & 128) {
            pg8::Gemm g{(const bf16*)XL, (const bf16*)(wl + WL_OUT), T, DM, DM}; pg8::StaticOrder S; S.init(T, DM, G, (int)blockIdx.x);
            EpiRes E{l == 0 ? a.x : a.out, a.out, modl + 2048, modl + 4096, XS, ssB};
            pg8::gemm_phase<EpiRes, pg8::StaticOrder, true, true>(ldsl, g, S, E);
        }
        GSYNC();
        if (PHM & 256) {
            pg8::Gemm g{(const bf16*)XS, (const bf16*)(wl + WL_FFI), T, 2 * DFF, DM}; pg8::StaticOrder S; S.init(T, 2 * DFF, G, (int)blockIdx.x);
            EpiFfi E{ssB, (const float*)(ws + WS_SHWF) + (size_t)l * 4 * 2 * DFF, UU};
            pg8::gemm_phase<EpiFfi, pg8::StaticOrder, true, true>(ldsl, g, S, E);
#ifdef PROBE_FFI2
            GSYNC();
            pg8::gemm_phase<EpiFfi, pg8::StaticOrder, true, true>(ldsl, g, S, E);
#endif
        }
        GSYNC();
        if (PHM & 512) {
            pg8::Gemm g{(const bf16*)UU, (const bf16*)(wl + WL_FFO), T, DM, DFF}; pg8::StaticOrder S; S.init(T, DM, G, (int)blockIdx.x);
            EpiRes E{a.out, a.out, modl + 5120, (l + 1 < DEPTH) ? modl + 4 * NMOD + 1024 : nullptr, XS, ssN};
            pg8::gemm_phase<EpiRes, pg8::StaticOrder, true, true>(ldsl, g, S, E);
        }
        GSYNC();
    }
    if (PHM & 1024) final_phase(a);
}

extern "C" void kernel_launch(void* const* d_in, const int* in_sizes, int n_in, void* d_out, int out_size, void* d_ws, size_t ws_size, hipStream_t stream) {
    static int grid = 0;
    if (grid == 0) {
        int dev = 0, cus = 0, per_cu = 0;
        if (hipGetDevice(&dev) != hipSuccess || hipDeviceGetAttribute(&cus, hipDeviceAttributeMultiprocessorCount, dev) != hipSuccess) { grid = -1; return; }
        if (hipFuncSetAttribute((const void*)fwd_megakernel, hipFuncAttributeMaxDynamicSharedMemorySize, LDS_BYTES) != hipSuccess) { fprintf(stderr, "hipFuncSetAttribute failed\n"); grid = -1; return; }
        if (hipOccupancyMaxActiveBlocksPerMultiprocessor(&per_cu, (const void*)fwd_megakernel, 512, LDS_BYTES) != hipSuccess || per_cu < 1) per_cu = 1;
        (void)hipGetLastError();
        grid = cus;
        if (ws_size < WS_END) { fprintf(stderr, "workspace too small: %zu < %zu\n", ws_size, (size_t)WS_END); grid = -1; return; }
    }
    if (grid < 0) return;
    Args a{};
    a.x = (const float*)d_in[0]; a.c = (const float*)d_in[1]; a.pos = (const int*)d_in[2]; a.w_ada = (const float*)d_in[3]; a.b_ada = (const float*)d_in[4];
    a.w_in = (const float*)d_in[5]; a.conv_w = (const float*)d_in[6]; a.conv_b = (const float*)d_in[7]; a.lru_wa = (const float*)d_in[8]; a.lru_ba = (const float*)d_in[9];
    a.lru_wx = (const float*)d_in[10]; a.lru_bx = (const float*)d_in[11]; a.lru_a = (const float*)d_in[12]; a.qg = (const float*)d_in[13]; a.kvg = (const float*)d_in[14];
    a.w_uq = (const float*)d_in[15]; a.w_ukv = (const float*)d_in[16]; a.w_out = (const float*)d_in[17]; a.w_ffi = (const float*)d_in[18]; a.w_ffo = (const float*)d_in[19];
    a.fg = (const float*)d_in[20]; a.out = (float*)d_out; a.ws = (unsigned char*)d_ws;
    if (hipMemsetAsync((char*)d_ws + WS_BAR, 0, 16384, stream) != hipSuccess) { fprintf(stderr, "memset failed\n"); return; }
    void* args[] = {&a};
    hipError_t e = hipLaunchCooperativeKernel((const void*)fwd_megakernel, dim3(grid), dim3(512), args, LDS_BYTES, stream);
    if (e != hipSuccess) fprintf(stderr, "cooperative launch failed: %s (grid %d)\n", hipGetErrorString(e), grid);
}
```

```cpp
#include <hip/hip_runtime.h>
#include <hip/hip_cooperative_groups.h>
#include <hip/hip_bf16.h>
#include <cstdio>
#include <cstdint>
namespace cg = cooperative_groups;
namespace pg8 {
#define PG8_LAS __attribute__((address_space(3)))
typedef unsigned short bf16_t;
typedef short bf16x8 __attribute__((ext_vector_type(8)));
typedef float f32x4 __attribute__((ext_vector_type(4)));
typedef unsigned u32x4 __attribute__((ext_vector_type(4)));
constexpr int BM = 256, BK = 64, HALF = 128, HTB = HALF * BK * 2  , STAGE_BYTES = 8 * HTB, NXCD = 8, WGM = 8;

__host__ __device__ __forceinline__ int lds_byte(int r, int c) { const int st = (r >> 4) * 2 + (c >> 5), rr = r & 15, cc = c & 31, ob = rr * 64 + cc * 2; return st * 1024 + (ob ^ (((ob >> 9) & 1) << 5)); }
__host__ __device__ __forceinline__ void stage_rc(int b, int& R, int& C) { const int st = b / 1024, sb = b % 1024, swz = sb ^ (((sb >> 9) & 1) << 5); R = (st >> 1) * 16 + swz / 64; C = (st & 1) * 32 + (swz % 64) / 2; }
__host__ __device__ __forceinline__ int perm32(int rho) { const int n = rho >> 4, i = rho & 15; return 8 * (i >> 2) + 4 * n + (i & 3); }

struct Unit { int pm, pn; };
struct Gemm { const bf16_t* A; const bf16_t* Bt; int M, N, K; };

struct StaticOrder {
    int nM, nN, nwg, G, c;
    __host__ __device__ void init(int M, int N, int G_, int c_) { nM = M / BM; nN = N / BM; nwg = nM * nN; G = G_; c = c_; }
    __host__ __device__ bool next(int i, Unit& u) const {
        const long L = (long)i * G + c; if (L >= nwg) return false;
        int wgid = (int)L; { const int q = nwg / NXCD, r = nwg % NXCD, xcd = wgid % NXCD, off = wgid / NXCD; wgid = (xcd < r ? xcd * (q + 1) : r * (q + 1) + (xcd - r) * q) + off; }
        const int nig = WGM * nN, gid = wgid / nig, fm = gid * WGM, gsz = (nM - fm) < WGM ? (nM - fm) : WGM;
        u.pm = fm + ((wgid % nig) % gsz); u.pn = (wgid % nig) / gsz; return true;
    }
    __device__ __forceinline__ void a_ready(const Unit&) const {}
    __device__ __forceinline__ void done(const Unit&) const {}
};

typedef float cvt_f32x2_t __attribute__((ext_vector_type(2))); typedef __bf16 cvt_bf16x2_t __attribute__((ext_vector_type(2)));
__device__ __forceinline__ unsigned cvt_pk_bf16(float lo, float hi) { cvt_f32x2_t v = {lo, hi}; cvt_bf16x2_t b = __builtin_convertvector(v, cvt_bf16x2_t); return __builtin_bit_cast(unsigned, b); }
typedef float f32x2 __attribute__((ext_vector_type(2)));
template <class Epi, class Sched, bool ALIGN_EPI = false, bool SP2 = false>
__device__ __forceinline__ void gemm_phase(PG8_LAS unsigned char* lds, const Gemm g, const Sched& S, const Epi& E) {
    int tid_ = threadIdx.x; asm volatile("" : "+v"(tid_));
    const int tid = tid_, wid = __builtin_amdgcn_readfirstlane(tid >> 6), lane = tid & 63, wr = wid >> 2, wc = wid & 3, fr = lane & 15, fq = lane >> 4;
    const int K = g.K, nt = K / BK;
    unsigned voffA[2], voffB[2];
#pragma unroll
    for (int i = 0; i < 2; ++i) { int R, C; stage_rc(tid * 16 + i * 8192, R, C); const int Rb = Epi::PERM ? ((R & ~31) + perm32(R & 31)) : R;
        voffA[i] = (unsigned)(R * K + C) * 2u; voffB[i] = (unsigned)(Rb * K + C) * 2u; }
    const size_t kstep = (size_t)(BK * 2);
    const size_t hstep = (size_t)HALF * K * 2;
    const size_t tstep = 2 * hstep;
    const unsigned ldsw = (unsigned)wid * 1024u;
    const int aoff = lds_byte(wr * 64 + fr, fq * 8), boff = lds_byte(wc * 32 + fr, fq * 8);
#define PG8_SA(b, h) (((b) * 2 + (h)) * HTB)
#define PG8_SB(b, h) ((4 + (b) * 2 + (h)) * HTB)
#define PG8_STAGE(bufoff, gbase, voff) do { _Pragma("unroll") for (int _i = 0; _i < 2; ++_i) \
        __builtin_amdgcn_global_load_lds((const unsigned*)((const char*)(gbase) + (voff)[_i]), (PG8_LAS unsigned*)(lds + (bufoff) + ldsw + _i * 8192), 16, 0, 0); } while (0)
#define PG8_LDA(dst, b, h) do { _Pragma("unroll") for (int m = 0; m < 4; ++m) _Pragma("unroll") for (int k = 0; k < 2; ++k) dst[m][k] = *(const PG8_LAS bf16x8*)(lds + PG8_SA(b, h) + aoff + m * 2048 + k * 1024); } while (0)
#define PG8_LDB(dst, b, h) do { _Pragma("unroll") for (int n = 0; n < 2; ++n) _Pragma("unroll") for (int k = 0; k < 2; ++k) dst[n][k] = *(const PG8_LAS bf16x8*)(lds + PG8_SB(b, h) + boff + n * 2048 + k * 1024); } while (0)
#define PG8_MMA(ai, bj, At, Bt) do { __builtin_amdgcn_s_setprio(1); _Pragma("unroll") for (int m = 0; m < 4; ++m) _Pragma("unroll") for (int n = 0; n < 2; ++n) _Pragma("unroll") for (int k = 0; k < 2; ++k) \
        acc[ai][bj][m][n] = __builtin_amdgcn_mfma_f32_16x16x32_bf16(Bt[n][k], At[m][k], acc[ai][bj][m][n], 0, 0, 0); __builtin_amdgcn_s_setprio(0); } while (0)
#define PG8_WAIT_V(n) asm volatile("s_waitcnt vmcnt(" #n ")" ::: "memory")
#define PG8_WAIT_L(n) asm volatile("s_waitcnt lgkmcnt(" #n ")" ::: "memory")
#define PG8_BAR __builtin_amdgcn_s_barrier()
#define PG8_SCHED __builtin_amdgcn_sched_barrier(0)
    Unit cur, nxt; int ui = 0;
    if (!S.next(0, cur)) return;
    f32x4 acc[2][2][4][2];
#pragma unroll
    for (int a = 0; a < 2; ++a)
#pragma unroll
        for (int b = 0; b < 2; ++b)
#pragma unroll
            for (int m = 0; m < 4; ++m)
#pragma unroll
                for (int n = 0; n < 2; ++n) acc[a][b][m][n] = (f32x4){0.f, 0.f, 0.f, 0.f};
    bf16x8 At[4][2], B0[2][2], B1[2][2];
    const char* cA = (const char*)g.A + (size_t)cur.pm * tstep; const char* cB = (const char*)g.Bt + (size_t)cur.pn * tstep;
    S.a_ready(cur);
    if constexpr (SP2) {
        PG8_STAGE(PG8_SB(0, 0), cB, voffB); PG8_STAGE(PG8_SB(0, 1), cB + hstep, voffB); PG8_STAGE(PG8_SA(0, 0), cA, voffA); PG8_STAGE(PG8_SA(0, 1), cA + hstep, voffA);
        if (wr == 1) PG8_BAR;
        PG8_WAIT_V(2); PG8_BAR;
        PG8_STAGE(PG8_SB(1, 0), cB + kstep, voffB); PG8_STAGE(PG8_SA(1, 0), cA + kstep, voffA); PG8_STAGE(PG8_SB(1, 1), cB + hstep + kstep, voffB);
        PG8_WAIT_V(6); PG8_BAR;
    } else {
        PG8_STAGE(PG8_SB(0, 0), cB, voffB); PG8_STAGE(PG8_SA(0, 0), cA, voffA); PG8_STAGE(PG8_SB(0, 1), cB + hstep, voffB); PG8_STAGE(PG8_SA(0, 1), cA + hstep, voffA);
        if (wr == 1) PG8_BAR;
        PG8_WAIT_V(4); PG8_BAR;
        PG8_STAGE(PG8_SB(1, 0), cB + kstep, voffB); PG8_STAGE(PG8_SA(1, 0), cA + kstep, voffA); PG8_STAGE(PG8_SB(1, 1), cB + hstep + kstep, voffB);
        PG8_WAIT_V(6); PG8_BAR;
    }
    for (;;) {
        const bool has_next = S.next(ui + 1, nxt);
        const char* nA = has_next ? (const char*)g.A + (size_t)nxt.pm * tstep : cA; const char* nB = has_next ? (const char*)g.Bt + (size_t)nxt.pn * tstep : cB;
        for (int t = 0; t < nt; t += 2) {
            const bool last = (t == nt - 2);
            const char* a1 = cA + (size_t)(t + 1) * kstep;
            const char* a2 = last ? nA : cA + (size_t)(t + 2) * kstep; const char* b2 = last ? nB : cB + (size_t)(t + 2) * kstep;
            const char* a3 = a2 + kstep; const char* b3 = b2 + kstep;
            if (last && has_next) S.a_ready(nxt);
            if constexpr (SP2) {
            PG8_LDB(B0, 0, 0); PG8_LDB(B1, 0, 1); PG8_SCHED; PG8_LDA(At, 0, 0); PG8_STAGE(PG8_SA(1, 1), a1 + hstep, voffA);
            PG8_WAIT_V(8); PG8_WAIT_L(0); PG8_BAR; PG8_MMA(0, 0, At, B0); PG8_MMA(0, 1, At, B1); PG8_BAR; PG8_SCHED;
            PG8_LDA(At, 0, 1); PG8_STAGE(PG8_SB(0, 0), b2, voffB); PG8_STAGE(PG8_SB(0, 1), b2 + hstep, voffB); PG8_STAGE(PG8_SA(0, 0), a2, voffA);
            PG8_WAIT_V(8); PG8_WAIT_L(0); PG8_BAR; PG8_MMA(1, 0, At, B0); PG8_MMA(1, 1, At, B1); PG8_BAR; PG8_SCHED;
            PG8_LDB(B0, 1, 0); PG8_LDB(B1, 1, 1); PG8_SCHED; PG8_LDA(At, 1, 0); PG8_STAGE(PG8_SA(0, 1), a2 + hstep, voffA);
            PG8_WAIT_V(8); PG8_WAIT_L(0); PG8_BAR; PG8_MMA(0, 0, At, B0); PG8_MMA(0, 1, At, B1); PG8_BAR; PG8_SCHED;
            PG8_LDA(At, 1, 1); PG8_STAGE(PG8_SB(1, 0), b3, voffB); PG8_STAGE(PG8_SB(1, 1), b3 + hstep, voffB); PG8_STAGE(PG8_SA(1, 0), a3, voffA);
            PG8_WAIT_V(8); PG8_WAIT_L(0); PG8_BAR; PG8_MMA(1, 0, At, B0); PG8_MMA(1, 1, At, B1); PG8_BAR; PG8_SCHED;
            } else {
            PG8_LDB(B0, 0, 0); PG8_SCHED; PG8_LDA(At, 0, 0); PG8_STAGE(PG8_SA(1, 1), a1 + hstep, voffA);
            PG8_WAIT_L(8); PG8_BAR; PG8_WAIT_L(0); PG8_MMA(0, 0, At, B0); PG8_BAR; PG8_SCHED;
            PG8_LDB(B1, 0, 1); PG8_STAGE(PG8_SB(0, 0), b2, voffB);
            PG8_BAR; PG8_WAIT_L(0); PG8_MMA(0, 1, At, B1); PG8_BAR;
            PG8_LDA(At, 0, 1); PG8_STAGE(PG8_SA(0, 0), a2, voffA);
            PG8_BAR; PG8_WAIT_L(0); PG8_MMA(1, 0, At, B0); PG8_BAR; PG8_SCHED;
            PG8_STAGE(PG8_SB(0, 1), b2 + hstep, voffB);
            PG8_WAIT_V(6); PG8_BAR; PG8_MMA(1, 1, At, B1); PG8_BAR;
            PG8_LDB(B0, 1, 0); PG8_SCHED; PG8_LDA(At, 1, 0); PG8_STAGE(PG8_SA(0, 1), a2 + hstep, voffA);
            PG8_WAIT_L(8); PG8_BAR; PG8_WAIT_L(0); PG8_MMA(0, 0, At, B0); PG8_BAR; PG8_SCHED;
            PG8_LDB(B1, 1, 1); PG8_STAGE(PG8_SB(1, 0), b3, voffB);
            PG8_BAR; PG8_WAIT_L(0); PG8_MMA(0, 1, At, B1); PG8_BAR;
            PG8_LDA(At, 1, 1); PG8_STAGE(PG8_SA(1, 0), a3, voffA);
            PG8_BAR; PG8_WAIT_L(0); PG8_MMA(1, 0, At, B0); PG8_BAR; PG8_SCHED;
            PG8_STAGE(PG8_SB(1, 1), b3 + hstep, voffB);
            PG8_WAIT_V(6); PG8_BAR; PG8_MMA(1, 1, At, B1); PG8_BAR;
            }
        }
        if constexpr (ALIGN_EPI) { if (wr == 0) PG8_BAR; }
        if constexpr (!Epi::AFTER_DRAIN) { E(acc, cur, wr, wc, fr, fq); S.done(cur); }
        if (!has_next) break;
#pragma unroll
        for (int a = 0; a < 2; ++a)
#pragma unroll
            for (int b = 0; b < 2; ++b)
#pragma unroll
                for (int m = 0; m < 4; ++m)
#pragma unroll
                    for (int n = 0; n < 2; ++n) acc[a][b][m][n] = (f32x4){0.f, 0.f, 0.f, 0.f};
        cur = nxt; cA = nA; cB = nB; ++ui;
        if constexpr (ALIGN_EPI) { if (wr == 1) PG8_BAR; }
    }
    PG8_WAIT_V(0);
    if constexpr (!ALIGN_EPI) { if (wr == 0) PG8_BAR; }
    PG8_BAR;
    if constexpr (Epi::AFTER_DRAIN) { E.fused(acc, cur, wr, wc, fr, fq, lds, wid, lane); S.done(cur); }
#undef PG8_SA
#undef PG8_SB
#undef PG8_STAGE
#undef PG8_LDA
#undef PG8_LDB
#undef PG8_MMA
#undef PG8_WAIT_V
#undef PG8_WAIT_L
#undef PG8_BAR
#undef PG8_SCHED
}
}
#define LAS __attribute__((address_space(3)))
typedef unsigned short bf16;
typedef float f32x4 __attribute__((ext_vector_type(4)));
typedef float f32x2 __attribute__((ext_vector_type(2)));
typedef float f32x16 __attribute__((ext_vector_type(16)));
typedef unsigned u32x4 __attribute__((ext_vector_type(4)));
typedef unsigned u32x2 __attribute__((ext_vector_type(2)));
typedef short bf16x8 __attribute__((ext_vector_type(8)));
typedef short s16x4 __attribute__((ext_vector_type(4)));
using pg8::Unit; using pg8::cvt_pk_bf16;

constexpr int NB = 4, SEQ = 8192, T = NB * SEQ, DM = 1024, DEPTH = 2, DINP = 3584, DFF = 2816, NMOD = 6144;
constexpr float EPS = 1e-6f;
constexpr size_t MiB = 1u << 20;
constexpr size_t WS_MOD = 0, WS_SHWIN = 256 * 1024, WS_SHWF = 512 * 1024, WS_SS = 1 * MiB, WS_SUMP = 3 * MiB, WS_SUMH = 4 * MiB, WS_CS = 8 * MiB, WS_W = 16 * MiB;
constexpr size_t WL_STRIDE = 28 * MiB, WL_IN = 0, WL_OUT = 7 * MiB, WL_FFI = 9 * MiB, WL_FFO = 20 * MiB, WL_UQ = 25 * MiB + 512 * 1024, WL_UKV = 26 * MiB + 256 * 1024, WL_LRU = 26 * MiB + 768 * 1024;
constexpr size_t WS_XS = 72 * MiB, WS_XL = 136 * MiB, WS_SGA = 200 * MiB, WS_SGB = 264 * MiB, WS_UU = 136 * MiB, WS_QD = 328 * MiB, WS_KVD = 344 * MiB, WS_KROPE = 352 * MiB,
                 WS_KR = 360 * MiB, WS_QN = 364 * MiB, WS_QR = 396 * MiB, WS_KN = 412 * MiB, WS_V = 444 * MiB, WS_END = 476 * MiB;
constexpr size_t WS_BAR = 5 * MiB;
constexpr int LDS_BYTES = 147456, LDS_XB = 144384;

__device__ const float INV_FREQ[32] = {1.0f, 0.7498942613601685f, 0.5623413324356079f, 0.4216965138912201f, 0.3162277638912201f, 0.23713737726211548f, 0.17782793939113617f, 0.133352130651474f, 0.10000000149011612f, 0.07498941570520401f, 0.05623413249850273f, 0.04216965287923813f, 0.03162277489900589f, 0.023713737726211548f, 0.017782794311642647f, 0.01333521492779255f, 0.009999999776482582f, 0.007498941849917173f, 0.005623413249850273f, 0.0042169648222625256f, 0.003162277629598975f, 0.00237137358635664f, 0.0017782794311642647f, 0.0013335214462131262f, 0.0010000000474974513f, 0.0007498942431993783f, 0.000562341301701963f, 0.0004216965171508491f, 0.0003162277571391314f, 0.00023713737027719617f, 0.00017782794020604342f, 0.0001333521504420787f};

struct Args {
    const float* x; const float* c; const int* pos; const float* w_ada; const float* b_ada; const float* w_in; const float* conv_w; const float* conv_b;
    const float* lru_wa; const float* lru_ba; const float* lru_wx; const float* lru_bx; const float* lru_a; const float* qg; const float* kvg;
    const float* w_uq; const float* w_ukv; const float* w_out; const float* w_ffi; const float* w_ffo; const float* fg;
    float* out; unsigned char* ws;
};

__device__ __forceinline__ float bf2f(bf16 u) { return __uint_as_float(((unsigned)u) << 16); }
__device__ __forceinline__ unsigned f2bf(float f) { unsigned u = __float_as_uint(f); return (u + 0x7fffu + ((u >> 16) & 1u)) >> 16; }
__device__ __forceinline__ float sigmoidf_(float x) { return __builtin_amdgcn_rcpf(1.0f + __builtin_amdgcn_exp2f(-1.4426950408889634f * x)); }
__device__ __forceinline__ void store8bf(bf16* p, f32x4 a, f32x4 b) { u32x4 w; w.x = cvt_pk_bf16(a[0], a[1]); w.y = cvt_pk_bf16(a[2], a[3]); w.z = cvt_pk_bf16(b[0], b[1]); w.w = cvt_pk_bf16(b[2], b[3]); *(u32x4*)p = w; }
__device__ __forceinline__ float sumsq4(f32x4 v) { return (v[0] * v[0] + v[1] * v[1]) + (v[2] * v[2] + v[3] * v[3]); }
__device__ __forceinline__ void atomic_addf(float* p, float v) { (void)__hip_atomic_fetch_add(p, v, __ATOMIC_RELAXED, __HIP_MEMORY_SCOPE_AGENT); }
__device__ __forceinline__ float wave_sum(float v) {
#pragma unroll
    for (int o = 1; o < 64; o <<= 1) v += __shfl_xor(v, o);
    return v;
}
#define LDS_WAIT() asm volatile("s_waitcnt lgkmcnt(0)" ::: "memory")

struct EpiIn {
    static constexpr bool PERM = true, AFTER_DRAIN = false;
    const float* ss; const float* shw; bf16* XL; bf16* QD; bf16* KVD; float* KROPE; bf16* SGA; bf16* SGB; float* ssq; float* sskv;
    __device__ __forceinline__ void operator()(const f32x4 (&acc)[2][2][4][2], const Unit& u, int wr, int wc, int fr, int fq) const {
        const int row0 = u.pm * 256 + wr * 64 + fr, b = u.pm >> 5, pn = u.pn, c8 = wc * 32 + 8 * fq;
        f32x4 sv[2][2];
#pragma unroll
        for (int bj = 0; bj < 2; ++bj)
#pragma unroll
            for (int n = 0; n < 2; ++n) sv[bj][n] = *(const f32x4*)(shw + b * DINP + pn * 256 + bj * 128 + c8 + 4 * n);
        float ssv[2][4];
#pragma unroll
        for (int ai = 0; ai < 2; ++ai)
#pragma unroll
            for (int m = 0; m < 4; ++m) ssv[ai][m] = ss[row0 + ai * 128 + m * 16];
#pragma unroll
        for (int ai = 0; ai < 2; ++ai)
#pragma unroll
            for (int m = 0; m < 4; ++m) {
                const size_t row = (size_t)(row0 + ai * 128 + m * 16);
                const float rstd = __builtin_amdgcn_rsqf(ssv[ai][m] * (1.0f / 1024.0f) + EPS);
                f32x4 v[2][2];
#pragma unroll
                for (int bj = 0; bj < 2; ++bj)
#pragma unroll
                    for (int n = 0; n < 2; ++n) v[bj][n] = acc[ai][bj][m][n] * rstd + sv[bj][n];
                if (pn < 4) {
#pragma unroll
                    for (int bj = 0; bj < 2; ++bj) store8bf(XL + row * 1024 + pn * 256 + bj * 128 + c8, v[bj][0], v[bj][1]);
                } else if (pn == 4) {
#pragma unroll
                    for (int bj = 0; bj < 2; ++bj) store8bf(QD + row * 256 + bj * 128 + c8, v[bj][0], v[bj][1]);
                    float s = (sumsq4(v[0][0]) + sumsq4(v[0][1])) + (sumsq4(v[1][0]) + sumsq4(v[1][1]));
                    s += __shfl_xor(s, 16); s += __shfl_xor(s, 32);
                    if (fq == 0) atomic_addf(ssq + row, s);
                } else if (pn == 5) {
                    store8bf(KVD + row * 128 + c8, v[0][0], v[0][1]);
                    float s = sumsq4(v[0][0]) + sumsq4(v[0][1]);
                    s += __shfl_xor(s, 16); s += __shfl_xor(s, 32);
                    if (fq == 0) atomic_addf(sskv + row, s);
                    if (wc < 2) { *(f32x4*)(KROPE + row * 64 + c8) = v[1][0]; *(f32x4*)(KROPE + row * 64 + c8 + 4) = v[1][1]; }
                } else {
                    bf16* G = (pn < 10) ? SGA + (pn - 6) * 256 : SGB + (pn - 10) * 256;
#pragma unroll
                    for (int bj = 0; bj < 2; ++bj) {
                        f32x4 a, c;
#pragma unroll
                        for (int j = 0; j < 4; ++j) { a[j] = sigmoidf_(v[bj][0][j]); c[j] = sigmoidf_(v[bj][1][j]); }
                        store8bf(G + row * 1024 + bj * 128 + c8, a, c);
                    }
                }
            }
    }
};
struct EpiQ {
    static constexpr bool PERM = true, AFTER_DRAIN = false;
    const float* ssq; const float* cs; bf16* QN; bf16* QR;
    __device__ __forceinline__ void operator()(const f32x4 (&acc)[2][2][4][2], const Unit& u, int wr, int wc, int fr, int fq) const {
        const int row0 = u.pm * 256 + wr * 64 + fr, pn = u.pn, c8 = wc * 32 + 8 * fq;
        float ssv[2][4];
#pragma unroll
        for (int ai = 0; ai < 2; ++ai)
#pragma unroll
            for (int m = 0; m < 4; ++m) ssv[ai][m] = ssq[row0 + ai * 128 + m * 16];
#pragma unroll
        for (int ai = 0; ai < 2; ++ai)
#pragma unroll
            for (int m = 0; m < 4; ++m) {
                const size_t row = (size_t)(row0 + ai * 128 + m * 16);
                const float rstd = __builtin_amdgcn_rsqf(ssv[ai][m] * (1.0f / 256.0f) + EPS);
                if (pn < 2) {
#pragma unroll
                    for (int bj = 0; bj < 2; ++bj) store8bf(QN + row * 512 + pn * 256 + bj * 128 + c8, acc[ai][bj][m][0] * rstd, acc[ai][bj][m][1] * rstd);
                } else {
                    const int i0 = (wc & 1) * 16 + 4 * fq;
                    const f32x4 cs0 = *(const f32x4*)(cs + row * 64 + 2 * i0), cs1 = *(const f32x4*)(cs + row * 64 + 2 * i0 + 4);
#pragma unroll
                    for (int bj = 0; bj < 2; ++bj) {
                        const f32x4 a = acc[ai][bj][m][0] * rstd, c = acc[ai][bj][m][1] * rstd; f32x4 oa, oc;
                        oa[0] = a[0] * cs0[0] - a[1] * cs0[1]; oa[1] = a[1] * cs0[0] + a[0] * cs0[1];
                        oa[2] = a[2] * cs0[2] - a[3] * cs0[3]; oa[3] = a[3] * cs0[2] + a[2] * cs0[3];
                        oc[0] = c[0] * cs1[0] - c[1] * cs1[1]; oc[1] = c[1] * cs1[0] + c[0] * cs1[1];
                        oc[2] = c[2] * cs1[2] - c[3] * cs1[3]; oc[3] = c[3] * cs1[2] + c[2] * cs1[3];
                        store8bf(QR + row * 256 + bj * 128 + c8, oa, oc);
                    }
                }
            }
    }
};
struct EpiKV {
    static constexpr bool PERM = true, AFTER_DRAIN = false;
    const float* sskv; bf16* KN; bf16* V;
    __device__ __forceinline__ void operator()(const f32x4 (&acc)[2][2][4][2], const Unit& u, int wr, int wc, int fr, int fq) const {
        const int row0 = u.pm * 256 + wr * 64 + fr, pn = u.pn, c8 = wc * 32 + 8 * fq;
        bf16* O = (pn < 2) ? KN + pn * 256 : V + (pn - 2) * 256;
        float ssv[2][4];
#pragma unroll
        for (int ai = 0; ai < 2; ++ai)
#pragma unroll
            for (int m = 0; m < 4; ++m) ssv[ai][m] = sskv[row0 + ai * 128 + m * 16];
#pragma unroll
        for (int ai = 0; ai < 2; ++ai)
#pragma unroll
            for (int m = 0; m < 4; ++m) {
                const size_t row = (size_t)(row0 + ai * 128 + m * 16);
                const float rstd = __builtin_amdgcn_rsqf(ssv[ai][m] * (1.0f / 128.0f) + EPS);
#pragma unroll
                for (int bj = 0; bj < 2; ++bj) store8bf(O + row * 512 + bj * 128 + c8, acc[ai][bj][m][0] * rstd, acc[ai][bj][m][1] * rstd);
            }
    }
};
struct EpiRes {
    static constexpr bool PERM = false, AFTER_DRAIN = false;
    const float* xres; float* xout; const float* g; const float* sc; bf16* XS; float* ssn;
    __device__ __forceinline__ void operator()(const f32x4 (&acc)[2][2][4][2], const Unit& u, int wr, int wc, int fr, int fq) const {
        const int row0 = u.pm * 256 + wr * 64 + fr, b = u.pm >> 5, col0 = u.pn * 256 + wc * 32 + 4 * fq;
        f32x4 gv[2][2], scv[2][2];
#pragma unroll
        for (int bj = 0; bj < 2; ++bj)
#pragma unroll
            for (int n = 0; n < 2; ++n) { gv[bj][n] = *(const f32x4*)(g + b * NMOD + col0 + bj * 128 + n * 16);
                scv[bj][n] = sc ? *(const f32x4*)(sc + b * NMOD + col0 + bj * 128 + n * 16) + 1.0f : (f32x4){1.f, 1.f, 1.f, 1.f}; }
#pragma unroll
        for (int ai = 0; ai < 2; ++ai)
#pragma unroll
        for (int mp = 0; mp < 2; ++mp) {
            f32x4 pre[2][2][2];
#pragma unroll
            for (int mm = 0; mm < 2; ++mm)
#pragma unroll
                for (int bj = 0; bj < 2; ++bj)
#pragma unroll
                    for (int n = 0; n < 2; ++n) pre[mm][bj][n] = *(const f32x4*)(xres + (size_t)(row0 + ai * 128 + (2 * mp + mm) * 16) * 1024 + col0 + bj * 128 + n * 16);
#pragma unroll
            for (int mm = 0; mm < 2; ++mm) { const int m = 2 * mp + mm;
                const size_t row = (size_t)(row0 + ai * 128 + m * 16); float s = 0.f;
#pragma unroll
                for (int bj = 0; bj < 2; ++bj)
#pragma unroll
                    for (int n = 0; n < 2; ++n) { const size_t off = row * 1024 + col0 + bj * 128 + n * 16;
                        const f32x4 xv = pre[mm][bj][n] + gv[bj][n] * acc[ai][bj][m][n];
                        *(f32x4*)(xout + off) = xv; s += sumsq4(xv);
                        if (sc) { const f32x4 y = xv * scv[bj][n]; u32x2 w; w.x = cvt_pk_bf16(y[0], y[1]); w.y = cvt_pk_bf16(y[2], y[3]); *(u32x2*)(XS + off) = w; } }
                s += __shfl_xor(s, 16); s += __shfl_xor(s, 32);
                if (fq == 0) atomic_addf(ssn + row, s);
            }
        }
    }
};
struct EpiFfi {
    static constexpr bool PERM = true, AFTER_DRAIN = false;
    const float* ss; const float* shw; bf16* UU;
    __device__ __forceinline__ void operator()(const f32x4 (&acc)[2][2][4][2], const Unit& u, int wr, int wc, int fr, int fq) const {
        const int row0 = u.pm * 256 + wr * 64 + fr, b = u.pm >> 5, pn = u.pn, c8 = wc * 32 + 8 * fq;
        f32x4 sv[2][2];
#pragma unroll
        for (int bj = 0; bj < 2; ++bj)
#pragma unroll
            for (int n = 0; n < 2; ++n) sv[bj][n] = *(const f32x4*)(shw + b * (2 * DFF) + pn * 256 + bj * 128 + c8 + 4 * n);
        float ssv[2][4];
#pragma unroll
        for (int ai = 0; ai < 2; ++ai)
#pragma unroll
            for (int m = 0; m < 4; ++m) ssv[ai][m] = ss[row0 + ai * 128 + m * 16];
#pragma unroll
        for (int ai = 0; ai < 2; ++ai)
#pragma unroll
            for (int m = 0; m < 4; ++m) {
                const size_t row = (size_t)(row0 + ai * 128 + m * 16);
                const float rstd = __builtin_amdgcn_rsqf(ssv[ai][m] * (1.0f / 1024.0f) + EPS);
                f32x4 h[2];
#pragma unroll
                for (int n = 0; n < 2; ++n) { const f32x4 gt = acc[ai][0][m][n] * rstd + sv[0][n], up = acc[ai][1][m][n] * rstd + sv[1][n];
#pragma unroll
                    for (int j = 0; j < 4; ++j) h[n][j] = gt[j] * sigmoidf_(gt[j]) * up[j]; }
                store8bf(UU + row * DFF + pn * 128 + c8, h[0], h[1]);
            }
    }
};
#define XB_TMO      128
#define XB_XCNT(j)  (256  + 64 * (j))
#define XB_XSUB(j)  (1280 + 64 * (j))
#define XB_XGEN(j)  (2304 + 64 * (j))
#define XB_TOP      3328
#define XB_TOPGEN   3392
#define XCD_BAR_WORDS 3456
#define XB_SPIN_CAP (1u << 18)

__device__ __forceinline__ unsigned xb_ld(unsigned* p)              { return __hip_atomic_load(p, __ATOMIC_RELAXED, __HIP_MEMORY_SCOPE_AGENT); }
__device__ __forceinline__ unsigned xb_add(unsigned* p, unsigned v) { return __hip_atomic_fetch_add(p, v, __ATOMIC_RELAXED, __HIP_MEMORY_SCOPE_AGENT); }
__device__ __forceinline__ unsigned xb_xcc_id() { return (unsigned)__builtin_amdgcn_s_getreg((3 << 11) | 20) & 0xFu; }
#define XB_SPIN(cond, bar) do { unsigned _sp = 0; while (cond) { __builtin_amdgcn_s_sleep(1); \
    if ((++_sp & 255u) == 0u) { if (xb_ld(&(bar)[XB_TMO])) break; if (_sp > XB_SPIN_CAP) { atomicAdd(&(bar)[XB_TMO], 1u); break; } } } } while (0)

struct XcdBarrier {
    unsigned* bar; unsigned x;
    volatile LAS unsigned* st;
};

__device__ __forceinline__ XcdBarrier xcd_barrier_post(unsigned* bar, volatile LAS unsigned* st) {
    XcdBarrier b; b.bar = bar; b.x = xb_xcc_id(); b.st = st;
    if (threadIdx.x == 0) (void)xb_add(&bar[XB_XCNT(b.x)], 1u);
    return b;
}
__device__ __forceinline__ void xcd_barrier_complete(unsigned* bar, unsigned x, unsigned& nloc, unsigned& nx) {
    const unsigned G = gridDim.x * gridDim.y * gridDim.z;
    unsigned sum, cnt, mine, sp = 0u;
    for (;;) {
        sum = 0u; cnt = 0u; mine = 0u;
#pragma unroll
        for (unsigned j = 0; j < 16; ++j) { const unsigned c = xb_ld(&bar[XB_XCNT(j)]); sum += c; cnt += (c > 0u) ? 1u : 0u; mine = (j == x) ? c : mine; }
        if (sum == G) break;
        __builtin_amdgcn_s_sleep(1);
        if ((++sp & 255u) == 0u) { if (xb_ld(&bar[XB_TMO])) break; if (sp > XB_SPIN_CAP) { atomicAdd(&bar[XB_TMO], 1u); break; } }
    }
    nloc = mine > 0u ? mine : 1u; nx = cnt > 0u ? cnt : 1u;
}

__device__ __forceinline__ void xcd_barrier(const XcdBarrier& b) {
    asm volatile("s_waitcnt vmcnt(0)" ::: "memory");
    __syncthreads();
    if (threadIdx.x == 0) {
        unsigned* bar = b.bar;
        __builtin_amdgcn_s_waitcnt(0);
        unsigned nloc = b.st[0], nx = b.st[1];
        if (nloc == 0u) { xcd_barrier_complete(bar, b.x, nloc, nx); b.st[0] = nloc; b.st[1] = nx; }
        const unsigned old = xb_add(&bar[XB_XSUB(b.x)], 1u);
        const unsigned gen = old / nloc;
        if (old + 1u == (gen + 1u) * nloc) {
            __builtin_amdgcn_fence(__ATOMIC_RELEASE, "agent");
            asm volatile("s_waitcnt vmcnt(0)" ::: "memory");
            const unsigned og = xb_add(&bar[XB_TOP], 1u);
            const unsigned tg = og / nx;
            if (og + 1u == (tg + 1u) * nx) xb_add(&bar[XB_TOPGEN], 1u);
            else XB_SPIN(xb_ld(&bar[XB_TOPGEN]) == tg, bar);
            __builtin_amdgcn_fence(__ATOMIC_ACQUIRE, "agent");
            xb_add(&bar[XB_XGEN(b.x)], 1u);
            asm volatile("s_waitcnt vmcnt(0)" ::: "memory");
        } else {
            XB_SPIN(xb_ld(&bar[XB_XGEN(b.x)]) == gen, bar);
            __builtin_amdgcn_fence(__ATOMIC_ACQUIRE, "agent");
            asm volatile("s_waitcnt vmcnt(0)" ::: "memory");
        }
    }
    __syncthreads();
}
__device__ __forceinline__ int map_col(int id, int n) {
    switch (id) {
        case 0: return n < 1472 ? n : (n < 1536 ? -1 : n - 64);
        case 2: { const int pn = n >> 8, w = n & 255; return w < 128 ? pn * 128 + w : DFF + pn * 128 + (w - 128); }
        case 3: { const int hh = n / 768; int r = n % 768;
                  if (r < 512) return (4 * hh + (r >> 7)) * 192 + (r & 127);
                  r -= 512; const int e = r & 63; return (4 * hh + (r >> 6)) * 192 + 128 + (e >> 1) + 32 * (e & 1); }
        case 4: { const int hh = n >> 10; int r = n & 1023;
                  if (r < 512) return (4 * hh + (r >> 7)) * 256 + (r & 127);
                  r -= 512; return (4 * hh + (r >> 7)) * 256 + 128 + (r & 127); }
        default: return n;
    }
}
__device__ __forceinline__ void transpose_item(const float* W, int ldw, int K, bf16* WT, int id, const float* kscale, int nblk, int item, LAS float* scr, int lane) {
    const int kb = item / nblk, nb = item % nblk, k0 = 64 * kb, n0 = 32 * nb;
    const int sc = map_col(id, n0 + (lane & 31));
#pragma unroll 16
    for (int i = 0; i < 32; ++i) { const int kk = 2 * i + (lane >> 5); float v = sc >= 0 ? W[(size_t)(k0 + kk) * ldw + sc] : 0.f; if (kscale) v *= kscale[k0 + kk]; scr[kk * 33 + (lane & 31)] = v; }
    LDS_WAIT(); asm volatile("" ::: "memory");
    const int c = lane & 7;
#pragma unroll
    for (int j = 0; j < 4; ++j) { const int n = (lane >> 3) + 8 * j; const LAS float* s = scr + (8 * c) * 33 + n;
        u32x4 o; o.x = cvt_pk_bf16(s[0 * 33], s[1 * 33]); o.y = cvt_pk_bf16(s[2 * 33], s[3 * 33]); o.z = cvt_pk_bf16(s[4 * 33], s[5 * 33]); o.w = cvt_pk_bf16(s[6 * 33], s[7 * 33]);
        *(u32x4*)(WT + (size_t)(n0 + n) * K + k0 + 8 * c) = o; }
    LDS_WAIT(); asm volatile("" ::: "memory");
}
#define OPAQUE_TID() int tid_ = threadIdx.x; asm volatile("" : "+v"(tid_)); const int lane = tid_ & 63, wave = __builtin_amdgcn_readfirstlane(tid_ >> 6), NGW = gridDim.x * 8, gw = blockIdx.x * 8 + wave; (void)lane; (void)wave; (void)NGW; (void)gw
__device__ __forceinline__ void phase0(const Args& a, LAS unsigned char* lds) {
    OPAQUE_TID();
    LAS float* scr = (LAS float*)(lds + wave * 16384);
    float* mod = (float*)(a.ws + WS_MOD);
    for (int it = blockIdx.x; it < DEPTH * (NMOD / 64); it += gridDim.x) {
        const int l = it / (NMOD / 64), n = (it % (NMOD / 64)) * 64 + lane;
        float a0 = 0.f, a1 = 0.f, a2 = 0.f, a3 = 0.f;
        const float* w = a.w_ada + (size_t)l * DM * NMOD + (size_t)(wave * 128) * NMOD + n; const float* cc = a.c + wave * 128;
#pragma unroll 16
        for (int k = 0; k < 128; ++k) { const float wv = w[(size_t)k * NMOD]; a0 += cc[k] * wv; a1 += cc[DM + k] * wv; a2 += cc[2 * DM + k] * wv; a3 += cc[3 * DM + k] * wv; }
        LAS float* red = (LAS float*)(lds + 73728);
        red[(wave * 4 + 0) * 64 + lane] = a0; red[(wave * 4 + 1) * 64 + lane] = a1; red[(wave * 4 + 2) * 64 + lane] = a2; red[(wave * 4 + 3) * 64 + lane] = a3;
        __syncthreads();
        if (wave < 4) { float s = a.b_ada[l * NMOD + n];
#pragma unroll
            for (int q = 0; q < 8; ++q) s += red[(q * 4 + wave) * 64 + lane];
            mod[(l * 4 + wave) * NMOD + n] = s; }
        __syncthreads();
    }
    constexpr int I_IN = 16 * (DINP / 32), I_OUT = 16 * 32, I_FFI = 16 * (2 * DFF / 32), I_FFO = (DFF / 64) * 32, I_UQ = 4 * 48, I_UKV = 2 * 64, I_LRU = 16 * 8;
    constexpr int I_L = I_IN + I_OUT + I_FFI + I_FFO + I_UQ + I_UKV + I_LRU;
    for (int it = gw; it < DEPTH * I_L; it += NGW) {
        const int l = it / I_L; int r = it % I_L; unsigned char* wl = a.ws + WS_W + (size_t)l * WL_STRIDE;
        if (r < I_IN) { transpose_item(a.w_in + (size_t)l * DM * 3520, 3520, DM, (bf16*)(wl + WL_IN), 0, nullptr, DINP / 32, r, scr, lane); continue; } r -= I_IN;
        if (r < I_OUT) { transpose_item(a.w_out + (size_t)l * DM * DM, DM, DM, (bf16*)(wl + WL_OUT), 1, nullptr, 32, r, scr, lane); continue; } r -= I_OUT;
        if (r < I_FFI) { transpose_item(a.w_ffi + (size_t)l * DM * 2 * DFF, 2 * DFF, DM, (bf16*)(wl + WL_FFI), 2, nullptr, 2 * DFF / 32, r, scr, lane); continue; } r -= I_FFI;
        if (r < I_FFO) { transpose_item(a.w_ffo + (size_t)l * DFF * DM, DM, DFF, (bf16*)(wl + WL_FFO), 1, nullptr, 32, r, scr, lane); continue; } r -= I_FFO;
        if (r < I_UQ) { transpose_item(a.w_uq + (size_t)l * 256 * 1536, 1536, 256, (bf16*)(wl + WL_UQ), 3, a.qg + l * 256, 48, r, scr, lane); continue; } r -= I_UQ;
        if (r < I_UKV) { transpose_item(a.w_ukv + (size_t)l * 128 * 2048, 2048, 128, (bf16*)(wl + WL_UKV), 4, a.kvg + l * 128, 64, r, scr, lane); continue; } r -= I_UKV;
        { const int mtx = r >> 3, nb = mtx >> 1, which = mtx & 1;
          const float* src = (which ? a.lru_wx : a.lru_wa) + (size_t)l * 8 * 16384 + (size_t)nb * 16384;
          transpose_item(src, 128, 128, (bf16*)(wl + WL_LRU) + (size_t)(nb * 256 + which * 128) * 128, 1, nullptr, 4, r & 7, scr, lane); }
    }
    f32x2* cs = (f32x2*)(a.ws + WS_CS);
    for (int e = gw * 64 + lane; e < T * 32; e += NGW * 64) {
        const int t = e >> 5, i = e & 31;
        const float ang = (float)a.pos[t] * INV_FREQ[i];
        const double q = rint((double)ang * 0.15915494309189535);
        const float rr = (float)((double)ang - q * 6.283185307179586);
        cs[e] = (f32x2){__cosf(rr), __sinf(rr)};
    }
}
__device__ __forceinline__ void phase1(const Args& a) {
    OPAQUE_TID();
    const float* mod = (const float*)(a.ws + WS_MOD);
    float* ss = (float*)(a.ws + WS_SS); bf16* XS = (bf16*)(a.ws + WS_XS);
    for (int row0 = gw; row0 < T; row0 += 4 * NGW) {
        f32x4 v[4][4]; float s[4];
#pragma unroll
        for (int q = 0; q < 4; ++q) { const int row = row0 + q * NGW; const f32x4* xr = (const f32x4*)(a.x + (size_t)row * DM) + lane; s[q] = 0.f;
#pragma unroll
            for (int j = 0; j < 4; ++j) { v[q][j] = xr[64 * j]; } }
#pragma unroll
        for (int q = 0; q < 4; ++q) { const int row = row0 + q * NGW, b = row >> 13; const f32x4* scp = (const f32x4*)(mod + b * NMOD + 1024) + lane;
#pragma unroll
            for (int j = 0; j < 4; ++j) s[q] += sumsq4(v[q][j]);
            s[q] = wave_sum(s[q]);
            u32x2* o = (u32x2*)(XS + (size_t)row * DM) + lane;
#pragma unroll
            for (int j = 0; j < 4; ++j) { const f32x4 y = v[q][j] * (scp[64 * j] + 1.0f); u32x2 w; w.x = cvt_pk_bf16(y[0], y[1]); w.y = cvt_pk_bf16(y[2], y[3]); o[64 * j] = w; }
            if (lane == 0) ss[row] = s[q];
            if (lane >= 1 && lane <= 8) ss[(size_t)lane * T + row] = 0.f; }
    }
    constexpr int NI = DINP + 2 * DFF;
    for (int it = gw; it < DEPTH * NI; it += NGW) {
        const int l = it / NI; int n = it % NI; const bool isf = n >= DINP; if (isf) n -= DINP;
        const bf16* wrow = (const bf16*)(a.ws + WS_W + (size_t)l * WL_STRIDE + (isf ? WL_FFI : WL_IN)) + (size_t)n * DM;
        const float* sh = mod + (size_t)l * 4 * NMOD + (isf ? 3072 : 0);
        float s0 = 0.f, s1 = 0.f, s2 = 0.f, s3 = 0.f;
#pragma unroll
        for (int h = 0; h < 2; ++h) { const int k0 = h * 512 + lane * 8; const bf16x8 wv = *(const bf16x8*)(wrow + k0);
#pragma unroll
            for (int j = 0; j < 8; ++j) { const float w = bf2f((bf16)wv[j]); s0 += w * sh[k0 + j]; s1 += w * sh[NMOD + k0 + j]; s2 += w * sh[2 * NMOD + k0 + j]; s3 += w * sh[3 * NMOD + k0 + j]; } }
        s0 = wave_sum(s0); s1 = wave_sum(s1); s2 = wave_sum(s2); s3 = wave_sum(s3);
        if (lane == 0) { float* o = (float*)(a.ws + (isf ? WS_SHWF : WS_SHWIN)) + (size_t)l * 4 * (isf ? 2 * DFF : DINP) + n; const int st = isf ? 2 * DFF : DINP; o[0] = s0; o[st] = s1; o[2 * st] = s2; o[3 * st] = s3; }
    }
}
__device__ __forceinline__ void lru_phase(const Args& a, int l, char* lds, bool dummy = false) {
    int tid_ = threadIdx.x; asm volatile("" : "+v"(tid_));
    const int tid = tid_, lane = tid & 63, wave = tid >> 6, fq = lane >> 4, fc = lane & 15;
    const bf16* XL = (const bf16*)(a.ws + WS_XL); bf16* SGA = (bf16*)(a.ws + WS_SGA); bf16* WC = (bf16*)(a.ws + WS_XS);
    float* sumP = (float*)(a.ws + WS_SUMP); float* sumH = (float*)(a.ws + WS_SUMH);
    const bf16* Wl = (const bf16*)(a.ws + WS_W + (size_t)l * WL_STRIDE + WL_LRU);
    const float* cw = a.conv_w + (size_t)l * 4 * DM; const float* cb = a.conv_b + (size_t)l * DM;
    constexpr int PITCH = 272, TILE = 128 * PITCH, OFF_SG = TILE, OFF_WC = 2 * TILE, OFF_PF = 3 * TILE;
    const int cgp = tid & 15, rr = tid >> 4;
    f32x4 w[4][2], bb[2]; bf16x8 bwa[4], bwx[4]; float ba = 0.f, bx = 0.f, c8 = 0.f; int nb_cur = -1;
    for (int unit = blockIdx.x; unit < (T / 128) * 8; unit += gridDim.x) {
        const int chunk = unit >> 3, nb = unit & 7, t0 = chunk * 128; const bool first = (t0 & (SEQ - 1)) == 0;
        const int ch = nb * 128 + cgp * 8;
        if (nb != nb_cur) { nb_cur = nb;
#pragma unroll
            for (int j = 0; j < 4; ++j) { w[j][0] = *(const f32x4*)(cw + j * DM + ch); w[j][1] = *(const f32x4*)(cw + j * DM + ch + 4); }
            bb[0] = *(const f32x4*)(cb + ch); bb[1] = *(const f32x4*)(cb + ch + 4);
            const bf16* wr_ = Wl + (size_t)(nb * 256 + 16 * wave + fc) * 128 + fq * 8;
#pragma unroll
            for (int ks = 0; ks < 4; ++ks) { bwa[ks] = *(const bf16x8*)(wr_ + ks * 32); bwx[ks] = *(const bf16x8*)(wr_ + 128 * 128 + ks * 32); }
            const int c_ = nb * 128 + 16 * wave + fc;
            ba = a.lru_ba[l * DM + c_]; bx = a.lru_bx[l * DM + c_]; c8 = -8.0f * log1pf(__expf(-a.lru_a[l * DM + c_])); }
        {
            bf16x8 sgv[4];
#pragma unroll
            for (int p = 0; p < 4; ++p) sgv[p] = *(const bf16x8*)(SGA + (size_t)(t0 + p * 32 + rr) * DM + ch);
            int pf = 0; if (tid < 128) pf = a.pos[t0 + tid];
#pragma unroll
            for (int p = 0; p < 4; ++p) { const int row = p * 32 + rr; f32x4 o0 = bb[0], o1 = bb[1];
#pragma unroll
                for (int j = 0; j < 4; ++j) { const int rj = row - 3 + j;
                    if (!(first && rj < 0)) { const bf16x8 xv = *(const bf16x8*)(XL + (size_t)(t0 + rj) * DM + ch);
#pragma unroll
                        for (int e = 0; e < 4; ++e) { o0[e] += w[j][0][e] * bf2f((bf16)xv[e]); o1[e] += w[j][1][e] * bf2f((bf16)xv[4 + e]); } } }
                u32x4 pk; pk.x = cvt_pk_bf16(o0[0], o0[1]); pk.y = cvt_pk_bf16(o0[2], o0[3]); pk.z = cvt_pk_bf16(o1[0], o1[1]); pk.w = cvt_pk_bf16(o1[2], o1[3]);
                *(u32x4*)(lds + row * PITCH + cgp * 16) = pk; }
#pragma unroll
            for (int p = 0; p < 4; ++p) *(bf16x8*)(lds + OFF_SG + (p * 32 + rr) * PITCH + cgp * 16) = sgv[p];
            if (tid < 128) *(int*)(lds + OFF_PF + tid * 4) = pf;
        }
        __syncthreads();
        f32x4 accA[8], accX[8];
        {
#pragma unroll
            for (int m = 0; m < 8; ++m) { accA[m] = (f32x4){0.f, 0.f, 0.f, 0.f}; accX[m] = (f32x4){0.f, 0.f, 0.f, 0.f};
#pragma unroll
                for (int ks = 0; ks < 4; ++ks) { const bf16x8 av = *(const bf16x8*)(lds + (16 * m + fc) * PITCH + ks * 64 + fq * 16);
                    accA[m] = __builtin_amdgcn_mfma_f32_16x16x32_bf16(av, bwa[ks], accA[m], 0, 0, 0);
                    accX[m] = __builtin_amdgcn_mfma_f32_16x16x32_bf16(av, bwx[ks], accX[m], 0, 0, 0); } }
        }
        const int cl = 16 * wave + fc, c = nb * 128 + cl;
        float Pm = 1.f, Hm = 0.f;
#pragma unroll
        for (int m = 0; m < 8; ++m) {
            float P[4], Hh[4], sg[4];
#pragma unroll
            for (int j = 0; j < 4; ++j) { const int tl = 16 * m + 4 * fq + j;
                const float r = sigmoidf_(accA[m][j] + ba), ig = sigmoidf_(accX[m][j] + bx);
                const float la = c8 * r, x2 = 2.0f * la;
                float av = __expf(la);
                float om = (x2 > -0.1f) ? -(x2 * (1.0f + x2 * (0.5f + x2 * (0.16666667f + x2 * 0.041666668f)))) : 1.0f - __expf(x2);
                float mult = __builtin_amdgcn_sqrtf(om);
                if (*(const int*)(lds + OFF_PF + tl * 4) == 0) { av = 0.f; mult = 1.f; }
                const float xc = bf2f(*(const bf16*)(lds + tl * PITCH + cl * 2));
                const float bv = xc * ig * mult;
                sg[j] = bf2f(*(const bf16*)(lds + OFF_SG + tl * PITCH + cl * 2));
                if (j == 0) { P[0] = av; Hh[0] = bv; } else { P[j] = P[j - 1] * av; Hh[j] = av * Hh[j - 1] + bv; } }
            float Pa = P[3], Ha = Hh[3];
            { const float Pp = __shfl_up(Pa, 16), Hp = __shfl_up(Ha, 16); if (fq >= 1) { Ha = Pa * Hp + Ha; Pa = Pp * Pa; } }
            { const float Pp = __shfl_up(Pa, 32), Hp = __shfl_up(Ha, 32); if (fq >= 2) { Ha = Pa * Hp + Ha; Pa = Pp * Pa; } }
            float Pex = __shfl_up(Pa, 16), Hex = __shfl_up(Ha, 16); if (fq == 0) { Pex = 1.f; Hex = 0.f; }
            const float Pt = __shfl(Pa, 48 + fc), Ht = __shfl(Ha, 48 + fc);
            const float Pin = Pm * Pex, Hin = Pex * Hm + Hex;
#pragma unroll
            for (int j = 0; j < 4; ++j) { const int tl = 16 * m + 4 * fq + j;
                const float cp = P[j] * Pin, hl = Hh[j] + P[j] * Hin;
                const unsigned pk = cvt_pk_bf16(sg[j] * hl, sg[j] * cp);
                *(bf16*)(lds + OFF_SG + tl * PITCH + cl * 2) = (bf16)(pk & 0xffffu); *(bf16*)(lds + OFF_WC + tl * PITCH + cl * 2) = (bf16)(pk >> 16); }
            Hm = Pt * Hm + Ht; Pm = Pm * Pt;
        }
        if (fq == 0) { sumP[(size_t)chunk * DM + c] = Pm; sumH[(size_t)chunk * DM + c] = Hm; }
        __syncthreads();
#pragma unroll
        for (int p = 0; p < 4; ++p) { const int row = p * 32 + rr; const size_t gi = (size_t)(t0 + row) * DM + ch;
            *(bf16x8*)((dummy ? (bf16*)a.out : SGA) + gi) = *(const bf16x8*)(lds + OFF_SG + row * PITCH + cgp * 16);
            *(bf16x8*)((dummy ? (bf16*)a.out + (size_t)T * DM : WC) + gi) = *(const bf16x8*)(lds + OFF_WC + row * PITCH + cgp * 16); }
        __syncthreads();
    }
}
__device__ __forceinline__ void krope_phase(const Args& a) {
    const float* KROPE = (const float*)(a.ws + WS_KROPE); unsigned* KR = (unsigned*)(a.ws + WS_KR); const f32x2* cs = (const f32x2*)(a.ws + WS_CS);
    int tid_ = threadIdx.x; asm volatile("" : "+v"(tid_));
    for (int e = blockIdx.x * 512 + tid_; e < T * 32; e += gridDim.x * 512) {
        const int t = e >> 5, i = e & 31; const float x1 = KROPE[t * 64 + i], x2 = KROPE[t * 64 + 32 + i]; const f32x2 v = cs[e];
        KR[e] = cvt_pk_bf16(x1 * v.x - x2 * v.y, x2 * v.x + x1 * v.y);
    }
}
__device__ __forceinline__ void final_phase(const Args& a) {
    OPAQUE_TID();
    for (int row0 = gw; row0 < T; row0 += 2 * NGW) {
        f32x4 v[2][4];
#pragma unroll
        for (int q = 0; q < 2; ++q) { const f32x4* xr = (const f32x4*)(a.out + (size_t)(row0 + q * NGW) * DM) + lane;
#pragma unroll
            for (int j = 0; j < 4; ++j) v[q][j] = xr[64 * j]; }
#pragma unroll
        for (int q = 0; q < 2; ++q) { float s = 0.f;
#pragma unroll
            for (int j = 0; j < 4; ++j) s += sumsq4(v[q][j]);
            const float rstd = __builtin_amdgcn_rsqf(wave_sum(s) * (1.0f / 1024.0f) + EPS);
            f32x4* xr = (f32x4*)(a.out + (size_t)(row0 + q * NGW) * DM) + lane; const f32x4* g = (const f32x4*)a.fg + lane;
#pragma unroll
            for (int j = 0; j < 4; ++j) xr[64 * j] = v[q][j] * rstd * g[64 * j]; }
    }
}
namespace att {
constexpr int KVBLK = 64, QB = 256;
constexpr int KP = 272, RP = 144;
constexpr int SHM_V = 16384, SHM_K = 64 * KP, SHM_R = 64 * RP;
constexpr int OFF_V = 0, OFF_K = 3 * SHM_V, OFF_R = OFF_K + 2 * SHM_K, OFF_QR = OFF_R + 2 * SHM_R  , OFF_WS = OFF_QR + 32768, OFF_CARRY = OFF_WS + 2048, ATT_LDS = OFF_CARRY + 1024;
static_assert(OFF_WS >= 131072 && ATT_LDS <= LDS_XB, "attention LDS map");
constexpr float SCALE = 0.07216878364870322f;
constexpr float THR = 8.f;
#define SBAR() __builtin_amdgcn_sched_barrier(0)
__device__ __forceinline__ int v_st(int k, int c) { const int kk = (k & ~0xC) | ((k & 4) << 1) | ((k & 8) >> 1); return ((kk >> 3) * 4 + (c >> 5)) * 512 + ((kk & 7) * 32 + (c & 31)) * 2; }
__device__ __forceinline__ int v_rd_base(int lane) { return ((lane & 3) << 3) | (((lane >> 2) & 3) << 6) | (((lane >> 4) & 1) << 5) | (((lane >> 5) & 1) << 8); }
constexpr int v_rd_off(int d0, int ks, int half) { return d0 * 512 + ks * 4096 + half * 2048; }
__device__ __forceinline__ int crow(int r, int hi) { return (r & 3) + 8 * (r >> 2) + 4 * hi; }
__device__ __forceinline__ unsigned cvtpk(float lo, float hi) { return pg8::cvt_pk_bf16(lo, hi); }
__device__ __forceinline__ void mask_tile(f32x16& p0, f32x16& p1, int dq) {
    const float NEG = -__builtin_inff();
#pragma unroll
    for (int r = 0; r < 16; ++r) { const int c = (r & 3) + 8 * (r >> 2);
        if (dq - c < 0) p0[r] = NEG;
        if (dq - c - 32 < 0) p1[r] = NEG; }
}
__device__ __forceinline__ void partialSM(f32x16& p0, f32x16& p1, float& m_reg, float& mn, float& alpha) {
    float pmax = p0[0];
#pragma unroll
    for (int r = 1; r < 16; ++r) pmax = fmaxf(pmax, p0[r]);
#pragma unroll
    for (int r = 0; r < 16; ++r) pmax = fmaxf(pmax, p1[r]);
    { auto rr = __builtin_amdgcn_permlane32_swap(__float_as_uint(pmax), __float_as_uint(pmax), false, false);
      pmax = fmaxf(__uint_as_float(rr[0]), __uint_as_float(rr[1])); }
    constexpr float C2 = 1.4426950408889634f * SCALE;
    if (__builtin_expect(__all((pmax - m_reg) * SCALE <= THR), 1)) { mn = m_reg; alpha = 1.f; }
    else { mn = fmaxf(m_reg, pmax); alpha = __builtin_amdgcn_exp2f((m_reg - mn) * C2); m_reg = mn; }
    const float mnL = -mn * C2;
#pragma unroll
    for (int r = 0; r < 16; ++r) p0[r] = fmaf(p0[r], C2, mnL);
#pragma unroll
    for (int r = 0; r < 16; ++r) p1[r] = fmaf(p1[r], C2, mnL);
#pragma unroll
    for (int r = 0; r < 16; ++r) p0[r] = __builtin_amdgcn_exp2f(p0[r]);
}
__device__ __forceinline__ void finishSM(f32x16& p0, f32x16& p1, float alpha, float& l_reg, bf16x8& pa0, bf16x8& pa1, bf16x8& pa2, bf16x8& pa3) {
#pragma unroll
    for (int r = 0; r < 16; ++r) p1[r] = __builtin_amdgcn_exp2f(p1[r]);
    float ps = 0;
#pragma unroll
    for (int r = 0; r < 16; ++r) ps += p0[r];
#pragma unroll
    for (int r = 0; r < 16; ++r) ps += p1[r];
    { auto rr = __builtin_amdgcn_permlane32_swap(__float_as_uint(ps), __float_as_uint(ps), false, false);
      ps = __uint_as_float(rr[0]) + __uint_as_float(rr[1]); }
    l_reg = l_reg * alpha + ps;
#define PK4(P, B_, OUT) do { unsigned a0 = cvtpk(P[B_+0], P[B_+1]), a1 = cvtpk(P[B_+2], P[B_+3]);                          \
        unsigned b0 = cvtpk(P[B_+4], P[B_+5]), b1 = cvtpk(P[B_+6], P[B_+7]);                                             \
        auto r0 = __builtin_amdgcn_permlane32_swap(a0, b0, false, false); auto r1 = __builtin_amdgcn_permlane32_swap(a1, b1, false, false); \
        u32x4 w = {r0[0], r1[0], r0[1], r1[1]}; OUT = *reinterpret_cast<bf16x8*>(&w); } while (0)
    PK4(p0, 0, pa0); PK4(p0, 8, pa1); PK4(p1, 0, pa2); PK4(p1, 8, pa3);
#undef PK4
}
template <int KB>
__device__ __forceinline__ void qkt(f32x16& p0, f32x16& p1, const char* lds, int r32, int hi, const bf16x8* qn, const char* qrr) {
    p0 = f32x16{}; p1 = f32x16{};
    bf16x8 qr[4];
#pragma unroll
    for (int d0 = 0; d0 < 4; ++d0) qr[d0] = *(const bf16x8*)(qrr + d0 * 1024);
    const char* ka = lds + OFF_K + KB * SHM_K + r32 * KP + hi * 16;
#pragma unroll
    for (int d0 = 0; d0 < 8; ++d0) {
        bf16x8 b0 = *reinterpret_cast<const bf16x8*>(ka + d0 * 32);
        bf16x8 b1 = *reinterpret_cast<const bf16x8*>(ka + d0 * 32 + 32 * KP);
        p0 = __builtin_amdgcn_mfma_f32_32x32x16_bf16(b0, qn[d0], p0, 0, 0, 0);
        p1 = __builtin_amdgcn_mfma_f32_32x32x16_bf16(b1, qn[d0], p1, 0, 0, 0); }
    const char* ra = lds + OFF_R + KB * SHM_R + r32 * RP + hi * 16;
#pragma unroll
    for (int d0 = 0; d0 < 4; ++d0) {
        bf16x8 b0 = *reinterpret_cast<const bf16x8*>(ra + d0 * 32);
        bf16x8 b1 = *reinterpret_cast<const bf16x8*>(ra + d0 * 32 + 32 * RP);
        p0 = __builtin_amdgcn_mfma_f32_32x32x16_bf16(b0, qr[d0], p0, 0, 0, 0);
        p1 = __builtin_amdgcn_mfma_f32_32x32x16_bf16(b1, qr[d0], p1, 0, 0, 0); }
}
template <int KB>
__device__ __forceinline__ void qkt_fin(f32x16& p0, f32x16& p1, f32x16& y0, f32x16& y1, float alpha, float& l_reg, bf16x8& pa0, bf16x8& pa1, bf16x8& pa2, bf16x8& pa3,
                                        const char* lds, int r32, int hi, const bf16x8* qn, const char* qrr) {
    p0 = f32x16{}; p1 = f32x16{};
    const char* ka = lds + OFF_K + KB * SHM_K + r32 * KP + hi * 16;
    const char* ra = lds + OFF_R + KB * SHM_R + r32 * RP + hi * 16;
#define QK_LD(i, X0, X1) do { if ((i) < 8) { X0 = *reinterpret_cast<const bf16x8*>(ka + (i) * 32); X1 = *reinterpret_cast<const bf16x8*>(ka + (i) * 32 + 32 * KP); } \
                              else { X0 = *reinterpret_cast<const bf16x8*>(ra + ((i) - 8) * 32); X1 = *reinterpret_cast<const bf16x8*>(ra + ((i) - 8) * 32 + 32 * RP); \
                                     Q##X0 = *(const bf16x8*)(qrr + ((i) - 8) * 1024); } } while (0)
#define QK_MM(i, X0, X1) do { const bf16x8 q_ = (i) < 8 ? qn[(i) < 8 ? (i) : 0] : Q##X0; \
        p0 = __builtin_amdgcn_mfma_f32_32x32x16_bf16(X0, q_, p0, 0, 0, 0); p1 = __builtin_amdgcn_mfma_f32_32x32x16_bf16(X1, q_, p1, 0, 0, 0); } while (0)
#define QK_PK4(P, B_, OUT) do { unsigned a0_ = cvtpk(P[B_+0], P[B_+1]), a1_ = cvtpk(P[B_+2], P[B_+3]); unsigned b0_ = cvtpk(P[B_+4], P[B_+5]), b1_ = cvtpk(P[B_+6], P[B_+7]); \
        auto r0_ = __builtin_amdgcn_permlane32_swap(a0_, b0_, false, false); auto r1_ = __builtin_amdgcn_permlane32_swap(a1_, b1_, false, false); \
        u32x4 w_ = {r0_[0], r1_[0], r0_[1], r1_[1]}; OUT = *reinterpret_cast<bf16x8*>(&w_); } while (0)
    __builtin_amdgcn_s_setprio(1);
    bf16x8 A0, A1, B0, B1, C0, C1, QA0, QB0, QC0; float ps = 0.f;
    QK_LD(0, A0, A1); QK_LD(1, B0, B1); SBAR();
    QK_LD(2, C0, C1); QK_MM(0, A0, A1);
#pragma unroll
    for (int r = 0; r < 4; ++r) y1[r] = __builtin_amdgcn_exp2f(y1[r]);
    QK_PK4(y0, 0, pa0); SBAR();
    QK_LD(3, A0, A1); QK_MM(1, B0, B1);
#pragma unroll
    for (int r = 4; r < 8; ++r) y1[r] = __builtin_amdgcn_exp2f(y1[r]);
    QK_PK4(y0, 8, pa1); SBAR();
    QK_LD(4, B0, B1); QK_MM(2, C0, C1);
#pragma unroll
    for (int r = 8; r < 12; ++r) y1[r] = __builtin_amdgcn_exp2f(y1[r]);
#pragma unroll
    for (int r = 0; r < 8; ++r) ps += y0[r];
    SBAR();
    QK_LD(5, C0, C1); QK_MM(3, A0, A1);
#pragma unroll
    for (int r = 12; r < 16; ++r) y1[r] = __builtin_amdgcn_exp2f(y1[r]);
#pragma unroll
    for (int r = 8; r < 16; ++r) ps += y0[r];
    SBAR();
    QK_LD(6, A0, A1); QK_MM(4, B0, B1);
    QK_PK4(y1, 0, pa2);
#pragma unroll
    for (int r = 0; r < 8; ++r) ps += y1[r];
    SBAR();
    QK_LD(7, B0, B1); QK_MM(5, C0, C1);
    QK_PK4(y1, 8, pa3);
#pragma unroll
    for (int r = 8; r < 16; ++r) ps += y1[r];
    SBAR();
    QK_LD(8, C0, C1); QK_MM(6, A0, A1);
    { auto rr = __builtin_amdgcn_permlane32_swap(__float_as_uint(ps), __float_as_uint(ps), false, false); ps = __uint_as_float(rr[0]) + __uint_as_float(rr[1]); }
    l_reg = l_reg * alpha + ps;
    SBAR();
    QK_LD(9, A0, A1); QK_MM(7, B0, B1); SBAR();
    QK_LD(10, B0, B1); QK_MM(8, C0, C1); SBAR();
    QK_LD(11, C0, C1); QK_MM(9, A0, A1); SBAR();
    QK_MM(10, B0, B1); SBAR();
    QK_MM(11, C0, C1);
    __builtin_amdgcn_s_setprio(0);
#undef QK_LD
#undef QK_MM
#undef QK_PK4
}
__device__ __forceinline__ void pv_tile(f32x16* o, int vb0, bf16x8 pa0, bf16x8 pa1, bf16x8 pa2, bf16x8 pa3) {
#define TRRD(dst, off) asm volatile("ds_read_b64_tr_b16 %0, %1 offset:%2" : "=&v"(dst) : "v"(vb0), "i"(off) : "memory")
#define PV_D0(d0) do { s16x4 l0, l1, l2, l3, h0, h1, h2, h3; constexpr int b_ = v_rd_off(d0, 0, 0); \
        TRRD(l0, b_); TRRD(h0, b_ + 2048); TRRD(l1, b_ + 4096); TRRD(h1, b_ + 6144); TRRD(l2, b_ + 8192); TRRD(h2, b_ + 10240); TRRD(l3, b_ + 12288); TRRD(h3, b_ + 14336); \
        asm volatile("s_waitcnt lgkmcnt(0)" ::: "memory"); SBAR();   \
        o[d0] = __builtin_amdgcn_mfma_f32_32x32x16_bf16(pa0, (bf16x8){l0[0], l0[1], l0[2], l0[3], h0[0], h0[1], h0[2], h0[3]}, o[d0], 0, 0, 0);   \
        o[d0] = __builtin_amdgcn_mfma_f32_32x32x16_bf16(pa1, (bf16x8){l1[0], l1[1], l1[2], l1[3], h1[0], h1[1], h1[2], h1[3]}, o[d0], 0, 0, 0);   \
        o[d0] = __builtin_amdgcn_mfma_f32_32x32x16_bf16(pa2, (bf16x8){l2[0], l2[1], l2[2], l2[3], h2[0], h2[1], h2[2], h2[3]}, o[d0], 0, 0, 0);   \
        o[d0] = __builtin_amdgcn_mfma_f32_32x32x16_bf16(pa3, (bf16x8){l3[0], l3[1], l3[2], l3[3], h3[0], h3[1], h3[2], h3[3]}, o[d0], 0, 0, 0); } while (0)
    __builtin_amdgcn_s_setprio(1); PV_D0(0); PV_D0(1); PV_D0(2); PV_D0(3); __builtin_amdgcn_s_setprio(0);
#undef PV_D0
#undef TRRD
}
__device__ __forceinline__ void attn_unit(int rb, int hh, int hl, int qb, unsigned char* wsb, char* lds, bool do_store = true) {
    const bf16* Qn = (const bf16*)(wsb + WS_QN); const bf16* Qr = (const bf16*)(wsb + WS_QR); const bf16* Kn = (const bf16*)(wsb + WS_KN); const bf16* Kr = (const bf16*)(wsb + WS_KR); const bf16* Vv = (const bf16*)(wsb + WS_V);
    int tid_ = threadIdx.x; asm volatile("" : "+v"(tid_));
    const int tid = tid_, wid = __builtin_amdgcn_readfirstlane(tid >> 6), lane = tid & 63, r32 = lane & 31, hi = lane >> 5;
    const int q0 = qb * QB, NT = (q0 + QB) / KVBLK;
    const int qlo = q0 + wid * 32, qm = qlo + r32 - 4 * hi;
    char* V_lds = lds + OFF_V; char* K_lds = lds + OFF_K; char* R_lds = lds + OFF_R;
    float* ws = (float*)(lds + OFF_WS) + wid * 64; float* li_l = ws; float* al_l = ws + 32;
    float* carry = (float*)(lds + OFF_CARRY);
    const int cb = (4 * hh + hl) * 128;
    const bf16* Kh = Kn + (size_t)rb * 512 + hl * 128; const bf16* Vh = Vv + (size_t)rb * 512 + hl * 128; const bf16* Rh = Kr + (size_t)rb * 64;
    const int sr = tid >> 4, sc = (tid & 15) * 8, vst0 = v_st(sr, sc), vst1 = v_st(32 + sr, sc), kws = sr * KP + sc * 2;
    const int rrow = tid >> 3, rc = (tid & 7) * 8, rws = rrow * RP + rc * 2;
    const int vb0 = (int)(uintptr_t)V_lds + v_rd_base(lane);
    bf16x8 st_v0, st_v1, st_k0, st_k1, st_r;
#define VMW() asm volatile("s_waitcnt vmcnt(0)" ::: "memory")
#define SLOAD(k0) do { st_v0 = *(const bf16x8*)(Vh + (size_t)((k0) + sr) * 512 + sc); st_v1 = *(const bf16x8*)(Vh + (size_t)((k0) + 32 + sr) * 512 + sc); \
                       st_k0 = *(const bf16x8*)(Kh + (size_t)((k0) + sr) * 512 + sc); st_k1 = *(const bf16x8*)(Kh + (size_t)((k0) + 32 + sr) * 512 + sc); \
                       st_r = *(const bf16x8*)(Rh + (size_t)((k0) + rrow) * 64 + rc); } while (0)
#define SWRITE(bf, vs) do { *(bf16x8*)(V_lds + (vs) + vst0) = st_v0; *(bf16x8*)(V_lds + (vs) + vst1) = st_v1; \
                        *(bf16x8*)(K_lds + (bf) * SHM_K + kws) = st_k0; *(bf16x8*)(K_lds + (bf) * SHM_K + kws + 32 * KP) = st_k1; \
                        *(bf16x8*)(R_lds + (bf) * SHM_R + rws) = st_r; } while (0)
    SLOAD(0);
    bf16x8 qn[8];
    const char* qrr = lds + OFF_QR + wid * 4096 + lane * 16;
    { const bf16* qg = Qr + (size_t)(rb + q0 + wid * 32 + r32) * 256 + hl * 64 + hi * 8;
#pragma unroll
      for (int d0 = 0; d0 < 4; ++d0) *(bf16x8*)(lds + OFF_QR + wid * 4096 + lane * 16 + d0 * 1024) = *(const bf16x8*)(qg + d0 * 16); }
    { const bf16* qrow = Qn + (size_t)(rb + q0 + wid * 32 + r32) * 512 + hl * 128 + hi * 8;
#pragma unroll
      for (int d0 = 0; d0 < 8; ++d0) qn[d0] = *(const bf16x8*)(qrow + d0 * 16); }
    if (tid < 256) { const int which = tid >> 7, c = tid & 127, kmax = qb * 2 + which; const size_t base = (size_t)(rb >> 7) * 1024 + cb + c;
        const float* sumP = (const float*)(wsb + WS_SUMP); const float* sumH = (const float*)(wsb + WS_SUMH);
        float H = 0.f;
        for (int j = 0; j < kmax; j += 8) { float hv[8], pw[8];
#pragma unroll
            for (int q = 0; q < 8; ++q) { const bool ok = j + q < kmax; hv[q] = ok ? sumH[base + (size_t)(j + q) * 1024] : 0.f; pw[q] = ok ? sumP[base + (size_t)(j + q) * 1024] : 1.f; }
#pragma unroll
            for (int q = 0; q < 8; ++q) H = hv[q] + pw[q] * H; }
        carry[which * 128 + c] = H; }
    VMW(); SWRITE(0, 0); SBAR();
    SLOAD(KVBLK);
    __syncthreads();
    float m_reg = -1e30f, l_reg = 0; f32x16 o[4] = {};
    f32x16 pA0, pA1, pB0, pB1; float mnA, mnB, alA, alB; bf16x8 pa0, pa1, pa2, pa3;
    int sl_prev = 0, sl_cur = 0, sl_next = SHM_V;
#define ROT() do { sl_prev = sl_cur; sl_cur = sl_next; sl_next = (sl_next == 2 * SHM_V) ? 0 : sl_next + SHM_V; } while (0)
#define RESC(a) do { if (__any((a) < 1.f)) { if (hi == 0) al_l[r32] = (a); asm volatile("s_waitcnt lgkmcnt(0)" ::: "memory");              \
                     for (int d_ = 0; d_ < 4; ++d_) for (int r = 0; r < 16; ++r) o[d_][r] *= al_l[crow(r, hi)]; } } while (0)
#define MASKT(P0_, P1_, t) do { const int kb_ = (t) * KVBLK; if (kb_ + KVBLK - 1 > qlo) mask_tile(P0_, P1_, qm - kb_); } while (0)
    SBAR(); qkt<0>(pA0, pA1, lds, r32, hi, qn, qrr);
    MASKT(pA0, pA1, 0); partialSM(pA0, pA1, m_reg, mnA, alA);
    VMW(); SWRITE(1, SHM_V);
    __syncthreads();
    ROT();
#define STEP(PX0, PX1, mnX, alX, PY0, PY1, alY, t, KB, LAST) do {                                                             \
        SBAR(); qkt_fin<KB>(PX0, PX1, PY0, PY1, alY, l_reg, pa0, pa1, pa2, pa3, lds, r32, hi, qn, qrr); SBAR();               \
        if (!(LAST)) { SLOAD(((t) + 1) * KVBLK); SBAR(); }                                                                    \
        pv_tile(o, vb0 + sl_prev, pa0, pa1, pa2, pa3); MASKT(PX0, PX1, (t)); partialSM(PX0, PX1, m_reg, mnX, alX);            \
        if (!(LAST)) { VMW(); SWRITE(1 - (KB), sl_next); }                                                                    \
        RESC(alX);                                                                                                            \
        if (!(LAST)) { __syncthreads(); ROT(); } } while (0)
    for (int t = 1; t + 1 < NT; t += 2) {
        STEP(pB0, pB1, mnB, alB, pA0, pA1, alA, t, 1, false);
        STEP(pA0, pA1, mnA, alA, pB0, pB1, alB, t + 1, 0, false);
    }
    STEP(pB0, pB1, mnB, alB, pA0, pA1, alA, NT - 1, 1, true);
    finishSM(pB0, pB1, alB, l_reg, pa0, pa1, pa2, pa3); SBAR(); pv_tile(o, vb0 + sl_cur, pa0, pa1, pa2, pa3);
    if (hi == 0) li_l[r32] = l_reg; asm volatile("s_waitcnt lgkmcnt(0)" ::: "memory");
    __syncthreads();
    {
        float* stg = (float*)lds + wid * 4096;
#pragma unroll
        for (int r = 0; r < 16; ++r) { const int orow = crow(r, hi); const float rl = __builtin_amdgcn_rcpf(li_l[orow]);
#pragma unroll
            for (int d0 = 0; d0 < 4; ++d0) stg[orow * 128 + d0 * 32 + r32] = o[d0][r] * rl; }
        asm volatile("s_waitcnt lgkmcnt(0)" ::: "memory");
        const float* cr = carry + (wid >> 2) * 128 + (lane & 15) * 8;
        const f32x4 h0 = *(const f32x4*)cr, h1 = *(const f32x4*)(cr + 4);
        const size_t gbase = (size_t)(rb + q0 + wid * 32 + (lane >> 4)) * DM + cb + (lane & 15) * 8;
        const bf16* U = (const bf16*)(wsb + WS_SGA) + gbase; const bf16* WC = (const bf16*)(wsb + WS_XS) + gbase; const bf16* SGB = (const bf16*)(wsb + WS_SGB) + gbase; bf16* Y = (bf16*)(wsb + WS_XL) + gbase;
        const float* sp = stg + (lane >> 4) * 128 + (lane & 15) * 8;
#pragma unroll 2
        for (int i = 0; i < 8; ++i) {
            const bf16x8 u = *(const bf16x8*)(U + (size_t)i * 4 * DM), w = *(const bf16x8*)(WC + (size_t)i * 4 * DM), g = *(const bf16x8*)(SGB + (size_t)i * 4 * DM);
            const f32x4 v0 = *(const f32x4*)(sp + i * 512), v1 = *(const f32x4*)(sp + i * 512 + 4);
            f32x4 y0, y1;
#pragma unroll
            for (int e = 0; e < 4; ++e) { y0[e] = bf2f((bf16)u[e]) + bf2f((bf16)w[e]) * h0[e] + bf2f((bf16)g[e]) * v0[e];
                                          y1[e] = bf2f((bf16)u[4 + e]) + bf2f((bf16)w[4 + e]) * h1[e] + bf2f((bf16)g[4 + e]) * v1[e]; }
            if (do_store) store8bf(Y + (size_t)i * 4 * DM, y0, y1);
        }
    }
    __syncthreads();
#undef RESC
#undef MASKT
#undef STEP
#undef ROT
#undef SLOAD
#undef SWRITE
#undef VMW
}
#undef SBAR
}
__global__ void __launch_bounds__(512, 2) fwd_megakernel(Args a) {
    extern __shared__ __attribute__((aligned(16))) unsigned char lds[];
    cg::grid_group grid = cg::this_grid();
    {
        if (threadIdx.x < 8) ((LAS unsigned*)(lds + LDS_XB))[threadIdx.x] = 0u;
        __syncthreads();
    }
    grid.sync();
    (void)xcd_barrier_post((unsigned*)(a.ws + WS_BAR), (volatile LAS unsigned*)((LAS unsigned char*)lds + LDS_XB));
#define GSYNC() do { XcdBarrier b_; b_.bar = (unsigned*)(a.ws + WS_BAR); b_.x = xb_xcc_id(); b_.st = (volatile LAS unsigned*)((LAS unsigned char*)lds + LDS_XB); xcd_barrier(b_); } while (0)
    const int G = gridDim.x;
    LAS unsigned char* ldsl = (LAS unsigned char*)lds;
    unsigned char* ws = a.ws;
    float* mod = (float*)(ws + WS_MOD); float* ss = (float*)(ws + WS_SS);
    bf16* XS = (bf16*)(ws + WS_XS); bf16* XL = (bf16*)(ws + WS_XL); bf16* SGA = (bf16*)(ws + WS_SGA); bf16* SGB = (bf16*)(ws + WS_SGB); bf16* UU = (bf16*)(ws + WS_UU);
    bf16* QD = (bf16*)(ws + WS_QD); bf16* KVD = (bf16*)(ws + WS_KVD); float* KROPE = (float*)(ws + WS_KROPE); bf16* KR = (bf16*)(ws + WS_KR);
    bf16* QN = (bf16*)(ws + WS_QN); bf16* QR = (bf16*)(ws + WS_QR); bf16* KN = (bf16*)(ws + WS_KN); bf16* VV = (bf16*)(ws + WS_V);

#ifndef PHM
#define PHM 0xFFFF
#endif
    if (PHM & 1) phase0(a, ldsl);
    GSYNC();
    if (PHM & 2) phase1(a);
    GSYNC();
#ifdef PROBE_P01
    phase0(a, ldsl);
    GSYNC();
    phase1(a);
    GSYNC();
#endif
    for (int l = 0; l < DEPTH; ++l) {
        unsigned char* wl = ws + WS_W + (size_t)l * WL_STRIDE;
        float* ssA = ss + (size_t)(4 * l) * T; float* ssB = ssA + T; float* ssQ = ssA + 2 * T; float* ssKV = ssA + 3 * T; float* ssN = ssA + 4 * T;
        const float* modl = mod + (size_t)l * 4 * NMOD;
        if (PHM & 4) {
            pg8::Gemm g{(const bf16*)XS, (const bf16*)(wl + WL_IN), T, DINP, DM}; pg8::StaticOrder S; S.init(T, DINP, G, (int)blockIdx.x);
            EpiIn E{ssA, (const float*)(ws + WS_SHWIN) + (size_t)l * 4 * DINP, XL, QD, KVD, KROPE, SGA, SGB, ssQ, ssKV};
            pg8::gemm_phase<EpiIn, pg8::StaticOrder, true, true>(ldsl, g, S, E);
        }
        GSYNC();
        for (int hh = 0; hh < 2; ++hh) {
#ifdef PROBE_LRU2
            if (hh == 0 && l == 0) { lru_phase(a, l, (char*)lds, true); lru_phase(a, l, (char*)lds, true); }
#endif
            if ((PHM & 8) && hh == 0) { lru_phase(a, l, (char*)lds); krope_phase(a); }
            if (PHM & 16) {
                int Kq = 256; asm volatile("" : "+s"(Kq));
                pg8::Gemm g{(const bf16*)QD, (const bf16*)(wl + WL_UQ) + (size_t)hh * 768 * 256, T, 768, Kq}; pg8::StaticOrder S; S.init(T, 768, G, (int)blockIdx.x);
                EpiQ E{ssQ, (const float*)(ws + WS_CS), QN, QR};
                pg8::gemm_phase<EpiQ, pg8::StaticOrder, true, true>(ldsl, g, S, E);
            }
            if (PHM & 32) {
                int Kk = 128; asm volatile("" : "+s"(Kk));
                pg8::Gemm g{(const bf16*)KVD, (const bf16*)(wl + WL_UKV) + (size_t)hh * 1024 * 128, T, 1024, Kk}; pg8::StaticOrder S; S.init(T, 1024, G, (int)blockIdx.x);
                EpiKV E{ssKV, KN, VV};
                pg8::gemm_phase<EpiKV, pg8::StaticOrder, true, true>(ldsl, g, S, E);
            }
#ifdef PROBE_QKV2
            {
                int Kq = 256; asm volatile("" : "+s"(Kq));
                pg8::Gemm g{(const bf16*)QD, (const bf16*)(wl + WL_UQ) + (size_t)hh * 768 * 256, T, 768, Kq}; pg8::StaticOrder S; S.init(T, 768, G, (int)blockIdx.x);
                EpiQ E{ssQ, (const float*)(ws + WS_CS), QN, QR};
                pg8::gemm_phase<EpiQ, pg8::StaticOrder, true, true>(ldsl, g, S, E);
            }
            {
                int Kk = 128; asm volatile("" : "+s"(Kk));
                pg8::Gemm g{(const bf16*)KVD, (const bf16*)(wl + WL_UKV) + (size_t)hh * 1024 * 128, T, 1024, Kk}; pg8::StaticOrder S; S.init(T, 1024, G, (int)blockIdx.x);
                EpiKV E{ssKV, KN, VV};
                pg8::gemm_phase<EpiKV, pg8::StaticOrder, true, true>(ldsl, g, S, E);
            }
#endif
            GSYNC();
            const int vcu = (G % 8 == 0) ? (int)(blockIdx.x & 7) * (G / 8) + (int)(blockIdx.x >> 3) : (int)blockIdx.x;
            if (PHM & 64) for (int p2 = 2 * vcu; p2 < 512; p2 += ((p2 & 1) ? 2 * G - 1 : 1)) {
                const int p = p2 >> 1, bh = p >> 4, s = p & 15, b = bh >> 2, hl = bh & 3;
                att::attn_unit(b * SEQ, hh, hl, (p2 & 1) ? s : 31 - s, ws, (char*)lds);
            }
#ifdef PROBE_ATT2
#ifndef PROBE_NOSYNC
            GSYNC();
#endif
            if (hh == PROBE_ATT2 - 1) for (int p2 = 2 * blockIdx.x; p2 < 512; p2 += ((p2 & 1) ? 2 * G - 1 : 1)) {
                const int p = p2 >> 1, bh = p >> 4, s = p & 15, b = bh >> 2, hl = bh & 3;
                att::attn_unit(b * SEQ, hh, hl, (p2 & 1) ? s : 31 - s, ws, (char*)lds, PROBE_STORE);
            }
#endif
            GSYNC();
        }
        if (PHM & 128) {
            pg8::Gemm g{(const bf16*)XL, (const bf16*)(wl + WL_OUT), T, DM, DM}; pg8::StaticOrder S; S.init(T, DM, G, (int)blockIdx.x);
            EpiRes E{l == 0 ? a.x : a.out, a.out, modl + 2048, modl + 4096, XS, ssB};
            pg8::gemm_phase<EpiRes, pg8::StaticOrder, true, true>(ldsl, g, S, E);
        }
        GSYNC();
        if (PHM & 256) {
            pg8::Gemm g{(const bf16*)XS, (const bf16*)(wl + WL_FFI), T, 2 * DFF, DM}; pg8::StaticOrder S; S.init(T, 2 * DFF, G, (int)blockIdx.x);
            EpiFfi E{ssB, (const float*)(ws + WS_SHWF) + (size_t)l * 4 * 2 * DFF, UU};
            pg8::gemm_phase<EpiFfi, pg8::StaticOrder, true, true>(ldsl, g, S, E);
#ifdef PROBE_FFI2
            GSYNC();
            pg8::gemm_phase<EpiFfi, pg8::StaticOrder, true, true>(ldsl, g, S, E);
#endif
        }
        GSYNC();
        if (PHM & 512) {
            pg8::Gemm g{(const bf16*)UU, (const bf16*)(wl + WL_FFO), T, DM, DFF}; pg8::StaticOrder S; S.init(T, DM, G, (int)blockIdx.x);
            EpiRes E{a.out, a.out, modl + 5120, (l + 1 < DEPTH) ? modl + 4 * NMOD + 1024 : nullptr, XS, ssN};
            pg8::gemm_phase<EpiRes, pg8::StaticOrder, true, true>(ldsl, g, S, E);
        }
        GSYNC();
    }
    if (PHM & 1024) final_phase(a);
}

extern "C" void kernel_launch(void* const* d_in, const int* in_sizes, int n_in, void* d_out, int out_size, void* d_ws, size_t ws_size, hipStream_t stream) {
    static int grid = 0;
    if (grid == 0) {
        int dev = 0, cus = 0, per_cu = 0;
        if (hipGetDevice(&dev) != hipSuccess || hipDeviceGetAttribute(&cus, hipDeviceAttributeMultiprocessorCount, dev) != hipSuccess) { grid = -1; return; }
        if (hipFuncSetAttribute((const void*)fwd_megakernel, hipFuncAttributeMaxDynamicSharedMemorySize, LDS_BYTES) != hipSuccess) { fprintf(stderr, "hipFuncSetAttribute failed\n"); grid = -1; return; }
        if (hipOccupancyMaxActiveBlocksPerMultiprocessor(&per_cu, (const void*)fwd_megakernel, 512, LDS_BYTES) != hipSuccess || per_cu < 1) per_cu = 1;
        (void)hipGetLastError();
        grid = cus;
        if (ws_size < WS_END) { fprintf(stderr, "workspace too small: %zu < %zu\n", ws_size, (size_t)WS_END); grid = -1; return; }
    }
    if (grid < 0) return;
    Args a{};
    a.x = (const float*)d_in[0]; a.c = (const float*)d_in[1]; a.pos = (const int*)d_in[2]; a.w_ada = (const float*)d_in[3]; a.b_ada = (const float*)d_in[4];
    a.w_in = (const float*)d_in[5]; a.conv_w = (const float*)d_in[6]; a.conv_b = (const float*)d_in[7]; a.lru_wa = (const float*)d_in[8]; a.lru_ba = (const float*)d_in[9];
    a.lru_wx = (const float*)d_in[10]; a.lru_bx = (const float*)d_in[11]; a.lru_a = (const float*)d_in[12]; a.qg = (const float*)d_in[13]; a.kvg = (const float*)d_in[14];
    a.w_uq = (const float*)d_in[15]; a.w_ukv = (const float*)d_in[16]; a.w_out = (const float*)d_in[17]; a.w_ffi = (const float*)d_in[18]; a.w_ffo = (const float*)d_in[19];
    a.fg = (const float*)d_in[20]; a.out = (float*)d_out; a.ws = (unsigned char*)d_ws;
    if (hipMemsetAsync((char*)d_ws + WS_BAR, 0, 16384, stream) != hipSuccess) { fprintf(stderr, "memset failed\n"); return; }
    void* args[] = {&a};
    hipError_t e = hipLaunchCooperativeKernel((const void*)fwd_megakernel, dim3(grid), dim3(512), args, LDS_BYTES, stream);
    if (e != hipSuccess) fprintf(stderr, "cooperative launch failed: %s (grid %d)\n", hipGetErrorString(e), grid);
}
```

```cpp
#include <hip/hip_runtime.h>
#include <hip/hip_cooperative_groups.h>
#include <hip/hip_bf16.h>
#include <cstdio>
#include <cstdint>
namespace cg = cooperative_groups;
namespace pg8 {
#define PG8_LAS __attribute__((address_space(3)))
typedef unsigned short bf16_t;
typedef short bf16x8 __attribute__((ext_vector_type(8)));
typedef float f32x4 __attribute__((ext_vector_type(4)));
typedef unsigned u32x4 __attribute__((ext_vector_type(4)));
constexpr int BM = 256, BK = 64, HALF = 128, HTB = HALF * BK * 2  , STAGE_BYTES = 8 * HTB, NXCD = 8, WGM = 8;

__host__ __device__ __forceinline__ int lds_byte(int r, int c) { const int st = (r >> 4) * 2 + (c >> 5), rr = r & 15, cc = c & 31, ob = rr * 64 + cc * 2; return st * 1024 + (ob ^ (((ob >> 9) & 1) << 5)); }
__host__ __device__ __forceinline__ void stage_rc(int b, int& R, int& C) { const int st = b / 1024, sb = b % 1024, swz = sb ^ (((sb >> 9) & 1) << 5); R = (st >> 1) * 16 + swz / 64; C = (st & 1) * 32 + (swz % 64) / 2; }
__host__ __device__ __forceinline__ int perm32(int rho) { const int n = rho >> 4, i = rho & 15; return 8 * (i >> 2) + 4 * n + (i & 3); }

struct Unit { int pm, pn; };
struct Gemm { const bf16_t* A; const bf16_t* Bt; int M, N, K; };

struct StaticOrder {
    int nM, nN, nwg, G, c;
    __host__ __device__ void init(int M, int N, int G_, int c_) { nM = M / BM; nN = N / BM; nwg = nM * nN; G = G_; c = c_; }
    __host__ __device__ bool next(int i, Unit& u) const {
        const long L = (long)i * G + c; if (L >= nwg) return false;
        int wgid = (int)L; { const int q = nwg / NXCD, r = nwg % NXCD, xcd = wgid % NXCD, off = wgid / NXCD; wgid = (xcd < r ? xcd * (q + 1) : r * (q + 1) + (xcd - r) * q) + off; }
        const int nig = WGM * nN, gid = wgid / nig, fm = gid * WGM, gsz = (nM - fm) < WGM ? (nM - fm) : WGM;
        u.pm = fm + ((wgid % nig) % gsz); u.pn = (wgid % nig) / gsz; return true;
    }
    __device__ __forceinline__ void a_ready(const Unit&) const {}
    __device__ __forceinline__ void done(const Unit&) const {}
};

typedef float cvt_f32x2_t __attribute__((ext_vector_type(2))); typedef __bf16 cvt_bf16x2_t __attribute__((ext_vector_type(2)));
__device__ __forceinline__ unsigned cvt_pk_bf16(float lo, float hi) { cvt_f32x2_t v = {lo, hi}; cvt_bf16x2_t b = __builtin_convertvector(v, cvt_bf16x2_t); return __builtin_bit_cast(unsigned, b); }
typedef float f32x2 __attribute__((ext_vector_type(2)));
template <class Epi, class Sched, bool ALIGN_EPI = false, bool SP2 = false>
__device__ __forceinline__ void gemm_phase(PG8_LAS unsigned char* lds, const Gemm g, const Sched& S, const Epi& E) {
    int tid_ = threadIdx.x; asm volatile("" : "+v"(tid_));
    const int tid = tid_, wid = __builtin_amdgcn_readfirstlane(tid >> 6), lane = tid & 63, wr = wid >> 2, wc = wid & 3, fr = lane & 15, fq = lane >> 4;
    const int K = g.K, nt = K / BK;
    unsigned voffA[2], voffB[2];
#pragma unroll
    for (int i = 0; i < 2; ++i) { int R, C; stage_rc(tid * 16 + i * 8192, R, C); const int Rb = Epi::PERM ? ((R & ~31) + perm32(R & 31)) : R;
        voffA[i] = (unsigned)(R * K + C) * 2u; voffB[i] = (unsigned)(Rb * K + C) * 2u; }
    const size_t kstep = (size_t)(BK * 2);
    const size_t hstep = (size_t)HALF * K * 2;
    const size_t tstep = 2 * hstep;
    const unsigned ldsw = (unsigned)wid * 1024u;
    const int aoff = lds_byte(wr * 64 + fr, fq * 8), boff = lds_byte(wc * 32 + fr, fq * 8);
#define PG8_SA(b, h) (((b) * 2 + (h)) * HTB)
#define PG8_SB(b, h) ((4 + (b) * 2 + (h)) * HTB)
#define PG8_STAGE(bufoff, gbase, voff) do { _Pragma("unroll") for (int _i = 0; _i < 2; ++_i) \
        __builtin_amdgcn_global_load_lds((const unsigned*)((const char*)(gbase) + (voff)[_i]), (PG8_LAS unsigned*)(lds + (bufoff) + ldsw + _i * 8192), 16, 0, 0); } while (0)
#define PG8_LDA(dst, b, h) do { _Pragma("unroll") for (int m = 0; m < 4; ++m) _Pragma("unroll") for (int k = 0; k < 2; ++k) dst[m][k] = *(const PG8_LAS bf16x8*)(lds + PG8_SA(b, h) + aoff + m * 2048 + k * 1024); } while (0)
#define PG8_LDB(dst, b, h) do { _Pragma("unroll") for (int n = 0; n < 2; ++n) _Pragma("unroll") for (int k = 0; k < 2; ++k) dst[n][k] = *(const PG8_LAS bf16x8*)(lds + PG8_SB(b, h) + boff + n * 2048 + k * 1024); } while (0)
#define PG8_MMA(ai, bj, At, Bt) do { __builtin_amdgcn_s_setprio(1); _Pragma("unroll") for (int m = 0; m < 4; ++m) _Pragma("unroll") for (int n = 0; n < 2; ++n) _Pragma("unroll") for (int k = 0; k < 2; ++k) \
        acc[ai][bj][m][n] = __builtin_amdgcn_mfma_f32_16x16x32_bf16(Bt[n][k], At[m][k], acc[ai][bj][m][n], 0, 0, 0); __builtin_amdgcn_s_setprio(0); } while (0)
#define PG8_WAIT_V(n) asm volatile("s_waitcnt vmcnt(" #n ")" ::: "memory")
#define PG8_WAIT_L(n) asm volatile("s_waitcnt lgkmcnt(" #n ")" ::: "memory")
#define PG8_BAR __builtin_amdgcn_s_barrier()
#define PG8_SCHED __builtin_amdgcn_sched_barrier(0)
    Unit cur, nxt; int ui = 0;
    if (!S.next(0, cur)) return;
    f32x4 acc[2][2][4][2];
#pragma unroll
    for (int a = 0; a < 2; ++a)
#pragma unroll
        for (int b = 0; b < 2; ++b)
#pragma unroll
            for (int m = 0; m < 4; ++m)
#pragma unroll
                for (int n = 0; n < 2; ++n) acc[a][b][m][n] = (f32x4){0.f, 0.f, 0.f, 0.f};
    bf16x8 At[4][2], B0[2][2], B1[2][2];
    const char* cA = (const char*)g.A + (size_t)cur.pm * tstep; const char* cB = (const char*)g.Bt + (size_t)cur.pn * tstep;
    S.a_ready(cur);
    if constexpr (SP2) {
        PG8_STAGE(PG8_SB(0, 0), cB, voffB); PG8_STAGE(PG8_SB(0, 1), cB + hstep, voffB); PG8_STAGE(PG8_SA(0, 0), cA, voffA); PG8_STAGE(PG8_SA(0, 1), cA + hstep, voffA);
        if (wr == 1) PG8_BAR;
        PG8_WAIT_V(2); PG8_BAR;
        PG8_STAGE(PG8_SB(1, 0), cB + kstep, voffB); PG8_STAGE(PG8_SA(1, 0), cA + kstep, voffA); PG8_STAGE(PG8_SB(1, 1), cB + hstep + kstep, voffB);
        PG8_WAIT_V(6); PG8_BAR;
    } else {
        PG8_STAGE(PG8_SB(0, 0), cB, voffB); PG8_STAGE(PG8_SA(0, 0), cA, voffA); PG8_STAGE(PG8_SB(0, 1), cB + hstep, voffB); PG8_STAGE(PG8_SA(0, 1), cA + hstep, voffA);
        if (wr == 1) PG8_BAR;
        PG8_WAIT_V(4); PG8_BAR;
        PG8_STAGE(PG8_SB(1, 0), cB + kstep, voffB); PG8_STAGE(PG8_SA(1, 0), cA + kstep, voffA); PG8_STAGE(PG8_SB(1, 1), cB + hstep + kstep, voffB);
        PG8_WAIT_V(6); PG8_BAR;
    }
    for (;;) {
        const bool has_next = S.next(ui + 1, nxt);
        const char* nA = has_next ? (const char*)g.A + (size_t)nxt.pm * tstep : cA; const char* nB = has_next ? (const char*)g.Bt + (size_t)nxt.pn * tstep : cB;
        for (int t = 0; t < nt; t += 2) {
            const bool last = (t == nt - 2);
            const char* a1 = cA + (size_t)(t + 1) * kstep;
            const char* a2 = last ? nA : cA + (size_t)(t + 2) * kstep; const char* b2 = last ? nB : cB + (size_t)(t + 2) * kstep;
            const char* a3 = a2 + kstep; const char* b3 = b2 + kstep;
            if (last && has_next) S.a_ready(nxt);
            if constexpr (SP2) {
            PG8_LDB(B0, 0, 0); PG8_LDB(B1, 0, 1); PG8_SCHED; PG8_LDA(At, 0, 0); PG8_STAGE(PG8_SA(1, 1), a1 + hstep, voffA);
            PG8_WAIT_V(8); PG8_WAIT_L(0); PG8_BAR; PG8_MMA(0, 0, At, B0); PG8_MMA(0, 1, At, B1); PG8_BAR; PG8_SCHED;
            PG8_LDA(At, 0, 1); PG8_STAGE(PG8_SB(0, 0), b2, voffB); PG8_STAGE(PG8_SB(0, 1), b2 + hstep, voffB); PG8_STAGE(PG8_SA(0, 0), a2, voffA);
            PG8_WAIT_V(8); PG8_WAIT_L(0); PG8_BAR; PG8_MMA(1, 0, At, B0); PG8_MMA(1, 1, At, B1); PG8_BAR; PG8_SCHED;
            PG8_LDB(B0, 1, 0); PG8_LDB(B1, 1, 1); PG8_SCHED; PG8_LDA(At, 1, 0); PG8_STAGE(PG8_SA(0, 1), a2 + hstep, voffA);
            PG8_WAIT_V(8); PG8_WAIT_L(0); PG8_BAR; PG8_MMA(0, 0, At, B0); PG8_MMA(0, 1, At, B1); PG8_BAR; PG8_SCHED;
            PG8_LDA(At, 1, 1); PG8_STAGE(PG8_SB(1, 0), b3, voffB); PG8_STAGE(PG8_SB(1, 1), b3 + hstep, voffB); PG8_STAGE(PG8_SA(1, 0), a3, voffA);
            PG8_WAIT_V(8); PG8_WAIT_L(0); PG8_BAR; PG8_MMA(1, 0, At, B0); PG8_MMA(1, 1, At, B1); PG8_BAR; PG8_SCHED;
            } else {
            PG8_LDB(B0, 0, 0); PG8_SCHED; PG8_LDA(At, 0, 0); PG8_STAGE(PG8_SA(1, 1), a1 + hstep, voffA);
            PG8_WAIT_L(8); PG8_BAR; PG8_WAIT_L(0); PG8_MMA(0, 0, At, B0); PG8_BAR; PG8_SCHED;
            PG8_LDB(B1, 0, 1); PG8_STAGE(PG8_SB(0, 0), b2, voffB);
            PG8_BAR; PG8_WAIT_L(0); PG8_MMA(0, 1, At, B1); PG8_BAR;
            PG8_LDA(At, 0, 1); PG8_STAGE(PG8_SA(0, 0), a2, voffA);
            PG8_BAR; PG8_WAIT_L(0); PG8_MMA(1, 0, At, B0); PG8_BAR; PG8_SCHED;
            PG8_STAGE(PG8_SB(0, 1), b2 + hstep, voffB);
            PG8_WAIT_V(6); PG8_BAR; PG8_MMA(1, 1, At, B1); PG8_BAR;
            PG8_LDB(B0, 1, 0); PG8_SCHED; PG8_LDA(At, 1, 0); PG8_STAGE(PG8_SA(0, 1), a2 + hstep, voffA);
            PG8_WAIT_L(8); PG8_BAR; PG8_WAIT_L(0); PG8_MMA(0, 0, At, B0); PG8_BAR; PG8_SCHED;
            PG8_LDB(B1, 1, 1); PG8_STAGE(PG8_SB(1, 0), b3, voffB);
            PG8_BAR; PG8_WAIT_L(0); PG8_MMA(0, 1, At, B1); PG8_BAR;
            PG8_LDA(At, 1, 1); PG8_STAGE(PG8_SA(1, 0), a3, voffA);
            PG8_BAR; PG8_WAIT_L(0); PG8_MMA(1, 0, At, B0); PG8_BAR; PG8_SCHED;
            PG8_STAGE(PG8_SB(1, 1), b3 + hstep, voffB);
            PG8_WAIT_V(6); PG8_BAR; PG8_MMA(1, 1, At, B1); PG8_BAR;
            }
        }
        if constexpr (ALIGN_EPI) { if (wr == 0) PG8_BAR; }
        if constexpr (!Epi::AFTER_DRAIN) { E(acc, cur, wr, wc, fr, fq); S.done(cur); }
        if (!has_next) break;
#pragma unroll
        for (int a = 0; a < 2; ++a)
#pragma unroll
            for (int b = 0; b < 2; ++b)
#pragma unroll
                for (int m = 0; m < 4; ++m)
#pragma unroll
                    for (int n = 0; n < 2; ++n) acc[a][b][m][n] = (f32x4){0.f, 0.f, 0.f, 0.f};
        cur = nxt; cA = nA; cB = nB; ++ui;
        if constexpr (ALIGN_EPI) { if (wr == 1) PG8_BAR; }
    }
    PG8_WAIT_V(0);
    if constexpr (!ALIGN_EPI) { if (wr == 0) PG8_BAR; }
    PG8_BAR;
    if constexpr (Epi::AFTER_DRAIN) { E.fused(acc, cur, wr, wc, fr, fq, lds, wid, lane); S.done(cur); }
#undef PG8_SA
#undef PG8_SB
#undef PG8_STAGE
#undef PG8_LDA
#undef PG8_LDB
#undef PG8_MMA
#undef PG8_WAIT_V
#undef PG8_WAIT_L
#undef PG8_BAR
#undef PG8_SCHED
}
}
#define LAS __attribute__((address_space(3)))
typedef unsigned short bf16;
typedef float f32x4 __attribute__((ext_vector_type(4)));
typedef float f32x2 __attribute__((ext_vector_type(2)));
typedef float f32x16 __attribute__((ext_vector_type(16)));
typedef unsigned u32x4 __attribute__((ext_vector_type(4)));
typedef unsigned u32x2 __attribute__((ext_vector_type(2)));
typedef short bf16x8 __attribute__((ext_vector_type(8)));
typedef short s16x4 __attribute__((ext_vector_type(4)));
using pg8::Unit; using pg8::cvt_pk_bf16;

constexpr int NB = 4, SEQ = 8192, T = NB * SEQ, DM = 1024, DEPTH = 2, DINP = 3584, DFF = 2816, NMOD = 6144;
constexpr float EPS = 1e-6f;
constexpr size_t MiB = 1u << 20;
constexpr size_t WS_MOD = 0, WS_SHWIN = 256 * 1024, WS_SHWF = 512 * 1024, WS_SS = 1 * MiB, WS_SUMP = 3 * MiB, WS_SUMH = 4 * MiB, WS_CS = 8 * MiB, WS_W = 16 * MiB;
constexpr size_t WL_STRIDE = 28 * MiB, WL_IN = 0, WL_OUT = 7 * MiB, WL_FFI = 9 * MiB, WL_FFO = 20 * MiB, WL_UQ = 25 * MiB + 512 * 1024, WL_UKV = 26 * MiB + 256 * 1024, WL_LRU = 26 * MiB + 768 * 1024;
constexpr size_t WS_XS = 72 * MiB, WS_XL = 136 * MiB, WS_SGA = 200 * MiB, WS_SGB = 264 * MiB, WS_UU = 136 * MiB, WS_QD = 328 * MiB, WS_KVD = 344 * MiB, WS_KROPE = 352 * MiB,
                 WS_KR = 360 * MiB, WS_QN = 364 * MiB, WS_QR = 396 * MiB, WS_KN = 412 * MiB, WS_V = 444 * MiB, WS_END = 476 * MiB;
constexpr size_t WS_BAR = 5 * MiB;
constexpr int LDS_BYTES = 147456, LDS_XB = 144384;

__device__ const float INV_FREQ[32] = {1.0f, 0.7498942613601685f, 0.5623413324356079f, 0.4216965138912201f, 0.3162277638912201f, 0.23713737726211548f, 0.17782793939113617f, 0.133352130651474f, 0.10000000149011612f, 0.07498941570520401f, 0.05623413249850273f, 0.04216965287923813f, 0.03162277489900589f, 0.023713737726211548f, 0.017782794311642647f, 0.01333521492779255f, 0.009999999776482582f, 0.007498941849917173f, 0.005623413249850273f, 0.0042169648222625256f, 0.003162277629598975f, 0.00237137358635664f, 0.0017782794311642647f, 0.0013335214462131262f, 0.0010000000474974513f, 0.0007498942431993783f, 0.000562341301701963f, 0.0004216965171508491f, 0.0003162277571391314f, 0.00023713737027719617f, 0.00017782794020604342f, 0.0001333521504420787f};

struct Args {
    const float* x; const float* c; const int* pos; const float* w_ada; const float* b_ada; const float* w_in; const float* conv_w; const float* conv_b;
    const float* lru_wa; const float* lru_ba; const float* lru_wx; const float* lru_bx; const float* lru_a; const float* qg; const float* kvg;
    const float* w_uq; const float* w_ukv; const float* w_out; const float* w_ffi; const float* w_ffo; const float* fg;
    float* out; unsigned char* ws;
};

__device__ __forceinline__ float bf2f(bf16 u) { return __uint_as_float(((unsigned)u) << 16); }
__device__ __forceinline__ unsigned f2bf(float f) { unsigned u = __float_as_uint(f); return (u + 0x7fffu + ((u >> 16) & 1u)) >> 16; }
__device__ __forceinline__ float sigmoidf_(float x) { return __builtin_amdgcn_rcpf(1.0f + __builtin_amdgcn_exp2f(-1.4426950408889634f * x)); }
__device__ __forceinline__ void store8bf(bf16* p, f32x4 a, f32x4 b) { u32x4 w; w.x = cvt_pk_bf16(a[0], a[1]); w.y = cvt_pk_bf16(a[2], a[3]); w.z = cvt_pk_bf16(b[0], b[1]); w.w = cvt_pk_bf16(b[2], b[3]); *(u32x4*)p = w; }
__device__ __forceinline__ float sumsq4(f32x4 v) { return (v[0] * v[0] + v[1] * v[1]) + (v[2] * v[2] + v[3] * v[3]); }
__device__ __forceinline__ void atomic_addf(float* p, float v) { (void)__hip_atomic_fetch_add(p, v, __ATOMIC_RELAXED, __HIP_MEMORY_SCOPE_AGENT); }
__device__ __forceinline__ float wave_sum(float v) {
#pragma unroll
    for (int o = 1; o < 64; o <<= 1) v += __shfl_xor(v, o);
    return v;
}
#define LDS_WAIT() asm volatile("s_waitcnt lgkmcnt(0)" ::: "memory")

struct EpiIn {
    static constexpr bool PERM = true, AFTER_DRAIN = false;
    const float* ss; const float* shw; bf16* XL; bf16* QD; bf16* KVD; float* KROPE; bf16* SGA; bf16* SGB; float* ssq; float* sskv;
    __device__ __forceinline__ void operator()(const f32x4 (&acc)[2][2][4][2], const Unit& u, int wr, int wc, int fr, int fq) const {
        const int row0 = u.pm * 256 + wr * 64 + fr, b = u.pm >> 5, pn = u.pn, c8 = wc * 32 + 8 * fq;
        f32x4 sv[2][2];
#pragma unroll
        for (int bj = 0; bj < 2; ++bj)
#pragma unroll
            for (int n = 0; n < 2; ++n) sv[bj][n] = *(const f32x4*)(shw + b * DINP + pn * 256 + bj * 128 + c8 + 4 * n);
        float ssv[2][4];
#pragma unroll
        for (int ai = 0; ai < 2; ++ai)
#pragma unroll
            for (int m = 0; m < 4; ++m) ssv[ai][m] = ss[row0 + ai * 128 + m * 16];
#pragma unroll
        for (int ai = 0; ai < 2; ++ai)
#pragma unroll
            for (int m = 0; m < 4; ++m) {
                const size_t row = (size_t)(row0 + ai * 128 + m * 16);
                const float rstd = __builtin_amdgcn_rsqf(ssv[ai][m] * (1.0f / 1024.0f) + EPS);
                f32x4 v[2][2];
#pragma unroll
                for (int bj = 0; bj < 2; ++bj)
#pragma unroll
                    for (int n = 0; n < 2; ++n) v[bj][n] = acc[ai][bj][m][n] * rstd + sv[bj][n];
                if (pn < 4) {
#pragma unroll
                    for (int bj = 0; bj < 2; ++bj) store8bf(XL + row * 1024 + pn * 256 + bj * 128 + c8, v[bj][0], v[bj][1]);
                } else if (pn == 4) {
#pragma unroll
                    for (int bj = 0; bj < 2; ++bj) store8bf(QD + row * 256 + bj * 128 + c8, v[bj][0], v[bj][1]);
                    float s = (sumsq4(v[0][0]) + sumsq4(v[0][1])) + (sumsq4(v[1][0]) + sumsq4(v[1][1]));
                    s += __shfl_xor(s, 16); s += __shfl_xor(s, 32);
                    if (fq == 0) atomic_addf(ssq + row, s);
                } else if (pn == 5) {
                    store8bf(KVD + row * 128 + c8, v[0][0], v[0][1]);
                    float s = sumsq4(v[0][0]) + sumsq4(v[0][1]);
                    s += __shfl_xor(s, 16); s += __shfl_xor(s, 32);
                    if (fq == 0) atomic_addf(sskv + row, s);
                    if (wc < 2) { *(f32x4*)(KROPE + row * 64 + c8) = v[1][0]; *(f32x4*)(KROPE + row * 64 + c8 + 4) = v[1][1]; }
                } else {
                    bf16* G = (pn < 10) ? SGA + (pn - 6) * 256 : SGB + (pn - 10) * 256;
#pragma unroll
                    for (int bj = 0; bj < 2; ++bj) {
                        f32x4 a, c;
#pragma unroll
                        for (int j = 0; j < 4; ++j) { a[j] = sigmoidf_(v[bj][0][j]); c[j] = sigmoidf_(v[bj][1][j]); }
                        store8bf(G + row * 1024 + bj * 128 + c8, a, c);
                    }
                }
            }
    }
};
struct EpiQ {
    static constexpr bool PERM = true, AFTER_DRAIN = false;
    const float* ssq; const float* cs; bf16* QN; bf16* QR;
    __device__ __forceinline__ void operator()(const f32x4 (&acc)[2][2][4][2], const Unit& u, int wr, int wc, int fr, int fq) const {
        const int row0 = u.pm * 256 + wr * 64 + fr, pn = u.pn, c8 = wc * 32 + 8 * fq;
        float ssv[2][4];
#pragma unroll
        for (int ai = 0; ai < 2; ++ai)
#pragma unroll
            for (int m = 0; m < 4; ++m) ssv[ai][m] = ssq[row0 + ai * 128 + m * 16];
#pragma unroll
        for (int ai = 0; ai < 2; ++ai)
#pragma unroll
            for (int m = 0; m < 4; ++m) {
                const size_t row = (size_t)(row0 + ai * 128 + m * 16);
                const float rstd = __builtin_amdgcn_rsqf(ssv[ai][m] * (1.0f / 256.0f) + EPS);
                if (pn < 2) {
#pragma unroll
                    for (int bj = 0; bj < 2; ++bj) store8bf(QN + row * 512 + pn * 256 + bj * 128 + c8, acc[ai][bj][m][0] * rstd, acc[ai][bj][m][1] * rstd);
                } else {
                    const int i0 = (wc & 1) * 16 + 4 * fq;
                    const f32x4 cs0 = *(const f32x4*)(cs + row * 64 + 2 * i0), cs1 = *(const f32x4*)(cs + row * 64 + 2 * i0 + 4);
#pragma unroll
                    for (int bj = 0; bj < 2; ++bj) {
                        const f32x4 a = acc[ai][bj][m][0] * rstd, c = acc[ai][bj][m][1] * rstd; f32x4 oa, oc;
                        oa[0] = a[0] * cs0[0] - a[1] * cs0[1]; oa[1] = a[1] * cs0[0] + a[0] * cs0[1];
                        oa[2] = a[2] * cs0[2] - a[3] * cs0[3]; oa[3] = a[3] * cs0[2] + a[2] * cs0[3];
                        oc[0] = c[0] * cs1[0] - c[1] * cs1[1]; oc[1] = c[1] * cs1[0] + c[0] * cs1[1];
                        oc[2] = c[2] * cs1[2] - c[3] * cs1[3]; oc[3] = c[3] * cs1[2] + c[2] * cs1[3];
                        store8bf(QR + row * 256 + bj * 128 + c8, oa, oc);
                    }
                }
            }
    }
};
struct EpiKV {
    static constexpr bool PERM = true, AFTER_DRAIN = false;
    const float* sskv; bf16* KN; bf16* V;
    __device__ __forceinline__ void operator()(const f32x4 (&acc)[2][2][4][2], const Unit& u, int wr, int wc, int fr, int fq) const {
        const int row0 = u.pm * 256 + wr * 64 + fr, pn = u.pn, c8 = wc * 32 + 8 * fq;
        bf16* O = (pn < 2) ? KN + pn * 256 : V + (pn - 2) * 256;
        float ssv[2][4];
#pragma unroll
        for (int ai = 0; ai < 2; ++ai)
#pragma unroll
            for (int m = 0; m < 4; ++m) ssv[ai][m] = sskv[row0 + ai * 128 + m * 16];
#pragma unroll
        for (int ai = 0; ai < 2; ++ai)
#pragma unroll
            for (int m = 0; m < 4; ++m) {
                const size_t row = (size_t)(row0 + ai * 128 + m * 16);
                const float rstd = __builtin_amdgcn_rsqf(ssv[ai][m] * (1.0f / 128.0f) + EPS);
#pragma unroll
                for (int bj = 0; bj < 2; ++bj) store8bf(O + row * 512 + bj * 128 + c8, acc[ai][bj][m][0] * rstd, acc[ai][bj][m][1] * rstd);
            }
    }
};
struct EpiRes {
    static constexpr bool PERM = false, AFTER_DRAIN = false;
    const float* xres; float* xout; const float* g; const float* sc; bf16* XS; float* ssn;
    __device__ __forceinline__ void operator()(const f32x4 (&acc)[2][2][4][2], const Unit& u, int wr, int wc, int fr, int fq) const {
        const int row0 = u.pm * 256 + wr * 64 + fr, b = u.pm >> 5, col0 = u.pn * 256 + wc * 32 + 4 * fq;
        f32x4 gv[2][2], scv[2][2];
#pragma unroll
        for (int bj = 0; bj < 2; ++bj)
#pragma unroll
            for (int n = 0; n < 2; ++n) { gv[bj][n] = *(const f32x4*)(g + b * NMOD + col0 + bj * 128 + n * 16);
                scv[bj][n] = sc ? *(const f32x4*)(sc + b * NMOD + col0 + bj * 128 + n * 16) + 1.0f : (f32x4){1.f, 1.f, 1.f, 1.f}; }
#pragma unroll
        for (int ai = 0; ai < 2; ++ai)
#pragma unroll
        for (int mp = 0; mp < 2; ++mp) {
            f32x4 pre[2][2][2];
#pragma unroll
            for (int mm = 0; mm < 2; ++mm)
#pragma unroll
                for (int bj = 0; bj < 2; ++bj)
#pragma unroll
                    for (int n = 0; n < 2; ++n) pre[mm][bj][n] = *(const f32x4*)(xres + (size_t)(row0 + ai * 128 + (2 * mp + mm) * 16) * 1024 + col0 + bj * 128 + n * 16);
#pragma unroll
            for (int mm = 0; mm < 2; ++mm) { const int m = 2 * mp + mm;
                const size_t row = (size_t)(row0 + ai * 128 + m * 16); float s = 0.f;
#pragma unroll
                for (int bj = 0; bj < 2; ++bj)
#pragma unroll
                    for (int n = 0; n < 2; ++n) { const size_t off = row * 1024 + col0 + bj * 128 + n * 16;
                        const f32x4 xv = pre[mm][bj][n] + gv[bj][n] * acc[ai][bj][m][n];
                        *(f32x4*)(xout + off) = xv; s += sumsq4(xv);
                        if (sc) { const f32x4 y = xv * scv[bj][n]; u32x2 w; w.x = cvt_pk_bf16(y[0], y[1]); w.y = cvt_pk_bf16(y[2], y[3]); *(u32x2*)(XS + off) = w; } }
                s += __shfl_xor(s, 16); s += __shfl_xor(s, 32);
                if (fq == 0) atomic_addf(ssn + row, s);
            }
        }
    }
};
struct EpiFfi {
    static constexpr bool PERM = true, AFTER_DRAIN = false;
    const float* ss; const float* shw; bf16* UU;
    __device__ __forceinline__ void operator()(const f32x4 (&acc)[2][2][4][2], const Unit& u, int wr, int wc, int fr, int fq) const {
        const int row0 = u.pm * 256 + wr * 64 + fr, b = u.pm >> 5, pn = u.pn, c8 = wc * 32 + 8 * fq;
        f32x4 sv[2][2];
#pragma unroll
        for (int bj = 0; bj < 2; ++bj)
#pragma unroll
            for (int n = 0; n < 2; ++n) sv[bj][n] = *(const f32x4*)(shw + b * (2 * DFF) + pn * 256 + bj * 128 + c8 + 4 * n);
        float ssv[2][4];
#pragma unroll
        for (int ai = 0; ai < 2; ++ai)
#pragma unroll
            for (int m = 0; m < 4; ++m) ssv[ai][m] = ss[row0 + ai * 128 + m * 16];
#pragma unroll
        for (int ai = 0; ai < 2; ++ai)
#pragma unroll
            for (int m = 0; m < 4; ++m) {
                const size_t row = (size_t)(row0 + ai * 128 + m * 16);
                const float rstd = __builtin_amdgcn_rsqf(ssv[ai][m] * (1.0f / 1024.0f) + EPS);
                f32x4 h[2];
#pragma unroll
                for (int n = 0; n < 2; ++n) { const f32x4 gt = acc[ai][0][m][n] * rstd + sv[0][n], up = acc[ai][1][m][n] * rstd + sv[1][n];
#pragma unroll
                    for (int j = 0; j < 4; ++j) h[n][j] = gt[j] * sigmoidf_(gt[j]) * up[j]; }
                store8bf(UU + row * DFF + pn * 128 + c8, h[0], h[1]);
            }
    }
};
#define XB_TMO      128
#define XB_XCNT(j)  (256  + 64 * (j))
#define XB_XSUB(j)  (1280 + 64 * (j))
#define XB_XGEN(j)  (2304 + 64 * (j))
#define XB_TOP      3328
#define XB_TOPGEN   3392
#define XCD_BAR_WORDS 3456
#define XB_SPIN_CAP (1u << 18)

__device__ __forceinline__ unsigned xb_ld(unsigned* p)              { return __hip_atomic_load(p, __ATOMIC_RELAXED, __HIP_MEMORY_SCOPE_AGENT); }
__device__ __forceinline__ unsigned xb_add(unsigned* p, unsigned v) { return __hip_atomic_fetch_add(p, v, __ATOMIC_RELAXED, __HIP_MEMORY_SCOPE_AGENT); }
__device__ __forceinline__ unsigned xb_xcc_id() { return (unsigned)__builtin_amdgcn_s_getreg((3 << 11) | 20) & 0xFu; }
#define XB_SPIN(cond, bar) do { unsigned _sp = 0; while (cond) { __builtin_amdgcn_s_sleep(1); \
    if ((++_sp & 255u) == 0u) { if (xb_ld(&(bar)[XB_TMO])) break; if (_sp > XB_SPIN_CAP) { atomicAdd(&(bar)[XB_TMO], 1u); break; } } } } while (0)

struct XcdBarrier {
    unsigned* bar; unsigned x;
    volatile LAS unsigned* st;
};

__device__ __forceinline__ XcdBarrier xcd_barrier_post(unsigned* bar, volatile LAS unsigned* st) {
    XcdBarrier b; b.bar = bar; b.x = xb_xcc_id(); b.st = st;
    if (threadIdx.x == 0) (void)xb_add(&bar[XB_XCNT(b.x)], 1u);
    return b;
}
__device__ __forceinline__ void xcd_barrier_complete(unsigned* bar, unsigned x, unsigned& nloc, unsigned& nx) {
    const unsigned G = gridDim.x * gridDim.y * gridDim.z;
    unsigned sum, cnt, mine, sp = 0u;
    for (;;) {
        sum = 0u; cnt = 0u; mine = 0u;
#pragma unroll
        for (unsigned j = 0; j < 16; ++j) { const unsigned c = xb_ld(&bar[XB_XCNT(j)]); sum += c; cnt += (c > 0u) ? 1u : 0u; mine = (j == x) ? c : mine; }
        if (sum == G) break;
        __builtin_amdgcn_s_sleep(1);
        if ((++sp & 255u) == 0u) { if (xb_ld(&bar[XB_TMO])) break; if (sp > XB_SPIN_CAP) { atomicAdd(&bar[XB_TMO], 1u); break; } }
    }
    nloc = mine > 0u ? mine : 1u; nx = cnt > 0u ? cnt : 1u;
}

__device__ __forceinline__ void xcd_barrier(const XcdBarrier& b) {
    asm volatile("s_waitcnt vmcnt(0)" ::: "memory");
    __syncthreads();
    if (threadIdx.x == 0) {
        unsigned* bar = b.bar;
        __builtin_amdgcn_s_waitcnt(0);
        unsigned nloc = b.st[0], nx = b.st[1];
        if (nloc == 0u) { xcd_barrier_complete(bar, b.x, nloc, nx); b.st[0] = nloc; b.st[1] = nx; }
        const unsigned old = xb_add(&bar[XB_XSUB(b.x)], 1u);
        const unsigned gen = old / nloc;
        if (old + 1u == (gen + 1u) * nloc) {
            __builtin_amdgcn_fence(__ATOMIC_RELEASE, "agent");
            asm volatile("s_waitcnt vmcnt(0)" ::: "memory");
            const unsigned og = xb_add(&bar[XB_TOP], 1u);
            const unsigned tg = og / nx;
            if (og + 1u == (tg + 1u) * nx) xb_add(&bar[XB_TOPGEN], 1u);
            else XB_SPIN(xb_ld(&bar[XB_TOPGEN]) == tg, bar);
            __builtin_amdgcn_fence(__ATOMIC_ACQUIRE, "agent");
            xb_add(&bar[XB_XGEN(b.x)], 1u);
            asm volatile("s_waitcnt vmcnt(0)" ::: "memory");
        } else {
            XB_SPIN(xb_ld(&bar[XB_XGEN(b.x)]) == gen, bar);
            __builtin_amdgcn_fence(__ATOMIC_ACQUIRE, "agent");
            asm volatile("s_waitcnt vmcnt(0)" ::: "memory");
        }
    }
    __syncthreads();
}
__device__ __forceinline__ int map_col(int id, int n) {
    switch (id) {
        case 0: return n < 1472 ? n : (n < 1536 ? -1 : n - 64);
        case 2: { const int pn = n >> 8, w = n & 255; return w < 128 ? pn * 128 + w : DFF + pn * 128 + (w - 128); }
        case 3: { const int hh = n / 768; int r = n % 768;
                  if (r < 512) return (4 * hh + (r >> 7)) * 192 + (r & 127);
                  r -= 512; const int e = r & 63; return (4 * hh + (r >> 6)) * 192 + 128 + (e >> 1) + 32 * (e & 1); }
        case 4: { const int hh = n >> 10; int r = n & 1023;
                  if (r < 512) return (4 * hh + (r >> 7)) * 256 + (r & 127);
                  r -= 512; return (4 * hh + (r >> 7)) * 256 + 128 + (r & 127); }
        default: return n;
    }
}
__device__ __forceinline__ void transpose_item(const float* W, int ldw, int K, bf16* WT, int id, const float* kscale, int nblk, int item, LAS float* scr, int lane) {
    const int kb = item / nblk, nb = item % nblk, k0 = 64 * kb, n0 = 32 * nb;
    const int sc = map_col(id, n0 + (lane & 31));
#pragma unroll 16
    for (int i = 0; i < 32; ++i) { const int kk = 2 * i + (lane >> 5); float v = sc >= 0 ? W[(size_t)(k0 + kk) * ldw + sc] : 0.f; if (kscale) v *= kscale[k0 + kk]; scr[kk * 33 + (lane & 31)] = v; }
    LDS_WAIT(); asm volatile("" ::: "memory");
    const int c = lane & 7;
#pragma unroll
    for (int j = 0; j < 4; ++j) { const int n = (lane >> 3) + 8 * j; const LAS float* s = scr + (8 * c) * 33 + n;
        u32x4 o; o.x = cvt_pk_bf16(s[0 * 33], s[1 * 33]); o.y = cvt_pk_bf16(s[2 * 33], s[3 * 33]); o.z = cvt_pk_bf16(s[4 * 33], s[5 * 33]); o.w = cvt_pk_bf16(s[6 * 33], s[7 * 33]);
        *(u32x4*)(WT + (size_t)(n0 + n) * K + k0 + 8 * c) = o; }
    LDS_WAIT(); asm volatile("" ::: "memory");
}
#define OPAQUE_TID() int tid_ = threadIdx.x; asm volatile("" : "+v"(tid_)); const int lane = tid_ & 63, wave = __builtin_amdgcn_readfirstlane(tid_ >> 6), NGW = gridDim.x * 8, gw = blockIdx.x * 8 + wave; (void)lane; (void)wave; (void)NGW; (void)gw
__device__ __forceinline__ void phase0(const Args& a, LAS unsigned char* lds) {
    OPAQUE_TID();
    LAS float* scr = (LAS float*)(lds + wave * 16384);
    float* mod = (float*)(a.ws + WS_MOD);
    for (int it = blockIdx.x; it < DEPTH * (NMOD / 64); it += gridDim.x) {
        const int l = it / (NMOD / 64), n = (it % (NMOD / 64)) * 64 + lane;
        float a0 = 0.f, a1 = 0.f, a2 = 0.f, a3 = 0.f;
        const float* w = a.w_ada + (size_t)l * DM * NMOD + (size_t)(wave * 128) * NMOD + n; const float* cc = a.c + wave * 128;
#pragma unroll 16
        for (int k = 0; k < 128; ++k) { const float wv = w[(size_t)k * NMOD]; a0 += cc[k] * wv; a1 += cc[DM + k] * wv; a2 += cc[2 * DM + k] * wv; a3 += cc[3 * DM + k] * wv; }
        LAS float* red = (LAS float*)(lds + 73728);
        red[(wave * 4 + 0) * 64 + lane] = a0; red[(wave * 4 + 1) * 64 + lane] = a1; red[(wave * 4 + 2) * 64 + lane] = a2; red[(wave * 4 + 3) * 64 + lane] = a3;
        __syncthreads();
        if (wave < 4) { float s = a.b_ada[l * NMOD + n];
#pragma unroll
            for (int q = 0; q < 8; ++q) s += red[(q * 4 + wave) * 64 + lane];
            mod[(l * 4 + wave) * NMOD + n] = s; }
        __syncthreads();
    }
    constexpr int I_IN = 16 * (DINP / 32), I_OUT = 16 * 32, I_FFI = 16 * (2 * DFF / 32), I_FFO = (DFF / 64) * 32, I_UQ = 4 * 48, I_UKV = 2 * 64, I_LRU = 16 * 8;
    constexpr int I_L = I_IN + I_OUT + I_FFI + I_FFO + I_UQ + I_UKV + I_LRU;
    for (int it = gw; it < DEPTH * I_L; it += NGW) {
        const int l = it / I_L; int r = it % I_L; unsigned char* wl = a.ws + WS_W + (size_t)l * WL_STRIDE;
        if (r < I_IN) { transpose_item(a.w_in + (size_t)l * DM * 3520, 3520, DM, (bf16*)(wl + WL_IN), 0, nullptr, DINP / 32, r, scr, lane); continue; } r -= I_IN;
        if (r < I_OUT) { transpose_item(a.w_out + (size_t)l * DM * DM, DM, DM, (bf16*)(wl + WL_OUT), 1, nullptr, 32, r, scr, lane); continue; } r -= I_OUT;
        if (r < I_FFI) { transpose_item(a.w_ffi + (size_t)l * DM * 2 * DFF, 2 * DFF, DM, (bf16*)(wl + WL_FFI), 2, nullptr, 2 * DFF / 32, r, scr, lane); continue; } r -= I_FFI;
        if (r < I_FFO) { transpose_item(a.w_ffo + (size_t)l * DFF * DM, DM, DFF, (bf16*)(wl + WL_FFO), 1, nullptr, 32, r, scr, lane); continue; } r -= I_FFO;
        if (r < I_UQ) { transpose_item(a.w_uq + (size_t)l * 256 * 1536, 1536, 256, (bf16*)(wl + WL_UQ), 3, a.qg + l * 256, 48, r, scr, lane); continue; } r -= I_UQ;
        if (r < I_UKV) { transpose_item(a.w_ukv + (size_t)l * 128 * 2048, 2048, 128, (bf16*)(wl + WL_UKV), 4, a.kvg + l * 128, 64, r, scr, lane); continue; } r -= I_UKV;
        { const int mtx = r >> 3, nb = mtx >> 1, which = mtx & 1;
          const float* src = (which ? a.lru_wx : a.lru_wa) + (size_t)l * 8 * 16384 + (size_t)nb * 16384;
          transpose_item(src, 128, 128, (bf16*)(wl + WL_LRU) + (size_t)(nb * 256 + which * 128) * 128, 1, nullptr, 4, r & 7, scr, lane); }
    }
    f32x2* cs = (f32x2*)(a.ws + WS_CS);
    for (int e = gw * 64 + lane; e < T * 32; e += NGW * 64) {
        const int t = e >> 5, i = e & 31;
        const float ang = (float)a.pos[t] * INV_FREQ[i];
        const double q = rint((double)ang * 0.15915494309189535);
        const float rr = (float)((double)ang - q * 6.283185307179586);
        cs[e] = (f32x2){__cosf(rr), __sinf(rr)};
    }
}
__device__ __forceinline__ void phase1(const Args& a) {
    OPAQUE_TID();
    const float* mod = (const float*)(a.ws + WS_MOD);
    float* ss = (float*)(a.ws + WS_SS); bf16* XS = (bf16*)(a.ws + WS_XS);
    for (int row0 = gw; row0 < T; row0 += 4 * NGW) {
        f32x4 v[4][4]; float s[4];
#pragma unroll
        for (int q = 0; q < 4; ++q) { const int row = row0 + q * NGW; const f32x4* xr = (const f32x4*)(a.x + (size_t)row * DM) + lane; s[q] = 0.f;
#pragma unroll
            for (int j = 0; j < 4; ++j) { v[q][j] = xr[64 * j]; } }
#pragma unroll
        for (int q = 0; q < 4; ++q) { const int row = row0 + q * NGW, b = row >> 13; const f32x4* scp = (const f32x4*)(mod + b * NMOD + 1024) + lane;
#pragma unroll
            for (int j = 0; j < 4; ++j) s[q] += sumsq4(v[q][j]);
            s[q] = wave_sum(s[q]);
            u32x2* o = (u32x2*)(XS + (size_t)row * DM) + lane;
#pragma unroll
            for (int j = 0; j < 4; ++j) { const f32x4 y = v[q][j] * (scp[64 * j] + 1.0f); u32x2 w; w.x = cvt_pk_bf16(y[0], y[1]); w.y = cvt_pk_bf16(y[2], y[3]); o[64 * j] = w; }
            if (lane == 0) ss[row] = s[q];
            if (lane >= 1 && lane <= 8) ss[(size_t)lane * T + row] = 0.f; }
    }
    constexpr int NI = DINP + 2 * DFF;
    for (int it = gw; it < DEPTH * NI; it += NGW) {
        const int l = it / NI; int n = it % NI; const bool isf = n >= DINP; if (isf) n -= DINP;
        const bf16* wrow = (const bf16*)(a.ws + WS_W + (size_t)l * WL_STRIDE + (isf ? WL_FFI : WL_IN)) + (size_t)n * DM;
        const float* sh = mod + (size_t)l * 4 * NMOD + (isf ? 3072 : 0);
        float s0 = 0.f, s1 = 0.f, s2 = 0.f, s3 = 0.f;
#pragma unroll
        for (int h = 0; h < 2; ++h) { const int k0 = h * 512 + lane * 8; const bf16x8 wv = *(const bf16x8*)(wrow + k0);
#pragma unroll
            for (int j = 0; j < 8; ++j) { const float w = bf2f((bf16)wv[j]); s0 += w * sh[k0 + j]; s1 += w * sh[NMOD + k0 + j]; s2 += w * sh[2 * NMOD + k0 + j]; s3 += w * sh[3 * NMOD + k0 + j]; } }
        s0 = wave_sum(s0); s1 = wave_sum(s1); s2 = wave_sum(s2); s3 = wave_sum(s3);
        if (lane == 0) { float* o = (float*)(a.ws + (isf ? WS_SHWF : WS_SHWIN)) + (size_t)l * 4 * (isf ? 2 * DFF : DINP) + n; const int st = isf ? 2 * DFF : DINP; o[0] = s0; o[st] = s1; o[2 * st] = s2; o[3 * st] = s3; }
    }
}
__device__ __forceinline__ void lru_phase(const Args& a, int l, char* lds, bool dummy = false) {
    int tid_ = threadIdx.x; asm volatile("" : "+v"(tid_));
    const int tid = tid_, lane = tid & 63, wave = tid >> 6, fq = lane >> 4, fc = lane & 15;
    const bf16* XL = (const bf16*)(a.ws + WS_XL); bf16* SGA = (bf16*)(a.ws + WS_SGA); bf16* WC = (bf16*)(a.ws + WS_XS);
    float* sumP = (float*)(a.ws + WS_SUMP); float* sumH = (float*)(a.ws + WS_SUMH);
    const bf16* Wl = (const bf16*)(a.ws + WS_W + (size_t)l * WL_STRIDE + WL_LRU);
    const float* cw = a.conv_w + (size_t)l * 4 * DM; const float* cb = a.conv_b + (size_t)l * DM;
    constexpr int PITCH = 272, TILE = 128 * PITCH, OFF_SG = TILE, OFF_WC = 2 * TILE, OFF_PF = 3 * TILE;
    const int cgp = tid & 15, rr = tid >> 4;
    f32x4 w[4][2], bb[2]; bf16x8 bwa[4], bwx[4]; float ba = 0.f, bx = 0.f, c8 = 0.f; int nb_cur = -1;
    for (int unit = blockIdx.x; unit < (T / 128) * 8; unit += gridDim.x) {
        const int chunk = unit >> 3, nb = unit & 7, t0 = chunk * 128; const bool first = (t0 & (SEQ - 1)) == 0;
        const int ch = nb * 128 + cgp * 8;
        if (nb != nb_cur) { nb_cur = nb;
#pragma unroll
            for (int j = 0; j < 4; ++j) { w[j][0] = *(const f32x4*)(cw + j * DM + ch); w[j][1] = *(const f32x4*)(cw + j * DM + ch + 4); }
            bb[0] = *(const f32x4*)(cb + ch); bb[1] = *(const f32x4*)(cb + ch + 4);
            const bf16* wr_ = Wl + (size_t)(nb * 256 + 16 * wave + fc) * 128 + fq * 8;
#pragma unroll
            for (int ks = 0; ks < 4; ++ks) { bwa[ks] = *(const bf16x8*)(wr_ + ks * 32); bwx[ks] = *(const bf16x8*)(wr_ + 128 * 128 + ks * 32); }
            const int c_ = nb * 128 + 16 * wave + fc;
            ba = a.lru_ba[l * DM + c_]; bx = a.lru_bx[l * DM + c_]; c8 = -8.0f * log1pf(__expf(-a.lru_a[l * DM + c_])); }
        {
            bf16x8 sgv[4], xv[4][4];
#pragma unroll
            for (int p = 0; p < 4; ++p) sgv[p] = *(const bf16x8*)(SGA + (size_t)(t0 + p * 32 + rr) * DM + ch);
            int pf = 0; if (tid < 128) pf = a.pos[t0 + tid];
#pragma unroll
            for (int p = 0; p < 4; ++p)
#pragma unroll
                for (int j = 0; j < 4; ++j) { const int rj = p * 32 + rr - 3 + j;
                    xv[p][j] = (first && rj < 0) ? (bf16x8){0, 0, 0, 0, 0, 0, 0, 0} : *(const bf16x8*)(XL + (size_t)(t0 + rj) * DM + ch); }
            __syncthreads();
#pragma unroll
            for (int p = 0; p < 4; ++p) { const int row = p * 32 + rr; f32x4 o0 = bb[0], o1 = bb[1];
#pragma unroll
                for (int j = 0; j < 4; ++j) {
#pragma unroll
                    for (int e = 0; e < 4; ++e) { o0[e] += w[j][0][e] * bf2f((bf16)xv[p][j][e]); o1[e] += w[j][1][e] * bf2f((bf16)xv[p][j][4 + e]); } }
                u32x4 pk; pk.x = cvt_pk_bf16(o0[0], o0[1]); pk.y = cvt_pk_bf16(o0[2], o0[3]); pk.z = cvt_pk_bf16(o1[0], o1[1]); pk.w = cvt_pk_bf16(o1[2], o1[3]);
                *(u32x4*)(lds + row * PITCH + cgp * 16) = pk; }
#pragma unroll
            for (int p = 0; p < 4; ++p) *(bf16x8*)(lds + OFF_SG + (p * 32 + rr) * PITCH + cgp * 16) = sgv[p];
            if (tid < 128) *(int*)(lds + OFF_PF + tid * 4) = pf;
        }
        __syncthreads();
        f32x4 accA[8], accX[8];
        {
#pragma unroll
            for (int m = 0; m < 8; ++m) { accA[m] = (f32x4){0.f, 0.f, 0.f, 0.f}; accX[m] = (f32x4){0.f, 0.f, 0.f, 0.f};
#pragma unroll
                for (int ks = 0; ks < 4; ++ks) { const bf16x8 av = *(const bf16x8*)(lds + (16 * m + fc) * PITCH + ks * 64 + fq * 16);
                    accA[m] = __builtin_amdgcn_mfma_f32_16x16x32_bf16(av, bwa[ks], accA[m], 0, 0, 0);
                    accX[m] = __builtin_amdgcn_mfma_f32_16x16x32_bf16(av, bwx[ks], accX[m], 0, 0, 0); } }
        }
        const int cl = 16 * wave + fc, c = nb * 128 + cl;
        float Pm = 1.f, Hm = 0.f;
#pragma unroll
        for (int m = 0; m < 8; ++m) {
            float P[4], Hh[4], sg[4];
#pragma unroll
            for (int j = 0; j < 4; ++j) { const int tl = 16 * m + 4 * fq + j;
                const float r = sigmoidf_(accA[m][j] + ba), ig = sigmoidf_(accX[m][j] + bx);
                const float la = c8 * r, x2 = 2.0f * la;
                float av = __expf(la);
                float om = (x2 > -0.1f) ? -(x2 * (1.0f + x2 * (0.5f + x2 * (0.16666667f + x2 * 0.041666668f)))) : 1.0f - __expf(x2);
                float mult = __builtin_amdgcn_sqrtf(om);
                if (*(const int*)(lds + OFF_PF + tl * 4) == 0) { av = 0.f; mult = 1.f; }
                const float xc = bf2f(*(const bf16*)(lds + tl * PITCH + cl * 2));
                const float bv = xc * ig * mult;
                sg[j] = bf2f(*(const bf16*)(lds + OFF_SG + tl * PITCH + cl * 2));
                if (j == 0) { P[0] = av; Hh[0] = bv; } else { P[j] = P[j - 1] * av; Hh[j] = av * Hh[j - 1] + bv; } }
            float Pa = P[3], Ha = Hh[3];
            { const float Pp = __shfl_up(Pa, 16), Hp = __shfl_up(Ha, 16); if (fq >= 1) { Ha = Pa * Hp + Ha; Pa = Pp * Pa; } }
            { const float Pp = __shfl_up(Pa, 32), Hp = __shfl_up(Ha, 32); if (fq >= 2) { Ha = Pa * Hp + Ha; Pa = Pp * Pa; } }
            float Pex = __shfl_up(Pa, 16), Hex = __shfl_up(Ha, 16); if (fq == 0) { Pex = 1.f; Hex = 0.f; }
            const float Pt = __shfl(Pa, 48 + fc), Ht = __shfl(Ha, 48 + fc);
            const float Pin = Pm * Pex, Hin = Pex * Hm + Hex;
#pragma unroll
            for (int j = 0; j < 4; ++j) { const int tl = 16 * m + 4 * fq + j;
                const float cp = P[j] * Pin, hl = Hh[j] + P[j] * Hin;
                const unsigned pk = cvt_pk_bf16(sg[j] * hl, sg[j] * cp);
                *(bf16*)(lds + OFF_SG + tl * PITCH + cl * 2) = (bf16)(pk & 0xffffu); *(bf16*)(lds + OFF_WC + tl * PITCH + cl * 2) = (bf16)(pk >> 16); }
            Hm = Pt * Hm + Ht; Pm = Pm * Pt;
        }
        if (fq == 0) { sumP[(size_t)chunk * DM + c] = Pm; sumH[(size_t)chunk * DM + c] = Hm; }
        __syncthreads();
#pragma unroll
        for (int p = 0; p < 4; ++p) { const int row = p * 32 + rr; const size_t gi = (size_t)(t0 + row) * DM + ch;
            *(bf16x8*)((dummy ? (bf16*)a.out : SGA) + gi) = *(const bf16x8*)(lds + OFF_SG + row * PITCH + cgp * 16);
            *(bf16x8*)((dummy ? (bf16*)a.out + (size_t)T * DM : WC) + gi) = *(const bf16x8*)(lds + OFF_WC + row * PITCH + cgp * 16); }
    }
    __syncthreads();
}
__device__ __forceinline__ void krope_phase(const Args& a) {
    const float* KROPE = (const float*)(a.ws + WS_KROPE); unsigned* KR = (unsigned*)(a.ws + WS_KR); const f32x2* cs = (const f32x2*)(a.ws + WS_CS);
    int tid_ = threadIdx.x; asm volatile("" : "+v"(tid_));
    for (int e = blockIdx.x * 512 + tid_; e < T * 32; e += gridDim.x * 512) {
        const int t = e >> 5, i = e & 31; const float x1 = KROPE[t * 64 + i], x2 = KROPE[t * 64 + 32 + i]; const f32x2 v = cs[e];
        KR[e] = cvt_pk_bf16(x1 * v.x - x2 * v.y, x2 * v.x + x1 * v.y);
    }
}
__device__ __forceinline__ void final_phase(const Args& a) {
    OPAQUE_TID();
    for (int row0 = gw; row0 < T; row0 += 2 * NGW) {
        f32x4 v[2][4];
#pragma unroll
        for (int q = 0; q < 2; ++q) { const f32x4* xr = (const f32x4*)(a.out + (size_t)(row0 + q * NGW) * DM) + lane;
#pragma unroll
            for (int j = 0; j < 4; ++j) v[q][j] = xr[64 * j]; }
#pragma unroll
        for (int q = 0; q < 2; ++q) { float s = 0.f;
#pragma unroll
            for (int j = 0; j < 4; ++j) s += sumsq4(v[q][j]);
            const float rstd = __builtin_amdgcn_rsqf(wave_sum(s) * (1.0f / 1024.0f) + EPS);
            f32x4* xr = (f32x4*)(a.out + (size_t)(row0 + q * NGW) * DM) + lane; const f32x4* g = (const f32x4*)a.fg + lane;
#pragma unroll
            for (int j = 0; j < 4; ++j) xr[64 * j] = v[q][j] * rstd * g[64 * j]; }
    }
}
namespace att {
constexpr int KVBLK = 64, QB = 256;
constexpr int KP = 272, RP = 144;
constexpr int SHM_V = 16384, SHM_K = 64 * KP, SHM_R = 64 * RP;
constexpr int OFF_V = 0, OFF_K = 3 * SHM_V, OFF_R = OFF_K + 2 * SHM_K, OFF_QR = OFF_R + 2 * SHM_R  , OFF_WS = OFF_QR + 32768, OFF_CARRY = OFF_WS + 2048, ATT_LDS = OFF_CARRY + 1024;
static_assert(OFF_WS >= 131072 && ATT_LDS <= LDS_XB, "attention LDS map");
constexpr float SCALE = 0.07216878364870322f;
constexpr float THR = 8.f;
#define SBAR() __builtin_amdgcn_sched_barrier(0)
__device__ __forceinline__ int v_st(int k, int c) { const int kk = (k & ~0xC) | ((k & 4) << 1) | ((k & 8) >> 1); return ((kk >> 3) * 4 + (c >> 5)) * 512 + ((kk & 7) * 32 + (c & 31)) * 2; }
__device__ __forceinline__ int v_rd_base(int lane) { return ((lane & 3) << 3) | (((lane >> 2) & 3) << 6) | (((lane >> 4) & 1) << 5) | (((lane >> 5) & 1) << 8); }
constexpr int v_rd_off(int d0, int ks, int half) { return d0 * 512 + ks * 4096 + half * 2048; }
__device__ __forceinline__ int crow(int r, int hi) { return (r & 3) + 8 * (r >> 2) + 4 * hi; }
__device__ __forceinline__ unsigned cvtpk(float lo, float hi) { return pg8::cvt_pk_bf16(lo, hi); }
__device__ __forceinline__ void mask_tile(f32x16& p0, f32x16& p1, int dq) {
    const float NEG = -__builtin_inff();
#pragma unroll
    for (int r = 0; r < 16; ++r) { const int c = (r & 3) + 8 * (r >> 2);
        if (dq - c < 0) p0[r] = NEG;
        if (dq - c - 32 < 0) p1[r] = NEG; }
}
__device__ __forceinline__ void partialSM(f32x16& p0, f32x16& p1, float& m_reg, float& mn, float& alpha) {
    float pmax = p0[0];
#pragma unroll
    for (int r = 1; r < 16; ++r) pmax = fmaxf(pmax, p0[r]);
#pragma unroll
    for (int r = 0; r < 16; ++r) pmax = fmaxf(pmax, p1[r]);
    { auto rr = __builtin_amdgcn_permlane32_swap(__float_as_uint(pmax), __float_as_uint(pmax), false, false);
      pmax = fmaxf(__uint_as_float(rr[0]), __uint_as_float(rr[1])); }
    constexpr float C2 = 1.4426950408889634f * SCALE;
    if (__builtin_expect(__all((pmax - m_reg) * SCALE <= THR), 1)) { mn = m_reg; alpha = 1.f; }
    else { mn = fmaxf(m_reg, pmax); alpha = __builtin_amdgcn_exp2f((m_reg - mn) * C2); m_reg = mn; }
    const float mnL = -mn * C2;
#pragma unroll
    for (int r = 0; r < 16; ++r) p0[r] = fmaf(p0[r], C2, mnL);
#pragma unroll
    for (int r = 0; r < 16; ++r) p1[r] = fmaf(p1[r], C2, mnL);
#pragma unroll
    for (int r = 0; r < 16; ++r) p0[r] = __builtin_amdgcn_exp2f(p0[r]);
}
__device__ __forceinline__ void finishSM(f32x16& p0, f32x16& p1, float alpha, float& l_reg, bf16x8& pa0, bf16x8& pa1, bf16x8& pa2, bf16x8& pa3) {
#pragma unroll
    for (int r = 0; r < 16; ++r) p1[r] = __builtin_amdgcn_exp2f(p1[r]);
    float ps = 0;
#pragma unroll
    for (int r = 0; r < 16; ++r) ps += p0[r];
#pragma unroll
    for (int r = 0; r < 16; ++r) ps += p1[r];
    { auto rr = __builtin_amdgcn_permlane32_swap(__float_as_uint(ps), __float_as_uint(ps), false, false);
      ps = __uint_as_float(rr[0]) + __uint_as_float(rr[1]); }
    l_reg = l_reg * alpha + ps;
#define PK4(P, B_, OUT) do { unsigned a0 = cvtpk(P[B_+0], P[B_+1]), a1 = cvtpk(P[B_+2], P[B_+3]);                          \
        unsigned b0 = cvtpk(P[B_+4], P[B_+5]), b1 = cvtpk(P[B_+6], P[B_+7]);                                             \
        auto r0 = __builtin_amdgcn_permlane32_swap(a0, b0, false, false); auto r1 = __builtin_amdgcn_permlane32_swap(a1, b1, false, false); \
        u32x4 w = {r0[0], r1[0], r0[1], r1[1]}; OUT = *reinterpret_cast<bf16x8*>(&w); } while (0)
    PK4(p0, 0, pa0); PK4(p0, 8, pa1); PK4(p1, 0, pa2); PK4(p1, 8, pa3);
#undef PK4
}
template <int KB>
__device__ __forceinline__ void qkt(f32x16& p0, f32x16& p1, const char* lds, int r32, int hi, const bf16x8* qn, const char* qrr) {
    p0 = f32x16{}; p1 = f32x16{};
    bf16x8 qr[4];
#pragma unroll
    for (int d0 = 0; d0 < 4; ++d0) qr[d0] = *(const bf16x8*)(qrr + d0 * 1024);
    const char* ka = lds + OFF_K + KB * SHM_K + r32 * KP + hi * 16;
#pragma unroll
    for (int d0 = 0; d0 < 8; ++d0) {
        bf16x8 b0 = *reinterpret_cast<const bf16x8*>(ka + d0 * 32);
        bf16x8 b1 = *reinterpret_cast<const bf16x8*>(ka + d0 * 32 + 32 * KP);
        p0 = __builtin_amdgcn_mfma_f32_32x32x16_bf16(b0, qn[d0], p0, 0, 0, 0);
        p1 = __builtin_amdgcn_mfma_f32_32x32x16_bf16(b1, qn[d0], p1, 0, 0, 0); }
    const char* ra = lds + OFF_R + KB * SHM_R + r32 * RP + hi * 16;
#pragma unroll
    for (int d0 = 0; d0 < 4; ++d0) {
        bf16x8 b0 = *reinterpret_cast<const bf16x8*>(ra + d0 * 32);
        bf16x8 b1 = *reinterpret_cast<const bf16x8*>(ra + d0 * 32 + 32 * RP);
        p0 = __builtin_amdgcn_mfma_f32_32x32x16_bf16(b0, qr[d0], p0, 0, 0, 0);
        p1 = __builtin_amdgcn_mfma_f32_32x32x16_bf16(b1, qr[d0], p1, 0, 0, 0); }
}
template <int KB>
__device__ __forceinline__ void qkt_fin(f32x16& p0, f32x16& p1, f32x16& y0, f32x16& y1, float alpha, float& l_reg, bf16x8& pa0, bf16x8& pa1, bf16x8& pa2, bf16x8& pa3,
                                        const char* lds, int r32, int hi, const bf16x8* qn, const char* qrr) {
    p0 = f32x16{}; p1 = f32x16{};
    const char* ka = lds + OFF_K + KB * SHM_K + r32 * KP + hi * 16;
    const char* ra = lds + OFF_R + KB * SHM_R + r32 * RP + hi * 16;
#define QK_LD(i, X0, X1) do { if ((i) < 8) { X0 = *reinterpret_cast<const bf16x8*>(ka + (i) * 32); X1 = *reinterpret_cast<const bf16x8*>(ka + (i) * 32 + 32 * KP); } \
                              else { X0 = *reinterpret_cast<const bf16x8*>(ra + ((i) - 8) * 32); X1 = *reinterpret_cast<const bf16x8*>(ra + ((i) - 8) * 32 + 32 * RP); \
                                     Q##X0 = *(const bf16x8*)(qrr + ((i) - 8) * 1024); } } while (0)
#define QK_MM(i, X0, X1) do { const bf16x8 q_ = (i) < 8 ? qn[(i) < 8 ? (i) : 0] : Q##X0; \
        p0 = __builtin_amdgcn_mfma_f32_32x32x16_bf16(X0, q_, p0, 0, 0, 0); p1 = __builtin_amdgcn_mfma_f32_32x32x16_bf16(X1, q_, p1, 0, 0, 0); } while (0)
#define QK_PK4(P, B_, OUT) do { unsigned a0_ = cvtpk(P[B_+0], P[B_+1]), a1_ = cvtpk(P[B_+2], P[B_+3]); unsigned b0_ = cvtpk(P[B_+4], P[B_+5]), b1_ = cvtpk(P[B_+6], P[B_+7]); \
        auto r0_ = __builtin_amdgcn_permlane32_swap(a0_, b0_, false, false); auto r1_ = __builtin_amdgcn_permlane32_swap(a1_, b1_, false, false); \
        u32x4 w_ = {r0_[0], r1_[0], r0_[1], r1_[1]}; OUT = *reinterpret_cast<bf16x8*>(&w_); } while (0)
    bf16x8 A0, A1, B0, B1, C0, C1, QA0, QB0, QC0; float ps = 0.f;
    QK_LD(0, A0, A1); QK_LD(1, B0, B1); SBAR();
    QK_LD(2, C0, C1); QK_MM(0, A0, A1);
#pragma unroll
    for (int r = 0; r < 4; ++r) y1[r] = __builtin_amdgcn_exp2f(y1[r]);
    QK_PK4(y0, 0, pa0); SBAR();
    QK_LD(3, A0, A1); QK_MM(1, B0, B1);
#pragma unroll
    for (int r = 4; r < 8; ++r) y1[r] = __builtin_amdgcn_exp2f(y1[r]);
    QK_PK4(y0, 8, pa1); SBAR();
    QK_LD(4, B0, B1); QK_MM(2, C0, C1);
#pragma unroll
    for (int r = 8; r < 12; ++r) y1[r] = __builtin_amdgcn_exp2f(y1[r]);
#pragma unroll
    for (int r = 0; r < 8; ++r) ps += y0[r];
    SBAR();
    QK_LD(5, C0, C1); QK_MM(3, A0, A1);
#pragma unroll
    for (int r = 12; r < 16; ++r) y1[r] = __builtin_amdgcn_exp2f(y1[r]);
#pragma unroll
    for (int r = 8; r < 16; ++r) ps += y0[r];
    SBAR();
    QK_LD(6, A0, A1); QK_MM(4, B0, B1);
    QK_PK4(y1, 0, pa2);
#pragma unroll
    for (int r = 0; r < 8; ++r) ps += y1[r];
    SBAR();
    QK_LD(7, B0, B1); QK_MM(5, C0, C1);
    QK_PK4(y1, 8, pa3);
#pragma unroll
    for (int r = 8; r < 16; ++r) ps += y1[r];
    SBAR();
    QK_LD(8, C0, C1); QK_MM(6, A0, A1);
    { auto rr = __builtin_amdgcn_permlane32_swap(__float_as_uint(ps), __float_as_uint(ps), false, false); ps = __uint_as_float(rr[0]) + __uint_as_float(rr[1]); }
    l_reg = l_reg * alpha + ps;
    SBAR();
    QK_LD(9, A0, A1); QK_MM(7, B0, B1); SBAR();
    QK_LD(10, B0, B1); QK_MM(8, C0, C1); SBAR();
    QK_LD(11, C0, C1); QK_MM(9, A0, A1); SBAR();
    QK_MM(10, B0, B1); SBAR();
    QK_MM(11, C0, C1);
#undef QK_LD
#undef QK_MM
#undef QK_PK4
}
__device__ __forceinline__ void pv_tile(f32x16* o, int vb0, bf16x8 pa0, bf16x8 pa1, bf16x8 pa2, bf16x8 pa3) {
#define TRRD(dst, off) asm volatile("ds_read_b64_tr_b16 %0, %1 offset:%2" : "=&v"(dst) : "v"(vb0), "i"(off) : "memory")
#define PV_D0(d0) do { s16x4 l0, l1, l2, l3, h0, h1, h2, h3; constexpr int b_ = v_rd_off(d0, 0, 0); \
        TRRD(l0, b_); TRRD(h0, b_ + 2048); TRRD(l1, b_ + 4096); TRRD(h1, b_ + 6144); TRRD(l2, b_ + 8192); TRRD(h2, b_ + 10240); TRRD(l3, b_ + 12288); TRRD(h3, b_ + 14336); \
        asm volatile("s_waitcnt lgkmcnt(0)" ::: "memory"); SBAR();   \
        o[d0] = __builtin_amdgcn_mfma_f32_32x32x16_bf16(pa0, (bf16x8){l0[0], l0[1], l0[2], l0[3], h0[0], h0[1], h0[2], h0[3]}, o[d0], 0, 0, 0);   \
        o[d0] = __builtin_amdgcn_mfma_f32_32x32x16_bf16(pa1, (bf16x8){l1[0], l1[1], l1[2], l1[3], h1[0], h1[1], h1[2], h1[3]}, o[d0], 0, 0, 0);   \
        o[d0] = __builtin_amdgcn_mfma_f32_32x32x16_bf16(pa2, (bf16x8){l2[0], l2[1], l2[2], l2[3], h2[0], h2[1], h2[2], h2[3]}, o[d0], 0, 0, 0);   \
        o[d0] = __builtin_amdgcn_mfma_f32_32x32x16_bf16(pa3, (bf16x8){l3[0], l3[1], l3[2], l3[3], h3[0], h3[1], h3[2], h3[3]}, o[d0], 0, 0, 0); } while (0)
    PV_D0(0); PV_D0(1); PV_D0(2); PV_D0(3);
#undef PV_D0
#undef TRRD
}
__device__ __forceinline__ void attn_unit(int rb, int hh, int hl, int qb, unsigned char* wsb, char* lds, bool do_store = true) {
    const bf16* Qn = (const bf16*)(wsb + WS_QN); const bf16* Qr = (const bf16*)(wsb + WS_QR); const bf16* Kn = (const bf16*)(wsb + WS_KN); const bf16* Kr = (const bf16*)(wsb + WS_KR); const bf16* Vv = (const bf16*)(wsb + WS_V);
    int tid_ = threadIdx.x; asm volatile("" : "+v"(tid_));
    const int tid = tid_, wid = __builtin_amdgcn_readfirstlane(tid >> 6), lane = tid & 63, r32 = lane & 31, hi = lane >> 5;
    const int q0 = qb * QB, NT = (q0 + QB) / KVBLK;
    const int qlo = q0 + wid * 32, qm = qlo + r32 - 4 * hi;
    char* V_lds = lds + OFF_V; char* K_lds = lds + OFF_K; char* R_lds = lds + OFF_R;
    float* ws = (float*)(lds + OFF_WS) + wid * 64; float* li_l = ws; float* al_l = ws + 32;
    float* carry = (float*)(lds + OFF_CARRY);
    const int cb = (4 * hh + hl) * 128;
    const bf16* Kh = Kn + (size_t)rb * 512 + hl * 128; const bf16* Vh = Vv + (size_t)rb * 512 + hl * 128; const bf16* Rh = Kr + (size_t)rb * 64;
    const int sr = tid >> 4, sc = (tid & 15) * 8, vst0 = v_st(sr, sc), vst1 = v_st(32 + sr, sc), kws = sr * KP + sc * 2;
    const int rrow = tid >> 3, rc = (tid & 7) * 8, rws = rrow * RP + rc * 2;
    const int vb0 = (int)(uintptr_t)V_lds + v_rd_base(lane);
    bf16x8 st_v0, st_v1, st_k0, st_k1, st_r;
#define VMW() asm volatile("s_waitcnt vmcnt(0)" ::: "memory")
#define SLOAD(k0) do { st_v0 = *(const bf16x8*)(Vh + (size_t)((k0) + sr) * 512 + sc); st_v1 = *(const bf16x8*)(Vh + (size_t)((k0) + 32 + sr) * 512 + sc); \
                       st_k0 = *(const bf16x8*)(Kh + (size_t)((k0) + sr) * 512 + sc); st_k1 = *(const bf16x8*)(Kh + (size_t)((k0) + 32 + sr) * 512 + sc); \
                       st_r = *(const bf16x8*)(Rh + (size_t)((k0) + rrow) * 64 + rc); } while (0)
#define SWRITE(bf, vs) do { *(bf16x8*)(V_lds + (vs) + vst0) = st_v0; *(bf16x8*)(V_lds + (vs) + vst1) = st_v1; \
                        *(bf16x8*)(K_lds + (bf) * SHM_K + kws) = st_k0; *(bf16x8*)(K_lds + (bf) * SHM_K + kws + 32 * KP) = st_k1; \
                        *(bf16x8*)(R_lds + (bf) * SHM_R + rws) = st_r; } while (0)
    SLOAD(0);
    bf16x8 qn[8];
    const char* qrr = lds + OFF_QR + wid * 4096 + lane * 16;
    { const bf16* qg = Qr + (size_t)(rb + q0 + wid * 32 + r32) * 256 + hl * 64 + hi * 8;
#pragma unroll
      for (int d0 = 0; d0 < 4; ++d0) *(bf16x8*)(lds + OFF_QR + wid * 4096 + lane * 16 + d0 * 1024) = *(const bf16x8*)(qg + d0 * 16); }
    { const bf16* qrow = Qn + (size_t)(rb + q0 + wid * 32 + r32) * 512 + hl * 128 + hi * 8;
#pragma unroll
      for (int d0 = 0; d0 < 8; ++d0) qn[d0] = *(const bf16x8*)(qrow + d0 * 16); }
    if (tid < 256) { const int which = tid >> 7, c = tid & 127, kmax = qb * 2 + which; const size_t base = (size_t)(rb >> 7) * 1024 + cb + c;
        const float* sumP = (const float*)(wsb + WS_SUMP); const float* sumH = (const float*)(wsb + WS_SUMH);
        float H = 0.f;
        for (int j = 0; j < kmax; j += 8) { float hv[8], pw[8];
#pragma unroll
            for (int q = 0; q < 8; ++q) { const bool ok = j + q < kmax; hv[q] = ok ? sumH[base + (size_t)(j + q) * 1024] : 0.f; pw[q] = ok ? sumP[base + (size_t)(j + q) * 1024] : 1.f; }
#pragma unroll
            for (int q = 0; q < 8; ++q) H = hv[q] + pw[q] * H; }
        carry[which * 128 + c] = H; }
    VMW(); SWRITE(0, 0); SBAR();
    SLOAD(KVBLK);
    __syncthreads();
    float m_reg = -1e30f, l_reg = 0; f32x16 o[4] = {};
    f32x16 pA0, pA1, pB0, pB1; float mnA, mnB, alA, alB; bf16x8 pa0, pa1, pa2, pa3;
    int sl_prev = 0, sl_cur = 0, sl_next = SHM_V;
#define ROT() do { sl_prev = sl_cur; sl_cur = sl_next; sl_next = (sl_next == 2 * SHM_V) ? 0 : sl_next + SHM_V; } while (0)
#define RESC(a) do { if (__any((a) < 1.f)) { if (hi == 0) al_l[r32] = (a); asm volatile("s_waitcnt lgkmcnt(0)" ::: "memory");              \
                     for (int d_ = 0; d_ < 4; ++d_) for (int r = 0; r < 16; ++r) o[d_][r] *= al_l[crow(r, hi)]; } } while (0)
#define MASKT(P0_, P1_, t) do { const int kb_ = (t) * KVBLK; if (kb_ + KVBLK - 1 > qlo) mask_tile(P0_, P1_, qm - kb_); } while (0)
    SBAR(); qkt<0>(pA0, pA1, lds, r32, hi, qn, qrr);
    MASKT(pA0, pA1, 0); partialSM(pA0, pA1, m_reg, mnA, alA);
    VMW(); SWRITE(1, SHM_V);
    __syncthreads();
    ROT();
#define STEP(PX0, PX1, mnX, alX, PY0, PY1, alY, t, KB, LAST) do {                                                             \
        SBAR(); qkt_fin<KB>(PX0, PX1, PY0, PY1, alY, l_reg, pa0, pa1, pa2, pa3, lds, r32, hi, qn, qrr); SBAR();               \
        if (!(LAST)) { SLOAD(((t) + 1) * KVBLK); SBAR(); }                                                                    \
        pv_tile(o, vb0 + sl_prev, pa0, pa1, pa2, pa3); MASKT(PX0, PX1, (t)); partialSM(PX0, PX1, m_reg, mnX, alX);            \
        if (!(LAST)) { VMW(); SWRITE(1 - (KB), sl_next); }                                                                    \
        RESC(alX);                                                                                                            \
        if (!(LAST)) { __syncthreads(); ROT(); } } while (0)
    for (int t = 1; t + 1 < NT; t += 2) {
        STEP(pB0, pB1, mnB, alB, pA0, pA1, alA, t, 1, false);
        STEP(pA0, pA1, mnA, alA, pB0, pB1, alB, t + 1, 0, false);
    }
    STEP(pB0, pB1, mnB, alB, pA0, pA1, alA, NT - 1, 1, true);
    finishSM(pB0, pB1, alB, l_reg, pa0, pa1, pa2, pa3); SBAR(); pv_tile(o, vb0 + sl_cur, pa0, pa1, pa2, pa3);
    if (hi == 0) li_l[r32] = l_reg; asm volatile("s_waitcnt lgkmcnt(0)" ::: "memory");
    __syncthreads();
    {
        float* stg = (float*)lds + wid * 4096;
#pragma unroll
        for (int r = 0; r < 16; ++r) { const int orow = crow(r, hi); const float rl = __builtin_amdgcn_rcpf(li_l[orow]);
#pragma unroll
            for (int d0 = 0; d0 < 4; ++d0) stg[orow * 128 + d0 * 32 + r32] = o[d0][r] * rl; }
        asm volatile("s_waitcnt lgkmcnt(0)" ::: "memory");
        const float* cr = carry + (wid >> 2) * 128 + (lane & 15) * 8;
        const f32x4 h0 = *(const f32x4*)cr, h1 = *(const f32x4*)(cr + 4);
        const size_t gbase = (size_t)(rb + q0 + wid * 32 + (lane >> 4)) * DM + cb + (lane & 15) * 8;
        const bf16* U = (const bf16*)(wsb + WS_SGA) + gbase; const bf16* WC = (const bf16*)(wsb + WS_XS) + gbase; const bf16* SGB = (const bf16*)(wsb + WS_SGB) + gbase; bf16* Y = (bf16*)(wsb + WS_XL) + gbase;
        const float* sp = stg + (lane >> 4) * 128 + (lane & 15) * 8;
#pragma unroll 2
        for (int i = 0; i < 8; ++i) {
            const bf16x8 u = *(const bf16x8*)(U + (size_t)i * 4 * DM), w = *(const bf16x8*)(WC + (size_t)i * 4 * DM), g = *(const bf16x8*)(SGB + (size_t)i * 4 * DM);
            const f32x4 v0 = *(const f32x4*)(sp + i * 512), v1 = *(const f32x4*)(sp + i * 512 + 4);
            f32x4 y0, y1;
#pragma unroll
            for (int e = 0; e < 4; ++e) { y0[e] = bf2f((bf16)u[e]) + bf2f((bf16)w[e]) * h0[e] + bf2f((bf16)g[e]) * v0[e];
                                          y1[e] = bf2f((bf16)u[4 + e]) + bf2f((bf16)w[4 + e]) * h1[e] + bf2f((bf16)g[4 + e]) * v1[e]; }
            if (do_store) store8bf(Y + (size_t)i * 4 * DM, y0, y1);
        }
    }
    __syncthreads();
#undef RESC
#undef MASKT
#undef STEP
#undef ROT
#undef SLOAD
#undef SWRITE
#undef VMW
}
#undef SBAR
}
__global__ void __launch_bounds__(512, 2) fwd_megakernel(Args a) {
    extern __shared__ __attribute__((aligned(16))) unsigned char lds[];
    cg::grid_group grid = cg::this_grid();
    {
        if (threadIdx.x < 8) ((LAS unsigned*)(lds + LDS_XB))[threadIdx.x] = 0u;
        __syncthreads();
    }
    grid.sync();
    (void)xcd_barrier_post((unsigned*)(a.ws + WS_BAR), (volatile LAS unsigned*)((LAS unsigned char*)lds + LDS_XB));
#define GSYNC() do { XcdBarrier b_; b_.bar = (unsigned*)(a.ws + WS_BAR); b_.x = xb_xcc_id(); b_.st = (volatile LAS unsigned*)((LAS unsigned char*)lds + LDS_XB); xcd_barrier(b_); } while (0)
    const int G = gridDim.x;
    LAS unsigned char* ldsl = (LAS unsigned char*)lds;
    unsigned char* ws = a.ws;
    float* mod = (float*)(ws + WS_MOD); float* ss = (float*)(ws + WS_SS);
    bf16* XS = (bf16*)(ws + WS_XS); bf16* XL = (bf16*)(ws + WS_XL); bf16* SGA = (bf16*)(ws + WS_SGA); bf16* SGB = (bf16*)(ws + WS_SGB); bf16* UU = (bf16*)(ws + WS_UU);
    bf16* QD = (bf16*)(ws + WS_QD); bf16* KVD = (bf16*)(ws + WS_KVD); float* KROPE = (float*)(ws + WS_KROPE); bf16* KR = (bf16*)(ws + WS_KR);
    bf16* QN = (bf16*)(ws + WS_QN); bf16* QR = (bf16*)(ws + WS_QR); bf16* KN = (bf16*)(ws + WS_KN); bf16* VV = (bf16*)(ws + WS_V);

#ifndef PHM
#define PHM 0xFFFF
#endif
    if (PHM & 1) phase0(a, ldsl);
    GSYNC();
    if (PHM & 2) phase1(a);
    GSYNC();
#ifdef PROBE_P01
    phase0(a, ldsl);
    GSYNC();
    phase1(a);
    GSYNC();
#endif
    for (int l = 0; l < DEPTH; ++l) {
        unsigned char* wl = ws + WS_W + (size_t)l * WL_STRIDE;
        float* ssA = ss + (size_t)(4 * l) * T; float* ssB = ssA + T; float* ssQ = ssA + 2 * T; float* ssKV = ssA + 3 * T; float* ssN = ssA + 4 * T;
        const float* modl = mod + (size_t)l * 4 * NMOD;
        if (PHM & 4) {
            pg8::Gemm g{(const bf16*)XS, (const bf16*)(wl + WL_IN), T, DINP, DM}; pg8::StaticOrder S; S.init(T, DINP, G, (int)blockIdx.x);
            EpiIn E{ssA, (const float*)(ws + WS_SHWIN) + (size_t)l * 4 * DINP, XL, QD, KVD, KROPE, SGA, SGB, ssQ, ssKV};
            pg8::gemm_phase<EpiIn, pg8::StaticOrder, true, true>(ldsl, g, S, E);
        }
        GSYNC();
        for (int hh = 0; hh < 2; ++hh) {
#ifdef PROBE_LRU2
            if (hh == 0 && l == 0) { lru_phase(a, l, (char*)lds, true); lru_phase(a, l, (char*)lds, true); }
#endif
            if ((PHM & 8) && hh == 0) { lru_phase(a, l, (char*)lds); krope_phase(a); }
            if (PHM & 16) {
                int Kq = 256; asm volatile("" : "+s"(Kq));
                pg8::Gemm g{(const bf16*)QD, (const bf16*)(wl + WL_UQ) + (size_t)hh * 768 * 256, T, 768, Kq}; pg8::StaticOrder S; S.init(T, 768, G, (int)blockIdx.x);
                EpiQ E{ssQ, (const float*)(ws + WS_CS), QN, QR};
                pg8::gemm_phase<EpiQ, pg8::StaticOrder, true, true>(ldsl, g, S, E);
            }
            if (PHM & 32) {
                int Kk = 128; asm volatile("" : "+s"(Kk));
                pg8::Gemm g{(const bf16*)KVD, (const bf16*)(wl + WL_UKV) + (size_t)hh * 1024 * 128, T, 1024, Kk}; pg8::StaticOrder S; S.init(T, 1024, G, (int)blockIdx.x);
                EpiKV E{ssKV, KN, VV};
                pg8::gemm_phase<EpiKV, pg8::StaticOrder, true, true>(ldsl, g, S, E);
            }
#ifdef PROBE_QKV2
            {
                int Kq = 256; asm volatile("" : "+s"(Kq));
                pg8::Gemm g{(const bf16*)QD, (const bf16*)(wl + WL_UQ) + (size_t)hh * 768 * 256, T, 768, Kq}; pg8::StaticOrder S; S.init(T, 768, G, (int)blockIdx.x);
                EpiQ E{ssQ, (const float*)(ws + WS_CS), QN, QR};
                pg8::gemm_phase<EpiQ, pg8::StaticOrder, true, true>(ldsl, g, S, E);
            }
            {
                int Kk = 128; asm volatile("" : "+s"(Kk));
                pg8::Gemm g{(const bf16*)KVD, (const bf16*)(wl + WL_UKV) + (size_t)hh * 1024 * 128, T, 1024, Kk}; pg8::StaticOrder S; S.init(T, 1024, G, (int)blockIdx.x);
                EpiKV E{ssKV, KN, VV};
                pg8::gemm_phase<EpiKV, pg8::StaticOrder, true, true>(ldsl, g, S, E);
            }
#endif
            GSYNC();
            const int vcu = (G % 8 == 0) ? (int)(blockIdx.x & 7) * (G / 8) + (int)(blockIdx.x >> 3) : (int)blockIdx.x;
            if (PHM & 64) for (int p2 = 2 * vcu; p2 < 512; p2 += ((p2 & 1) ? 2 * G - 1 : 1)) {
                const int p = p2 >> 1, bh = p >> 4, s = p & 15, b = bh >> 2, hl = bh & 3;
                att::attn_unit(b * SEQ, hh, hl, (p2 & 1) ? s : 31 - s, ws, (char*)lds);
            }
#ifdef PROBE_ATT2
#ifndef PROBE_NOSYNC
            GSYNC();
#endif
            if (hh == PROBE_ATT2 - 1) for (int p2 = 2 * blockIdx.x; p2 < 512; p2 += ((p2 & 1) ? 2 * G - 1 : 1)) {
                const int p = p2 >> 1, bh = p >> 4, s = p & 15, b = bh >> 2, hl = bh & 3;
                att::attn_unit(b * SEQ, hh, hl, (p2 & 1) ? s : 31 - s, ws, (char*)lds, PROBE_STORE);
            }
#endif
            GSYNC();
        }
        if (PHM & 128) {
            pg8::Gemm g{(const bf16*)XL, (const bf16*)(wl + WL_OUT), T, DM, DM}; pg8::StaticOrder S; S.init(T, DM, G, (int)blockIdx.x);
            EpiRes E{l == 0 ? a.x : a.out, a.out, modl + 2048, modl + 4096, XS, ssB};
            pg8::gemm_phase<EpiRes, pg8::StaticOrder, true, true>(ldsl, g, S, E);
        }
        GSYNC();
        if (PHM & 256) {
            pg8::Gemm g{(const bf16*)XS, (const bf16*)(wl + WL_FFI), T, 2 * DFF, DM}; pg8::StaticOrder S; S.init(T, 2 * DFF, G, (int)blockIdx.x);
            EpiFfi E{ssB, (const float*)(ws + WS_SHWF) + (size_t)l * 4 * 2 * DFF, UU};
            pg8::gemm_phase<EpiFfi, pg8::StaticOrder, true, true>(ldsl, g, S, E);
#ifdef PROBE_FFI2
            GSYNC();
            pg8::gemm_phase<EpiFfi, pg8::StaticOrder, true, true>(ldsl, g, S, E);
#endif
        }
        GSYNC();
        if (PHM & 512) {
            pg8::Gemm g{(const bf16*)UU, (const bf16*)(wl + WL_FFO), T, DM, DFF}; pg8::StaticOrder S; S.init(T, DM, G, (int)blockIdx.x);
            EpiRes E{a.out, a.out, modl + 5120, (l + 1 < DEPTH) ? modl + 4 * NMOD + 1024 : nullptr, XS, ssN};
            pg8::gemm_phase<EpiRes, pg8::StaticOrder, true, true>(ldsl, g, S, E);
        }
        GSYNC();
    }
    if (PHM & 1024) final_phase(a);
}

extern "C" void kernel_launch(void* const* d_in, const int* in_sizes, int n_in, void* d_out, int out_size, void* d_ws, size_t ws_size, hipStream_t stream) {
    static int grid = 0;
    if (grid == 0) {
        int dev = 0, cus = 0, per_cu = 0;
        if (hipGetDevice(&dev) != hipSuccess || hipDeviceGetAttribute(&cus, hipDeviceAttributeMultiprocessorCount, dev) != hipSuccess) { grid = -1; return; }
        if (hipFuncSetAttribute((const void*)fwd_megakernel, hipFuncAttributeMaxDynamicSharedMemorySize, LDS_BYTES) != hipSuccess) { fprintf(stderr, "hipFuncSetAttribute failed\n"); grid = -1; return; }
        if (hipOccupancyMaxActiveBlocksPerMultiprocessor(&per_cu, (const void*)fwd_megakernel, 512, LDS_BYTES) != hipSuccess || per_cu < 1) per_cu = 1;
        (void)hipGetLastError();
        grid = cus;
        if (ws_size < WS_END) { fprintf(stderr, "workspace too small: %zu < %zu\n", ws_size, (size_t)WS_END); grid = -1; return; }
    }
    if (grid < 0) return;
    Args a{};
    a.x = (const float*)d_in[0]; a.c = (const float*)d_in[1]; a.pos = (const int*)d_in[2]; a.w_ada = (const float*)d_in[3]; a.b_ada = (const float*)d_in[4];
    a.w_in = (const float*)d_in[5]; a.conv_w = (const float*)d_in[6]; a.conv_b = (const float*)d_in[7]; a.lru_wa = (const float*)d_in[8]; a.lru_ba = (const float*)d_in[9];
    a.lru_wx = (const float*)d_in[10]; a.lru_bx = (const float*)d_in[11]; a.lru_a = (const float*)d_in[12]; a.qg = (const float*)d_in[13]; a.kvg = (const float*)d_in[14];
    a.w_uq = (const float*)d_in[15]; a.w_ukv = (const float*)d_in[16]; a.w_out = (const float*)d_in[17]; a.w_ffi = (const float*)d_in[18]; a.w_ffo = (const float*)d_in[19];
    a.fg = (const float*)d_in[20]; a.out = (float*)d_out; a.ws = (unsigned char*)d_ws;
    if (hipMemsetAsync((char*)d_ws + WS_BAR, 0, 16384, stream) != hipSuccess) { fprintf(stderr, "memset failed\n"); return; }
    void* args[] = {&a};
    hipError_t e = hipLaunchCooperativeKernel((const void*)fwd_megakernel, dim3(grid), dim3(512), args, LDS_BYTES, stream);
    if (e != hipSuccess) fprintf(stderr, "cooperative launch failed: %s (grid %d)\n", hipGetErrorString(e), grid);
}
```

```cpp
#include <hip/hip_runtime.h>
#include <hip/hip_cooperative_groups.h>
#include <hip/hip_bf16.h>
#include <cstdio>
#include <cstdint>
namespace cg = cooperative_groups;
namespace pg8 {
#define PG8_LAS __attribute__((address_space(3)))
typedef unsigned short bf16_t;
typedef short bf16x8 __attribute__((ext_vector_type(8)));
typedef float f32x4 __attribute__((ext_vector_type(4)));
typedef unsigned u32x4 __attribute__((ext_vector_type(4)));
constexpr int BM = 256, BK = 64, HALF = 128, HTB = HALF * BK * 2  , STAGE_BYTES = 8 * HTB, NXCD = 8, WGM = 8;

__host__ __device__ __forceinline__ int lds_byte(int r, int c) { const int st = (r >> 4) * 2 + (c >> 5), rr = r & 15, cc = c & 31, ob = rr * 64 + cc * 2; return st * 1024 + (ob ^ (((ob >> 9) & 1) << 5)); }
__host__ __device__ __forceinline__ void stage_rc(int b, int& R, int& C) { const int st = b / 1024, sb = b % 1024, swz = sb ^ (((sb >> 9) & 1) << 5); R = (st >> 1) * 16 + swz / 64; C = (st & 1) * 32 + (swz % 64) / 2; }
__host__ __device__ __forceinline__ int perm32(int rho) { const int n = rho >> 4, i = rho & 15; return 8 * (i >> 2) + 4 * n + (i & 3); }

struct Unit { int pm, pn; };
struct Gemm { const bf16_t* A; const bf16_t* Bt; int M, N, K; };

struct StaticOrder {
    int nM, nN, nwg, G, c;
    __host__ __device__ void init(int M, int N, int G_, int c_) { nM = M / BM; nN = N / BM; nwg = nM * nN; G = G_; c = c_; }
    __host__ __device__ bool next(int i, Unit& u) const {
        const long L = (long)i * G + c; if (L >= nwg) return false;
        int wgid = (int)L; { const int q = nwg / NXCD, r = nwg % NXCD, xcd = wgid % NXCD, off = wgid / NXCD; wgid = (xcd < r ? xcd * (q + 1) : r * (q + 1) + (xcd - r) * q) + off; }
        const int nig = WGM * nN, gid = wgid / nig, fm = gid * WGM, gsz = (nM - fm) < WGM ? (nM - fm) : WGM;
        u.pm = fm + ((wgid % nig) % gsz); u.pn = (wgid % nig) / gsz; return true;
    }
    __device__ __forceinline__ void a_ready(const Unit&) const {}
    __device__ __forceinline__ void done(const Unit&) const {}
};

typedef float cvt_f32x2_t __attribute__((ext_vector_type(2))); typedef __bf16 cvt_bf16x2_t __attribute__((ext_vector_type(2)));
__device__ __forceinline__ unsigned cvt_pk_bf16(float lo, float hi) { cvt_f32x2_t v = {lo, hi}; cvt_bf16x2_t b = __builtin_convertvector(v, cvt_bf16x2_t); return __builtin_bit_cast(unsigned, b); }
typedef float f32x2 __attribute__((ext_vector_type(2)));
template <class Epi, class Sched, bool ALIGN_EPI = false, bool SP2 = false>
__device__ __forceinline__ void gemm_phase(PG8_LAS unsigned char* lds, const Gemm g, const Sched& S, const Epi& E) {
    int tid_ = threadIdx.x; asm volatile("" : "+v"(tid_));
    const int tid = tid_, wid = __builtin_amdgcn_readfirstlane(tid >> 6), lane = tid & 63, wr = wid >> 2, wc = wid & 3, fr = lane & 15, fq = lane >> 4;
    const int K = g.K, nt = K / BK;
    unsigned voffA[2], voffB[2];
#pragma unroll
    for (int i = 0; i < 2; ++i) { int R, C; stage_rc(tid * 16 + i * 8192, R, C); const int Rb = Epi::PERM ? ((R & ~31) + perm32(R & 31)) : R;
        voffA[i] = (unsigned)(R * K + C) * 2u; voffB[i] = (unsigned)(Rb * K + C) * 2u; }
    const size_t kstep = (size_t)(BK * 2);
    const size_t hstep = (size_t)HALF * K * 2;
    const size_t tstep = 2 * hstep;
    const unsigned ldsw = (unsigned)wid * 1024u;
    const int aoff = lds_byte(wr * 64 + fr, fq * 8), boff = lds_byte(wc * 32 + fr, fq * 8);
#define PG8_SA(b, h) (((b) * 2 + (h)) * HTB)
#define PG8_SB(b, h) ((4 + (b) * 2 + (h)) * HTB)
#define PG8_STAGE(bufoff, gbase, voff) do { _Pragma("unroll") for (int _i = 0; _i < 2; ++_i) \
        __builtin_amdgcn_global_load_lds((const unsigned*)((const char*)(gbase) + (voff)[_i]), (PG8_LAS unsigned*)(lds + (bufoff) + ldsw + _i * 8192), 16, 0, 0); } while (0)
#define PG8_LDA(dst, b, h) do { _Pragma("unroll") for (int m = 0; m < 4; ++m) _Pragma("unroll") for (int k = 0; k < 2; ++k) dst[m][k] = *(const PG8_LAS bf16x8*)(lds + PG8_SA(b, h) + aoff + m * 2048 + k * 1024); } while (0)
#define PG8_LDB(dst, b, h) do { _Pragma("unroll") for (int n = 0; n < 2; ++n) _Pragma("unroll") for (int k = 0; k < 2; ++k) dst[n][k] = *(const PG8_LAS bf16x8*)(lds + PG8_SB(b, h) + boff + n * 2048 + k * 1024); } while (0)
#define PG8_MMA(ai, bj, At, Bt) do { __builtin_amdgcn_s_setprio(1); _Pragma("unroll") for (int m = 0; m < 4; ++m) _Pragma("unroll") for (int n = 0; n < 2; ++n) _Pragma("unroll") for (int k = 0; k < 2; ++k) \
        acc[ai][bj][m][n] = __builtin_amdgcn_mfma_f32_16x16x32_bf16(Bt[n][k], At[m][k], acc[ai][bj][m][n], 0, 0, 0); __builtin_amdgcn_s_setprio(0); } while (0)
#define PG8_WAIT_V(n) asm volatile("s_waitcnt vmcnt(" #n ")" ::: "memory")
#define PG8_WAIT_L(n) asm volatile("s_waitcnt lgkmcnt(" #n ")" ::: "memory")
#define PG8_BAR __builtin_amdgcn_s_barrier()
#define PG8_SCHED __builtin_amdgcn_sched_barrier(0)
    Unit cur, nxt; int ui = 0;
    if (!S.next(0, cur)) return;
    f32x4 acc[2][2][4][2];
#pragma unroll
    for (int a = 0; a < 2; ++a)
#pragma unroll
        for (int b = 0; b < 2; ++b)
#pragma unroll
            for (int m = 0; m < 4; ++m)
#pragma unroll
                for (int n = 0; n < 2; ++n) acc[a][b][m][n] = (f32x4){0.f, 0.f, 0.f, 0.f};
    bf16x8 At[4][2], B0[2][2], B1[2][2];
    const char* cA = (const char*)g.A + (size_t)cur.pm * tstep; const char* cB = (const char*)g.Bt + (size_t)cur.pn * tstep;
    S.a_ready(cur);
    if constexpr (SP2) {
        PG8_STAGE(PG8_SB(0, 0), cB, voffB); PG8_STAGE(PG8_SB(0, 1), cB + hstep, voffB); PG8_STAGE(PG8_SA(0, 0), cA, voffA); PG8_STAGE(PG8_SA(0, 1), cA + hstep, voffA);
        if (wr == 1) PG8_BAR;
        PG8_WAIT_V(2); PG8_BAR;
        PG8_STAGE(PG8_SB(1, 0), cB + kstep, voffB); PG8_STAGE(PG8_SA(1, 0), cA + kstep, voffA); PG8_STAGE(PG8_SB(1, 1), cB + hstep + kstep, voffB);
        PG8_WAIT_V(6); PG8_BAR;
    } else {
        PG8_STAGE(PG8_SB(0, 0), cB, voffB); PG8_STAGE(PG8_SA(0, 0), cA, voffA); PG8_STAGE(PG8_SB(0, 1), cB + hstep, voffB); PG8_STAGE(PG8_SA(0, 1), cA + hstep, voffA);
        if (wr == 1) PG8_BAR;
        PG8_WAIT_V(4); PG8_BAR;
        PG8_STAGE(PG8_SB(1, 0), cB + kstep, voffB); PG8_STAGE(PG8_SA(1, 0), cA + kstep, voffA); PG8_STAGE(PG8_SB(1, 1), cB + hstep + kstep, voffB);
        PG8_WAIT_V(6); PG8_BAR;
    }
    for (;;) {
        const bool has_next = S.next(ui + 1, nxt);
        const char* nA = has_next ? (const char*)g.A + (size_t)nxt.pm * tstep : cA; const char* nB = has_next ? (const char*)g.Bt + (size_t)nxt.pn * tstep : cB;
        for (int t = 0; t < nt; t += 2) {
            const bool last = (t == nt - 2);
            const char* a1 = cA + (size_t)(t + 1) * kstep;
            const char* a2 = last ? nA : cA + (size_t)(t + 2) * kstep; const char* b2 = last ? nB : cB + (size_t)(t + 2) * kstep;
            const char* a3 = a2 + kstep; const char* b3 = b2 + kstep;
            if (last && has_next) S.a_ready(nxt);
            if constexpr (SP2) {
            PG8_LDB(B0, 0, 0); PG8_LDB(B1, 0, 1); PG8_SCHED; PG8_LDA(At, 0, 0); PG8_STAGE(PG8_SA(1, 1), a1 + hstep, voffA);
            PG8_WAIT_V(8); PG8_WAIT_L(0); PG8_BAR; PG8_MMA(0, 0, At, B0); PG8_MMA(0, 1, At, B1); PG8_BAR; PG8_SCHED;
            PG8_LDA(At, 0, 1); PG8_STAGE(PG8_SB(0, 0), b2, voffB); PG8_STAGE(PG8_SB(0, 1), b2 + hstep, voffB); PG8_STAGE(PG8_SA(0, 0), a2, voffA);
            PG8_WAIT_V(8); PG8_WAIT_L(0); PG8_BAR; PG8_MMA(1, 0, At, B0); PG8_MMA(1, 1, At, B1); PG8_BAR; PG8_SCHED;
            PG8_LDB(B0, 1, 0); PG8_LDB(B1, 1, 1); PG8_SCHED; PG8_LDA(At, 1, 0); PG8_STAGE(PG8_SA(0, 1), a2 + hstep, voffA);
            PG8_WAIT_V(8); PG8_WAIT_L(0); PG8_BAR; PG8_MMA(0, 0, At, B0); PG8_MMA(0, 1, At, B1); PG8_BAR; PG8_SCHED;
            PG8_LDA(At, 1, 1); PG8_STAGE(PG8_SB(1, 0), b3, voffB); PG8_STAGE(PG8_SB(1, 1), b3 + hstep, voffB); PG8_STAGE(PG8_SA(1, 0), a3, voffA);
            PG8_WAIT_V(8); PG8_WAIT_L(0); PG8_BAR; PG8_MMA(1, 0, At, B0); PG8_MMA(1, 1, At, B1); PG8_BAR; PG8_SCHED;
            } else {
            PG8_LDB(B0, 0, 0); PG8_SCHED; PG8_LDA(At, 0, 0); PG8_STAGE(PG8_SA(1, 1), a1 + hstep, voffA);
            PG8_WAIT_L(8); PG8_BAR; PG8_WAIT_L(0); PG8_MMA(0, 0, At, B0); PG8_BAR; PG8_SCHED;
            PG8_LDB(B1, 0, 1); PG8_STAGE(PG8_SB(0, 0), b2, voffB);
            PG8_BAR; PG8_WAIT_L(0); PG8_MMA(0, 1, At, B1); PG8_BAR;
            PG8_LDA(At, 0, 1); PG8_STAGE(PG8_SA(0, 0), a2, voffA);
            PG8_BAR; PG8_WAIT_L(0); PG8_MMA(1, 0, At, B0); PG8_BAR; PG8_SCHED;
            PG8_STAGE(PG8_SB(0, 1), b2 + hstep, voffB);
            PG8_WAIT_V(6); PG8_BAR; PG8_MMA(1, 1, At, B1); PG8_BAR;
            PG8_LDB(B0, 1, 0); PG8_SCHED; PG8_LDA(At, 1, 0); PG8_STAGE(PG8_SA(0, 1), a2 + hstep, voffA);
            PG8_WAIT_L(8); PG8_BAR; PG8_WAIT_L(0); PG8_MMA(0, 0, At, B0); PG8_BAR; PG8_SCHED;
            PG8_LDB(B1, 1, 1); PG8_STAGE(PG8_SB(1, 0), b3, voffB);
            PG8_BAR; PG8_WAIT_L(0); PG8_MMA(0, 1, At, B1); PG8_BAR;
            PG8_LDA(At, 1, 1); PG8_STAGE(PG8_SA(1, 0), a3, voffA);
            PG8_BAR; PG8_WAIT_L(0); PG8_MMA(1, 0, At, B0); PG8_BAR; PG8_SCHED;
            PG8_STAGE(PG8_SB(1, 1), b3 + hstep, voffB);
            PG8_WAIT_V(6); PG8_BAR; PG8_MMA(1, 1, At, B1); PG8_BAR;
            }
        }
        if constexpr (ALIGN_EPI) { if (wr == 0) PG8_BAR; }
        if constexpr (!Epi::AFTER_DRAIN) { E(acc, cur, wr, wc, fr, fq); S.done(cur); }
        if (!has_next) break;
#pragma unroll
        for (int a = 0; a < 2; ++a)
#pragma unroll
            for (int b = 0; b < 2; ++b)
#pragma unroll
                for (int m = 0; m < 4; ++m)
#pragma unroll
                    for (int n = 0; n < 2; ++n) acc[a][b][m][n] = (f32x4){0.f, 0.f, 0.f, 0.f};
        cur = nxt; cA = nA; cB = nB; ++ui;
        if constexpr (ALIGN_EPI) { if (wr == 1) PG8_BAR; }
    }
    PG8_WAIT_V(0);
    if constexpr (!ALIGN_EPI) { if (wr == 0) PG8_BAR; }
    PG8_BAR;
    if constexpr (Epi::AFTER_DRAIN) { E.fused(acc, cur, wr, wc, fr, fq, lds, wid, lane); S.done(cur); }
#undef PG8_SA
#undef PG8_SB
#undef PG8_STAGE
#undef PG8_LDA
#undef PG8_LDB
#undef PG8_MMA
#undef PG8_WAIT_V
#undef PG8_WAIT_L
#undef PG8_BAR
#undef PG8_SCHED
}
}
#define LAS __attribute__((address_space(3)))
typedef unsigned short bf16;
typedef float f32x4 __attribute__((ext_vector_type(4)));
typedef float f32x2 __attribute__((ext_vector_type(2)));
typedef float f32x16 __attribute__((ext_vector_type(16)));
typedef unsigned u32x4 __attribute__((ext_vector_type(4)));
typedef unsigned u32x2 __attribute__((ext_vector_type(2)));
typedef short bf16x8 __attribute__((ext_vector_type(8)));
typedef short s16x4 __attribute__((ext_vector_type(4)));
using pg8::Unit; using pg8::cvt_pk_bf16;

constexpr int NB = 4, SEQ = 8192, T = NB * SEQ, DM = 1024, DEPTH = 2, DINP = 3584, DFF = 2816, NMOD = 6144;
constexpr float EPS = 1e-6f;
constexpr size_t MiB = 1u << 20;
constexpr size_t WS_MOD = 0, WS_SHWIN = 256 * 1024, WS_SHWF = 512 * 1024, WS_SS = 1 * MiB, WS_SUMP = 3 * MiB, WS_SUMH = 4 * MiB, WS_CS = 8 * MiB, WS_W = 16 * MiB;
constexpr size_t WL_STRIDE = 28 * MiB, WL_IN = 0, WL_OUT = 7 * MiB, WL_FFI = 9 * MiB, WL_FFO = 20 * MiB, WL_UQ = 25 * MiB + 512 * 1024, WL_UKV = 26 * MiB + 256 * 1024, WL_LRU = 26 * MiB + 768 * 1024;
constexpr size_t WS_XS = 72 * MiB, WS_XL = 136 * MiB, WS_SGA = 200 * MiB, WS_SGB = 264 * MiB, WS_UU = 136 * MiB, WS_QD = 328 * MiB, WS_KVD = 344 * MiB, WS_KROPE = 352 * MiB,
                 WS_KR = 360 * MiB, WS_QN = 364 * MiB, WS_QR = 396 * MiB, WS_KN = 412 * MiB, WS_V = 444 * MiB, WS_END = 476 * MiB;
constexpr size_t WS_BAR = 5 * MiB;
constexpr int LDS_BYTES = 147456, LDS_XB = 144384;

__device__ const float INV_FREQ[32] = {1.0f, 0.7498942613601685f, 0.5623413324356079f, 0.4216965138912201f, 0.3162277638912201f, 0.23713737726211548f, 0.17782793939113617f, 0.133352130651474f, 0.10000000149011612f, 0.07498941570520401f, 0.05623413249850273f, 0.04216965287923813f, 0.03162277489900589f, 0.023713737726211548f, 0.017782794311642647f, 0.01333521492779255f, 0.009999999776482582f, 0.007498941849917173f, 0.005623413249850273f, 0.0042169648222625256f, 0.003162277629598975f, 0.00237137358635664f, 0.0017782794311642647f, 0.0013335214462131262f, 0.0010000000474974513f, 0.0007498942431993783f, 0.000562341301701963f, 0.0004216965171508491f, 0.0003162277571391314f, 0.00023713737027719617f, 0.00017782794020604342f, 0.0001333521504420787f};

struct Args {
    const float* x; const float* c; const int* pos; const float* w_ada; const float* b_ada; const float* w_in; const float* conv_w; const float* conv_b;
    const float* lru_wa; const float* lru_ba; const float* lru_wx; const float* lru_bx; const float* lru_a; const float* qg; const float* kvg;
    const float* w_uq; const float* w_ukv; const float* w_out; const float* w_ffi; const float* w_ffo; const float* fg;
    float* out; unsigned char* ws;
};

__device__ __forceinline__ float bf2f(bf16 u) { return __uint_as_float(((unsigned)u) << 16); }
__device__ __forceinline__ unsigned f2bf(float f) { unsigned u = __float_as_uint(f); return (u + 0x7fffu + ((u >> 16) & 1u)) >> 16; }
__device__ __forceinline__ float sigmoidf_(float x) { return __builtin_amdgcn_rcpf(1.0f + __builtin_amdgcn_exp2f(-1.4426950408889634f * x)); }
__device__ __forceinline__ void store8bf(bf16* p, f32x4 a, f32x4 b) { u32x4 w; w.x = cvt_pk_bf16(a[0], a[1]); w.y = cvt_pk_bf16(a[2], a[3]); w.z = cvt_pk_bf16(b[0], b[1]); w.w = cvt_pk_bf16(b[2], b[3]); *(u32x4*)p = w; }
__device__ __forceinline__ float sumsq4(f32x4 v) { return (v[0] * v[0] + v[1] * v[1]) + (v[2] * v[2] + v[3] * v[3]); }
__device__ __forceinline__ void atomic_addf(float* p, float v) { (void)__hip_atomic_fetch_add(p, v, __ATOMIC_RELAXED, __HIP_MEMORY_SCOPE_AGENT); }
__device__ __forceinline__ float wave_sum(float v) {
#pragma unroll
    for (int o = 1; o < 64; o <<= 1) v += __shfl_xor(v, o);
    return v;
}
#define LDS_WAIT() asm volatile("s_waitcnt lgkmcnt(0)" ::: "memory")

struct EpiIn {
    static constexpr bool PERM = true, AFTER_DRAIN = false;
    const float* ss; const float* shw; bf16* XL; bf16* QD; bf16* KVD; float* KROPE; bf16* SGA; bf16* SGB; float* ssq; float* sskv;
    __device__ __forceinline__ void operator()(const f32x4 (&acc)[2][2][4][2], const Unit& u, int wr, int wc, int fr, int fq) const {
        const int row0 = u.pm * 256 + wr * 64 + fr, b = u.pm >> 5, pn = u.pn, c8 = wc * 32 + 8 * fq;
        f32x4 sv[2][2];
#pragma unroll
        for (int bj = 0; bj < 2; ++bj)
#pragma unroll
            for (int n = 0; n < 2; ++n) sv[bj][n] = *(const f32x4*)(shw + b * DINP + pn * 256 + bj * 128 + c8 + 4 * n);
        float ssv[2][4];
#pragma unroll
        for (int ai = 0; ai < 2; ++ai)
#pragma unroll
            for (int m = 0; m < 4; ++m) ssv[ai][m] = ss[row0 + ai * 128 + m * 16];
#pragma unroll
        for (int ai = 0; ai < 2; ++ai)
#pragma unroll
            for (int m = 0; m < 4; ++m) {
                const size_t row = (size_t)(row0 + ai * 128 + m * 16);
                const float rstd = __builtin_amdgcn_rsqf(ssv[ai][m] * (1.0f / 1024.0f) + EPS);
                f32x4 v[2][2];
#pragma unroll
                for (int bj = 0; bj < 2; ++bj)
#pragma unroll
                    for (int n = 0; n < 2; ++n) v[bj][n] = acc[ai][bj][m][n] * rstd + sv[bj][n];
                if (pn < 4) {
#pragma unroll
                    for (int bj = 0; bj < 2; ++bj) store8bf(XL + row * 1024 + pn * 256 + bj * 128 + c8, v[bj][0], v[bj][1]);
                } else if (pn == 4) {
#pragma unroll
                    for (int bj = 0; bj < 2; ++bj) store8bf(QD + row * 256 + bj * 128 + c8, v[bj][0], v[bj][1]);
                    float s = (sumsq4(v[0][0]) + sumsq4(v[0][1])) + (sumsq4(v[1][0]) + sumsq4(v[1][1]));
                    s += __shfl_xor(s, 16); s += __shfl_xor(s, 32);
                    if (fq == 0) atomic_addf(ssq + row, s);
                } else if (pn == 5) {
                    store8bf(KVD + row * 128 + c8, v[0][0], v[0][1]);
                    float s = sumsq4(v[0][0]) + sumsq4(v[0][1]);
                    s += __shfl_xor(s, 16); s += __shfl_xor(s, 32);
                    if (fq == 0) atomic_addf(sskv + row, s);
                    if (wc < 2) { *(f32x4*)(KROPE + row * 64 + c8) = v[1][0]; *(f32x4*)(KROPE + row * 64 + c8 + 4) = v[1][1]; }
                } else {
                    bf16* G = (pn < 10) ? SGA + (pn - 6) * 256 : SGB + (pn - 10) * 256;
#pragma unroll
                    for (int bj = 0; bj < 2; ++bj) {
                        f32x4 a, c;
#pragma unroll
                        for (int j = 0; j < 4; ++j) { a[j] = sigmoidf_(v[bj][0][j]); c[j] = sigmoidf_(v[bj][1][j]); }
                        store8bf(G + row * 1024 + bj * 128 + c8, a, c);
                    }
                }
            }
    }
};
struct EpiQ {
    static constexpr bool PERM = true, AFTER_DRAIN = false;
    const float* ssq; const float* cs; bf16* QN; bf16* QR;
    __device__ __forceinline__ void operator()(const f32x4 (&acc)[2][2][4][2], const Unit& u, int wr, int wc, int fr, int fq) const {
        const int row0 = u.pm * 256 + wr * 64 + fr, pn = u.pn, c8 = wc * 32 + 8 * fq;
        float ssv[2][4];
#pragma unroll
        for (int ai = 0; ai < 2; ++ai)
#pragma unroll
            for (int m = 0; m < 4; ++m) ssv[ai][m] = ssq[row0 + ai * 128 + m * 16];
#pragma unroll
        for (int ai = 0; ai < 2; ++ai)
#pragma unroll
            for (int m = 0; m < 4; ++m) {
                const size_t row = (size_t)(row0 + ai * 128 + m * 16);
                const float rstd = __builtin_amdgcn_rsqf(ssv[ai][m] * (1.0f / 256.0f) + EPS);
                if (pn < 2) {
#pragma unroll
                    for (int bj = 0; bj < 2; ++bj) store8bf(QN + row * 512 + pn * 256 + bj * 128 + c8, acc[ai][bj][m][0] * rstd, acc[ai][bj][m][1] * rstd);
                } else {
                    const int i0 = (wc & 1) * 16 + 4 * fq;
                    const f32x4 cs0 = *(const f32x4*)(cs + row * 64 + 2 * i0), cs1 = *(const f32x4*)(cs + row * 64 + 2 * i0 + 4);
#pragma unroll
                    for (int bj = 0; bj < 2; ++bj) {
                        const f32x4 a = acc[ai][bj][m][0] * rstd, c = acc[ai][bj][m][1] * rstd; f32x4 oa, oc;
                        oa[0] = a[0] * cs0[0] - a[1] * cs0[1]; oa[1] = a[1] * cs0[0] + a[0] * cs0[1];
                        oa[2] = a[2] * cs0[2] - a[3] * cs0[3]; oa[3] = a[3] * cs0[2] + a[2] * cs0[3];
                        oc[0] = c[0] * cs1[0] - c[1] * cs1[1]; oc[1] = c[1] * cs1[0] + c[0] * cs1[1];
                        oc[2] = c[2] * cs1[2] - c[3] * cs1[3]; oc[3] = c[3] * cs1[2] + c[2] * cs1[3];
                        store8bf(QR + row * 256 + bj * 128 + c8, oa, oc);
                    }
                }
            }
    }
};
struct EpiKV {
    static constexpr bool PERM = true, AFTER_DRAIN = false;
    const float* sskv; bf16* KN; bf16* V;
    __device__ __forceinline__ void operator()(const f32x4 (&acc)[2][2][4][2], const Unit& u, int wr, int wc, int fr, int fq) const {
        const int row0 = u.pm * 256 + wr * 64 + fr, pn = u.pn, c8 = wc * 32 + 8 * fq;
        bf16* O = (pn < 2) ? KN + pn * 256 : V + (pn - 2) * 256;
        float ssv[2][4];
#pragma unroll
        for (int ai = 0; ai < 2; ++ai)
#pragma unroll
            for (int m = 0; m < 4; ++m) ssv[ai][m] = sskv[row0 + ai * 128 + m * 16];
#pragma unroll
        for (int ai = 0; ai < 2; ++ai)
#pragma unroll
            for (int m = 0; m < 4; ++m) {
                const size_t row = (size_t)(row0 + ai * 128 + m * 16);
                const float rstd = __builtin_amdgcn_rsqf(ssv[ai][m] * (1.0f / 128.0f) + EPS);
#pragma unroll
                for (int bj = 0; bj < 2; ++bj) store8bf(O + row * 512 + bj * 128 + c8, acc[ai][bj][m][0] * rstd, acc[ai][bj][m][1] * rstd);
            }
    }
};
struct EpiRes {
    static constexpr bool PERM = false, AFTER_DRAIN = false;
    const float* xres; float* xout; const float* g; const float* sc; bf16* XS; float* ssn;
    __device__ __forceinline__ void operator()(const f32x4 (&acc)[2][2][4][2], const Unit& u, int wr, int wc, int fr, int fq) const {
        const int row0 = u.pm * 256 + wr * 64 + fr, b = u.pm >> 5, col0 = u.pn * 256 + wc * 32 + 4 * fq;
        f32x4 gv[2][2], scv[2][2];
#pragma unroll
        for (int bj = 0; bj < 2; ++bj)
#pragma unroll
            for (int n = 0; n < 2; ++n) { gv[bj][n] = *(const f32x4*)(g + b * NMOD + col0 + bj * 128 + n * 16);
                scv[bj][n] = sc ? *(const f32x4*)(sc + b * NMOD + col0 + bj * 128 + n * 16) + 1.0f : (f32x4){1.f, 1.f, 1.f, 1.f}; }
#pragma unroll
        for (int ai = 0; ai < 2; ++ai)
#pragma unroll
        for (int mp = 0; mp < 2; ++mp) {
            f32x4 pre[2][2][2];
#pragma unroll
            for (int mm = 0; mm < 2; ++mm)
#pragma unroll
                for (int bj = 0; bj < 2; ++bj)
#pragma unroll
                    for (int n = 0; n < 2; ++n) pre[mm][bj][n] = *(const f32x4*)(xres + (size_t)(row0 + ai * 128 + (2 * mp + mm) * 16) * 1024 + col0 + bj * 128 + n * 16);
#pragma unroll
            for (int mm = 0; mm < 2; ++mm) { const int m = 2 * mp + mm;
                const size_t row = (size_t)(row0 + ai * 128 + m * 16); float s = 0.f;
#pragma unroll
                for (int bj = 0; bj < 2; ++bj)
#pragma unroll
                    for (int n = 0; n < 2; ++n) { const size_t off = row * 1024 + col0 + bj * 128 + n * 16;
                        const f32x4 xv = pre[mm][bj][n] + gv[bj][n] * acc[ai][bj][m][n];
                        *(f32x4*)(xout + off) = xv; s += sumsq4(xv);
                        if (sc) { const f32x4 y = xv * scv[bj][n]; u32x2 w; w.x = cvt_pk_bf16(y[0], y[1]); w.y = cvt_pk_bf16(y[2], y[3]); *(u32x2*)(XS + off) = w; } }
                s += __shfl_xor(s, 16); s += __shfl_xor(s, 32);
                if (fq == 0) atomic_addf(ssn + row, s);
            }
        }
    }
};
struct EpiFfi {
    static constexpr bool PERM = true, AFTER_DRAIN = false;
    const float* ss; const float* shw; bf16* UU;
    __device__ __forceinline__ void operator()(const f32x4 (&acc)[2][2][4][2], const Unit& u, int wr, int wc, int fr, int fq) const {
        const int row0 = u.pm * 256 + wr * 64 + fr, b = u.pm >> 5, pn = u.pn, c8 = wc * 32 + 8 * fq;
        f32x4 sv[2][2];
#pragma unroll
        for (int bj = 0; bj < 2; ++bj)
#pragma unroll
            for (int n = 0; n < 2; ++n) sv[bj][n] = *(const f32x4*)(shw + b * (2 * DFF) + pn * 256 + bj * 128 + c8 + 4 * n);
        float ssv[2][4];
#pragma unroll
        for (int ai = 0; ai < 2; ++ai)
#pragma unroll
            for (int m = 0; m < 4; ++m) ssv[ai][m] = ss[row0 + ai * 128 + m * 16];
#pragma unroll
        for (int ai = 0; ai < 2; ++ai)
#pragma unroll
            for (int m = 0; m < 4; ++m) {
                const size_t row = (size_t)(row0 + ai * 128 + m * 16);
                const float rstd = __builtin_amdgcn_rsqf(ssv[ai][m] * (1.0f / 1024.0f) + EPS);
                f32x4 h[2];
#pragma unroll
                for (int n = 0; n < 2; ++n) { const f32x4 gt = acc[ai][0][m][n] * rstd + sv[0][n], up = acc[ai][1][m][n] * rstd + sv[1][n];
#pragma unroll
                    for (int j = 0; j < 4; ++j) h[n][j] = gt[j] * sigmoidf_(gt[j]) * up[j]; }
                store8bf(UU + row * DFF + pn * 128 + c8, h[0], h[1]);
            }
    }
};
#define XB_TMO      128
#define XB_XCNT(j)  (256  + 64 * (j))
#define XB_XSUB(j)  (1280 + 64 * (j))
#define XB_XGEN(j)  (2304 + 64 * (j))
#define XB_TOP      3328
#define XB_TOPGEN   3392
#define XCD_BAR_WORDS 3456
#define XB_SPIN_CAP (1u << 18)

__device__ __forceinline__ unsigned xb_ld(unsigned* p)              { return __hip_atomic_load(p, __ATOMIC_RELAXED, __HIP_MEMORY_SCOPE_AGENT); }
__device__ __forceinline__ unsigned xb_add(unsigned* p, unsigned v) { return __hip_atomic_fetch_add(p, v, __ATOMIC_RELAXED, __HIP_MEMORY_SCOPE_AGENT); }
__device__ __forceinline__ unsigned xb_xcc_id() { return (unsigned)__builtin_amdgcn_s_getreg((3 << 11) | 20) & 0xFu; }
#define XB_SPIN(cond, bar) do { unsigned _sp = 0; while (cond) { __builtin_amdgcn_s_sleep(1); \
    if ((++_sp & 255u) == 0u) { if (xb_ld(&(bar)[XB_TMO])) break; if (_sp > XB_SPIN_CAP) { atomicAdd(&(bar)[XB_TMO], 1u); break; } } } } while (0)

struct XcdBarrier {
    unsigned* bar; unsigned x;
    volatile LAS unsigned* st;
};

__device__ __forceinline__ XcdBarrier xcd_barrier_post(unsigned* bar, volatile LAS unsigned* st) {
    XcdBarrier b; b.bar = bar; b.x = xb_xcc_id(); b.st = st;
    if (threadIdx.x == 0) (void)xb_add(&bar[XB_XCNT(b.x)], 1u);
    return b;
}
__device__ __forceinline__ void xcd_barrier_complete(unsigned* bar, unsigned x, unsigned& nloc, unsigned& nx) {
    const unsigned G = gridDim.x * gridDim.y * gridDim.z;
    unsigned sum, cnt, mine, sp = 0u;
    for (;;) {
        sum = 0u; cnt = 0u; mine = 0u;
#pragma unroll
        for (unsigned j = 0; j < 16; ++j) { const unsigned c = xb_ld(&bar[XB_XCNT(j)]); sum += c; cnt += (c > 0u) ? 1u : 0u; mine = (j == x) ? c : mine; }
        if (sum == G) break;
        __builtin_amdgcn_s_sleep(1);
        if ((++sp & 255u) == 0u) { if (xb_ld(&bar[XB_TMO])) break; if (sp > XB_SPIN_CAP) { atomicAdd(&bar[XB_TMO], 1u); break; } }
    }
    nloc = mine > 0u ? mine : 1u; nx = cnt > 0u ? cnt : 1u;
}

__device__ __forceinline__ void xcd_barrier(const XcdBarrier& b) {
    asm volatile("s_waitcnt vmcnt(0)" ::: "memory");
    __syncthreads();
    if (threadIdx.x == 0) {
        unsigned* bar = b.bar;
        __builtin_amdgcn_s_waitcnt(0);
        unsigned nloc = b.st[0], nx = b.st[1];
        if (nloc == 0u) { xcd_barrier_complete(bar, b.x, nloc, nx); b.st[0] = nloc; b.st[1] = nx; }
        const unsigned old = xb_add(&bar[XB_XSUB(b.x)], 1u);
        const unsigned gen = old / nloc;
        if (old + 1u == (gen + 1u) * nloc) {
            __builtin_amdgcn_fence(__ATOMIC_RELEASE, "agent");
            asm volatile("s_waitcnt vmcnt(0)" ::: "memory");
            const unsigned og = xb_add(&bar[XB_TOP], 1u);
            const unsigned tg = og / nx;
            if (og + 1u == (tg + 1u) * nx) xb_add(&bar[XB_TOPGEN], 1u);
            else XB_SPIN(xb_ld(&bar[XB_TOPGEN]) == tg, bar);
            __builtin_amdgcn_fence(__ATOMIC_ACQUIRE, "agent");
            xb_add(&bar[XB_XGEN(b.x)], 1u);
            asm volatile("s_waitcnt vmcnt(0)" ::: "memory");
        } else {
            XB_SPIN(xb_ld(&bar[XB_XGEN(b.x)]) == gen, bar);
            __builtin_amdgcn_fence(__ATOMIC_ACQUIRE, "agent");
            asm volatile("s_waitcnt vmcnt(0)" ::: "memory");
        }
    }
    __syncthreads();
}
__device__ __forceinline__ int map_col(int id, int n) {
    switch (id) {
        case 0: return n < 1472 ? n : (n < 1536 ? -1 : n - 64);
        case 2: { const int pn = n >> 8, w = n & 255; return w < 128 ? pn * 128 + w : DFF + pn * 128 + (w - 128); }
        case 3: { const int hh = n / 768; int r = n % 768;
                  if (r < 512) return (4 * hh + (r >> 7)) * 192 + (r & 127);
                  r -= 512; const int e = r & 63; return (4 * hh + (r >> 6)) * 192 + 128 + (e >> 1) + 32 * (e & 1); }
        case 4: { const int hh = n >> 10; int r = n & 1023;
                  if (r < 512) return (4 * hh + (r >> 7)) * 256 + (r & 127);
                  r -= 512; return (4 * hh + (r >> 7)) * 256 + 128 + (r & 127); }
        default: return n;
    }
}
__device__ __forceinline__ void transpose_item(const float* W, int ldw, int K, bf16* WT, int id, const float* kscale, int nblk, int item, LAS float* scr, int lane) {
    const int kb = item / nblk, nb = item % nblk, k0 = 64 * kb, n0 = 32 * nb;
    const int sc = map_col(id, n0 + (lane & 31));
#pragma unroll 16
    for (int i = 0; i < 32; ++i) { const int kk = 2 * i + (lane >> 5); float v = sc >= 0 ? W[(size_t)(k0 + kk) * ldw + sc] : 0.f; if (kscale) v *= kscale[k0 + kk]; scr[kk * 33 + (lane & 31)] = v; }
    LDS_WAIT(); asm volatile("" ::: "memory");
    const int c = lane & 7;
#pragma unroll
    for (int j = 0; j < 4; ++j) { const int n = (lane >> 3) + 8 * j; const LAS float* s = scr + (8 * c) * 33 + n;
        u32x4 o; o.x = cvt_pk_bf16(s[0 * 33], s[1 * 33]); o.y = cvt_pk_bf16(s[2 * 33], s[3 * 33]); o.z = cvt_pk_bf16(s[4 * 33], s[5 * 33]); o.w = cvt_pk_bf16(s[6 * 33], s[7 * 33]);
        *(u32x4*)(WT + (size_t)(n0 + n) * K + k0 + 8 * c) = o; }
    LDS_WAIT(); asm volatile("" ::: "memory");
}
#define OPAQUE_TID() int tid_ = threadIdx.x; asm volatile("" : "+v"(tid_)); const int lane = tid_ & 63, wave = __builtin_amdgcn_readfirstlane(tid_ >> 6), NGW = gridDim.x * 8, gw = blockIdx.x * 8 + wave; (void)lane; (void)wave; (void)NGW; (void)gw
__device__ __forceinline__ void phase0(const Args& a, LAS unsigned char* lds) {
    OPAQUE_TID();
    LAS float* scr = (LAS float*)(lds + wave * 16384);
    float* mod = (float*)(a.ws + WS_MOD);
    for (int it = blockIdx.x; it < DEPTH * (NMOD / 64); it += gridDim.x) {
        const int l = it / (NMOD / 64), n = (it % (NMOD / 64)) * 64 + lane;
        float a0 = 0.f, a1 = 0.f, a2 = 0.f, a3 = 0.f;
        const float* w = a.w_ada + (size_t)l * DM * NMOD + (size_t)(wave * 128) * NMOD + n; const float* cc = a.c + wave * 128;
#pragma unroll 16
        for (int k = 0; k < 128; ++k) { const float wv = w[(size_t)k * NMOD]; a0 += cc[k] * wv; a1 += cc[DM + k] * wv; a2 += cc[2 * DM + k] * wv; a3 += cc[3 * DM + k] * wv; }
        LAS float* red = (LAS float*)(lds + 73728);
        red[(wave * 4 + 0) * 64 + lane] = a0; red[(wave * 4 + 1) * 64 + lane] = a1; red[(wave * 4 + 2) * 64 + lane] = a2; red[(wave * 4 + 3) * 64 + lane] = a3;
        __syncthreads();
        if (wave < 4) { float s = a.b_ada[l * NMOD + n];
#pragma unroll
            for (int q = 0; q < 8; ++q) s += red[(q * 4 + wave) * 64 + lane];
            mod[(l * 4 + wave) * NMOD + n] = s; }
        __syncthreads();
    }
    constexpr int I_IN = 16 * (DINP / 32), I_OUT = 16 * 32, I_FFI = 16 * (2 * DFF / 32), I_FFO = (DFF / 64) * 32, I_UQ = 4 * 48, I_UKV = 2 * 64, I_LRU = 16 * 8;
    constexpr int I_L = I_IN + I_OUT + I_FFI + I_FFO + I_UQ + I_UKV + I_LRU;
    for (int it = gw; it < DEPTH * I_L; it += NGW) {
        const int l = it / I_L; int r = it % I_L; unsigned char* wl = a.ws + WS_W + (size_t)l * WL_STRIDE;
        if (r < I_IN) { transpose_item(a.w_in + (size_t)l * DM * 3520, 3520, DM, (bf16*)(wl + WL_IN), 0, nullptr, DINP / 32, r, scr, lane); continue; } r -= I_IN;
        if (r < I_OUT) { transpose_item(a.w_out + (size_t)l * DM * DM, DM, DM, (bf16*)(wl + WL_OUT), 1, nullptr, 32, r, scr, lane); continue; } r -= I_OUT;
        if (r < I_FFI) { transpose_item(a.w_ffi + (size_t)l * DM * 2 * DFF, 2 * DFF, DM, (bf16*)(wl + WL_FFI), 2, nullptr, 2 * DFF / 32, r, scr, lane); continue; } r -= I_FFI;
        if (r < I_FFO) { transpose_item(a.w_ffo + (size_t)l * DFF * DM, DM, DFF, (bf16*)(wl + WL_FFO), 1, nullptr, 32, r, scr, lane); continue; } r -= I_FFO;
        if (r < I_UQ) { transpose_item(a.w_uq + (size_t)l * 256 * 1536, 1536, 256, (bf16*)(wl + WL_UQ), 3, a.qg + l * 256, 48, r, scr, lane); continue; } r -= I_UQ;
        if (r < I_UKV) { transpose_item(a.w_ukv + (size_t)l * 128 * 2048, 2048, 128, (bf16*)(wl + WL_UKV), 4, a.kvg + l * 128, 64, r, scr, lane); continue; } r -= I_UKV;
        { const int mtx = r >> 3, nb = mtx >> 1, which = mtx & 1;
          const float* src = (which ? a.lru_wx : a.lru_wa) + (size_t)l * 8 * 16384 + (size_t)nb * 16384;
          transpose_item(src, 128, 128, (bf16*)(wl + WL_LRU) + (size_t)(nb * 256 + which * 128) * 128, 1, nullptr, 4, r & 7, scr, lane); }
    }
    f32x2* cs = (f32x2*)(a.ws + WS_CS);
    for (int e = gw * 64 + lane; e < T * 32; e += NGW * 64) {
        const int t = e >> 5, i = e & 31;
        const float ang = (float)a.pos[t] * INV_FREQ[i];
        const double q = rint((double)ang * 0.15915494309189535);
        const float rr = (float)((double)ang - q * 6.283185307179586);
        cs[e] = (f32x2){__cosf(rr), __sinf(rr)};
    }
}
__device__ __forceinline__ void phase1(const Args& a) {
    OPAQUE_TID();
    const float* mod = (const float*)(a.ws + WS_MOD);
    float* ss = (float*)(a.ws + WS_SS); bf16* XS = (bf16*)(a.ws + WS_XS);
    for (int row0 = gw; row0 < T; row0 += 4 * NGW) {
        f32x4 v[4][4]; float s[4];
#pragma unroll
        for (int q = 0; q < 4; ++q) { const int row = row0 + q * NGW; const f32x4* xr = (const f32x4*)(a.x + (size_t)row * DM) + lane; s[q] = 0.f;
#pragma unroll
            for (int j = 0; j < 4; ++j) { v[q][j] = xr[64 * j]; } }
#pragma unroll
        for (int q = 0; q < 4; ++q) { const int row = row0 + q * NGW, b = row >> 13; const f32x4* scp = (const f32x4*)(mod + b * NMOD + 1024) + lane;
#pragma unroll
            for (int j = 0; j < 4; ++j) s[q] += sumsq4(v[q][j]);
            s[q] = wave_sum(s[q]);
            u32x2* o = (u32x2*)(XS + (size_t)row * DM) + lane;
#pragma unroll
            for (int j = 0; j < 4; ++j) { const f32x4 y = v[q][j] * (scp[64 * j] + 1.0f); u32x2 w; w.x = cvt_pk_bf16(y[0], y[1]); w.y = cvt_pk_bf16(y[2], y[3]); o[64 * j] = w; }
            if (lane == 0) ss[row] = s[q];
            if (lane >= 1 && lane <= 8) ss[(size_t)lane * T + row] = 0.f; }
    }
    constexpr int NI = DINP + 2 * DFF;
    for (int it = gw; it < DEPTH * NI; it += NGW) {
        const int l = it / NI; int n = it % NI; const bool isf = n >= DINP; if (isf) n -= DINP;
        const bf16* wrow = (const bf16*)(a.ws + WS_W + (size_t)l * WL_STRIDE + (isf ? WL_FFI : WL_IN)) + (size_t)n * DM;
        const float* sh = mod + (size_t)l * 4 * NMOD + (isf ? 3072 : 0);
        float s0 = 0.f, s1 = 0.f, s2 = 0.f, s3 = 0.f;
#pragma unroll
        for (int h = 0; h < 2; ++h) { const int k0 = h * 512 + lane * 8; const bf16x8 wv = *(const bf16x8*)(wrow + k0);
#pragma unroll
            for (int j = 0; j < 8; ++j) { const float w = bf2f((bf16)wv[j]); s0 += w * sh[k0 + j]; s1 += w * sh[NMOD + k0 + j]; s2 += w * sh[2 * NMOD + k0 + j]; s3 += w * sh[3 * NMOD + k0 + j]; } }
        s0 = wave_sum(s0); s1 = wave_sum(s1); s2 = wave_sum(s2); s3 = wave_sum(s3);
        if (lane == 0) { float* o = (float*)(a.ws + (isf ? WS_SHWF : WS_SHWIN)) + (size_t)l * 4 * (isf ? 2 * DFF : DINP) + n; const int st = isf ? 2 * DFF : DINP; o[0] = s0; o[st] = s1; o[2 * st] = s2; o[3 * st] = s3; }
    }
}
__device__ __forceinline__ void lru_phase(const Args& a, int l, char* lds, bool dummy = false) {
    int tid_ = threadIdx.x; asm volatile("" : "+v"(tid_));
    const int tid = tid_, lane = tid & 63, wave = tid >> 6, fq = lane >> 4, fc = lane & 15;
    const bf16* XL = (const bf16*)(a.ws + WS_XL); bf16* SGA = (bf16*)(a.ws + WS_SGA); bf16* WC = (bf16*)(a.ws + WS_XS);
    float* sumP = (float*)(a.ws + WS_SUMP); float* sumH = (float*)(a.ws + WS_SUMH);
    const bf16* Wl = (const bf16*)(a.ws + WS_W + (size_t)l * WL_STRIDE + WL_LRU);
    const float* cw = a.conv_w + (size_t)l * 4 * DM; const float* cb = a.conv_b + (size_t)l * DM;
    constexpr int PITCH = 272, TILE = 128 * PITCH, OFF_SG = TILE, OFF_WC = 2 * TILE, OFF_PF = 3 * TILE;
    const int cgp = tid & 15, rr = tid >> 4;
    f32x4 w[4][2], bb[2]; bf16x8 bwa[4], bwx[4]; float ba = 0.f, bx = 0.f, c8 = 0.f; int nb_cur = -1;
    for (int unit = blockIdx.x; unit < (T / 128) * 8; unit += gridDim.x) {
        const int chunk = unit >> 3, nb = unit & 7, t0 = chunk * 128; const bool first = (t0 & (SEQ - 1)) == 0;
        const int ch = nb * 128 + cgp * 8;
        if (nb != nb_cur) { nb_cur = nb;
#pragma unroll
            for (int j = 0; j < 4; ++j) { w[j][0] = *(const f32x4*)(cw + j * DM + ch); w[j][1] = *(const f32x4*)(cw + j * DM + ch + 4); }
            bb[0] = *(const f32x4*)(cb + ch); bb[1] = *(const f32x4*)(cb + ch + 4);
            const bf16* wr_ = Wl + (size_t)(nb * 256 + 16 * wave + fc) * 128 + fq * 8;
#pragma unroll
            for (int ks = 0; ks < 4; ++ks) { bwa[ks] = *(const bf16x8*)(wr_ + ks * 32); bwx[ks] = *(const bf16x8*)(wr_ + 128 * 128 + ks * 32); }
            const int c_ = nb * 128 + 16 * wave + fc;
            ba = a.lru_ba[l * DM + c_]; bx = a.lru_bx[l * DM + c_]; c8 = -8.0f * log1pf(__expf(-a.lru_a[l * DM + c_])); }
        {
            bf16x8 sgv[4], xv[4][4];
#pragma unroll
            for (int p = 0; p < 4; ++p) sgv[p] = *(const bf16x8*)(SGA + (size_t)(t0 + p * 32 + rr) * DM + ch);
            int pf = 0; if (tid < 128) pf = a.pos[t0 + tid];
#pragma unroll
            for (int p = 0; p < 4; ++p)
#pragma unroll
                for (int j = 0; j < 4; ++j) { const int rj = p * 32 + rr - 3 + j;
                    xv[p][j] = (first && rj < 0) ? (bf16x8){0, 0, 0, 0, 0, 0, 0, 0} : *(const bf16x8*)(XL + (size_t)(t0 + rj) * DM + ch); }
            __syncthreads();
#pragma unroll
            for (int p = 0; p < 4; ++p) { const int row = p * 32 + rr; f32x4 o0 = bb[0], o1 = bb[1];
#pragma unroll
                for (int j = 0; j < 4; ++j) {
#pragma unroll
                    for (int e = 0; e < 4; ++e) { o0[e] += w[j][0][e] * bf2f((bf16)xv[p][j][e]); o1[e] += w[j][1][e] * bf2f((bf16)xv[p][j][4 + e]); } }
                u32x4 pk; pk.x = cvt_pk_bf16(o0[0], o0[1]); pk.y = cvt_pk_bf16(o0[2], o0[3]); pk.z = cvt_pk_bf16(o1[0], o1[1]); pk.w = cvt_pk_bf16(o1[2], o1[3]);
                *(u32x4*)(lds + row * PITCH + cgp * 16) = pk; }
#pragma unroll
            for (int p = 0; p < 4; ++p) *(bf16x8*)(lds + OFF_SG + (p * 32 + rr) * PITCH + cgp * 16) = sgv[p];
            if (tid < 128) *(int*)(lds + OFF_PF + tid * 4) = pf;
        }
        __syncthreads();
        f32x4 accA[8], accX[8];
        {
#pragma unroll
            for (int m = 0; m < 8; ++m) { accA[m] = (f32x4){0.f, 0.f, 0.f, 0.f}; accX[m] = (f32x4){0.f, 0.f, 0.f, 0.f};
#pragma unroll
                for (int ks = 0; ks < 4; ++ks) { const bf16x8 av = *(const bf16x8*)(lds + (16 * m + fc) * PITCH + ks * 64 + fq * 16);
                    accA[m] = __builtin_amdgcn_mfma_f32_16x16x32_bf16(av, bwa[ks], accA[m], 0, 0, 0);
                    accX[m] = __builtin_amdgcn_mfma_f32_16x16x32_bf16(av, bwx[ks], accX[m], 0, 0, 0); } }
        }
        const int cl = 16 * wave + fc, c = nb * 128 + cl;
        float Pm = 1.f, Hm = 0.f;
#pragma unroll
        for (int m = 0; m < 8; ++m) {
            float P[4], Hh[4], sg[4];
#pragma unroll
            for (int j = 0; j < 4; ++j) { const int tl = 16 * m + 4 * fq + j;
                const float r = sigmoidf_(accA[m][j] + ba), ig = sigmoidf_(accX[m][j] + bx);
                const float la = c8 * r, x2 = 2.0f * la;
                float av = __expf(la);
                float om = (x2 > -0.1f) ? -(x2 * (1.0f + x2 * (0.5f + x2 * (0.16666667f + x2 * 0.041666668f)))) : 1.0f - __expf(x2);
                float mult = __builtin_amdgcn_sqrtf(om);
                if (*(const int*)(lds + OFF_PF + tl * 4) == 0) { av = 0.f; mult = 1.f; }
                const float xc = bf2f(*(const bf16*)(lds + tl * PITCH + cl * 2));
                const float bv = xc * ig * mult;
                sg[j] = bf2f(*(const bf16*)(lds + OFF_SG + tl * PITCH + cl * 2));
                if (j == 0) { P[0] = av; Hh[0] = bv; } else { P[j] = P[j - 1] * av; Hh[j] = av * Hh[j - 1] + bv; } }
            float Pa = P[3], Ha = Hh[3];
            { const float Pp = __shfl_up(Pa, 16), Hp = __shfl_up(Ha, 16); if (fq >= 1) { Ha = Pa * Hp + Ha; Pa = Pp * Pa; } }
            { const float Pp = __shfl_up(Pa, 32), Hp = __shfl_up(Ha, 32); if (fq >= 2) { Ha = Pa * Hp + Ha; Pa = Pp * Pa; } }
            float Pex = __shfl_up(Pa, 16), Hex = __shfl_up(Ha, 16); if (fq == 0) { Pex = 1.f; Hex = 0.f; }
            const float Pt = __shfl(Pa, 48 + fc), Ht = __shfl(Ha, 48 + fc);
            const float Pin = Pm * Pex, Hin = Pex * Hm + Hex;
#pragma unroll
            for (int j = 0; j < 4; ++j) { const int tl = 16 * m + 4 * fq + j;
                const float cp = P[j] * Pin, hl = Hh[j] + P[j] * Hin;
                const unsigned pk = cvt_pk_bf16(sg[j] * hl, sg[j] * cp);
                *(bf16*)(lds + OFF_SG + tl * PITCH + cl * 2) = (bf16)(pk & 0xffffu); *(bf16*)(lds + OFF_WC + tl * PITCH + cl * 2) = (bf16)(pk >> 16); }
            Hm = Pt * Hm + Ht; Pm = Pm * Pt;
        }
        if (fq == 0) { sumP[(size_t)chunk * DM + c] = Pm; sumH[(size_t)chunk * DM + c] = Hm; }
        __syncthreads();
#pragma unroll
        for (int p = 0; p < 4; ++p) { const int row = p * 32 + rr; const size_t gi = (size_t)(t0 + row) * DM + ch;
            *(bf16x8*)((dummy ? (bf16*)a.out : SGA) + gi) = *(const bf16x8*)(lds + OFF_SG + row * PITCH + cgp * 16);
            *(bf16x8*)((dummy ? (bf16*)a.out + (size_t)T * DM : WC) + gi) = *(const bf16x8*)(lds + OFF_WC + row * PITCH + cgp * 16); }
    }
    __syncthreads();
}
__device__ __forceinline__ void krope_phase(const Args& a) {
    const float* KROPE = (const float*)(a.ws + WS_KROPE); unsigned* KR = (unsigned*)(a.ws + WS_KR); const f32x2* cs = (const f32x2*)(a.ws + WS_CS);
    int tid_ = threadIdx.x; asm volatile("" : "+v"(tid_));
    for (int e = blockIdx.x * 512 + tid_; e < T * 32; e += gridDim.x * 512) {
        const int t = e >> 5, i = e & 31; const float x1 = KROPE[t * 64 + i], x2 = KROPE[t * 64 + 32 + i]; const f32x2 v = cs[e];
        KR[e] = cvt_pk_bf16(x1 * v.x - x2 * v.y, x2 * v.x + x1 * v.y);
    }
}
__device__ __forceinline__ void final_phase(const Args& a) {
    OPAQUE_TID();
    for (int row0 = gw; row0 < T; row0 += 2 * NGW) {
        f32x4 v[2][4];
#pragma unroll
        for (int q = 0; q < 2; ++q) { const f32x4* xr = (const f32x4*)(a.out + (size_t)(row0 + q * NGW) * DM) + lane;
#pragma unroll
            for (int j = 0; j < 4; ++j) v[q][j] = xr[64 * j]; }
#pragma unroll
        for (int q = 0; q < 2; ++q) { float s = 0.f;
#pragma unroll
            for (int j = 0; j < 4; ++j) s += sumsq4(v[q][j]);
            const float rstd = __builtin_amdgcn_rsqf(wave_sum(s) * (1.0f / 1024.0f) + EPS);
            f32x4* xr = (f32x4*)(a.out + (size_t)(row0 + q * NGW) * DM) + lane; const f32x4* g = (const f32x4*)a.fg + lane;
#pragma unroll
            for (int j = 0; j < 4; ++j) xr[64 * j] = v[q][j] * rstd * g[64 * j]; }
    }
}
namespace att {
constexpr int KVBLK = 64, QB = 256;
constexpr int KP = 272, RP = 144;
constexpr int SHM_V = 16384, SHM_K = 64 * KP, SHM_R = 64 * RP;
constexpr int OFF_V = 0, OFF_K = 3 * SHM_V, OFF_R = OFF_K + 2 * SHM_K, OFF_QR = OFF_R + 2 * SHM_R  , OFF_WS = OFF_QR + 32768, OFF_CARRY = OFF_WS + 2048, ATT_LDS = OFF_CARRY + 1024;
static_assert(OFF_WS >= 131072 && ATT_LDS <= LDS_XB, "attention LDS map");
constexpr float SCALE = 0.07216878364870322f;
constexpr float THR = 8.f;
#define SBAR() __builtin_amdgcn_sched_barrier(0)
__device__ __forceinline__ int v_st(int k, int c) { const int kk = (k & ~0xC) | ((k & 4) << 1) | ((k & 8) >> 1); return ((kk >> 3) * 4 + (c >> 5)) * 512 + ((kk & 7) * 32 + (c & 31)) * 2; }
__device__ __forceinline__ int v_rd_base(int lane) { return ((lane & 3) << 3) | (((lane >> 2) & 3) << 6) | (((lane >> 4) & 1) << 5) | (((lane >> 5) & 1) << 8); }
constexpr int v_rd_off(int d0, int ks, int half) { return d0 * 512 + ks * 4096 + half * 2048; }
__device__ __forceinline__ int crow(int r, int hi) { return (r & 3) + 8 * (r >> 2) + 4 * hi; }
__device__ __forceinline__ unsigned cvtpk(float lo, float hi) { return pg8::cvt_pk_bf16(lo, hi); }
__device__ __forceinline__ void mask_tile(f32x16& p0, f32x16& p1, int dq) {
    const float NEG = -__builtin_inff();
#pragma unroll
    for (int r = 0; r < 16; ++r) { const int c = (r & 3) + 8 * (r >> 2);
        if (dq - c < 0) p0[r] = NEG;
        if (dq - c - 32 < 0) p1[r] = NEG; }
}
__device__ __forceinline__ void partialSM(f32x16& p0, f32x16& p1, float& m_reg, float& mn, float& alpha) {
    float pmax = p0[0];
#pragma unroll
    for (int r = 1; r < 16; ++r) pmax = fmaxf(pmax, p0[r]);
#pragma unroll
    for (int r = 0; r < 16; ++r) pmax = fmaxf(pmax, p1[r]);
    { auto rr = __builtin_amdgcn_permlane32_swap(__float_as_uint(pmax), __float_as_uint(pmax), false, false);
      pmax = fmaxf(__uint_as_float(rr[0]), __uint_as_float(rr[1])); }
    constexpr float C2 = 1.4426950408889634f * SCALE;
    if (__builtin_expect(__all((pmax - m_reg) * SCALE <= THR), 1)) { mn = m_reg; alpha = 1.f; }
    else { mn = fmaxf(m_reg, pmax); alpha = __builtin_amdgcn_exp2f((m_reg - mn) * C2); m_reg = mn; }
    const float mnL = -mn * C2;
#pragma unroll
    for (int r = 0; r < 16; ++r) p0[r] = fmaf(p0[r], C2, mnL);
#pragma unroll
    for (int r = 0; r < 16; ++r) p1[r] = fmaf(p1[r], C2, mnL);
#pragma unroll
    for (int r = 0; r < 16; ++r) p0[r] = __builtin_amdgcn_exp2f(p0[r]);
}
__device__ __forceinline__ void finishSM(f32x16& p0, f32x16& p1, float alpha, float& l_reg, bf16x8& pa0, bf16x8& pa1, bf16x8& pa2, bf16x8& pa3) {
#pragma unroll
    for (int r = 0; r < 16; ++r) p1[r] = __builtin_amdgcn_exp2f(p1[r]);
    float ps = 0;
#pragma unroll
    for (int r = 0; r < 16; ++r) ps += p0[r];
#pragma unroll
    for (int r = 0; r < 16; ++r) ps += p1[r];
    { auto rr = __builtin_amdgcn_permlane32_swap(__float_as_uint(ps), __float_as_uint(ps), false, false);
      ps = __uint_as_float(rr[0]) + __uint_as_float(rr[1]); }
    l_reg = l_reg * alpha + ps;
#define PK4(P, B_, OUT) do { unsigned a0 = cvtpk(P[B_+0], P[B_+1]), a1 = cvtpk(P[B_+2], P[B_+3]);                          \
        unsigned b0 = cvtpk(P[B_+4], P[B_+5]), b1 = cvtpk(P[B_+6], P[B_+7]);                                             \
        auto r0 = __builtin_amdgcn_permlane32_swap(a0, b0, false, false); auto r1 = __builtin_amdgcn_permlane32_swap(a1, b1, false, false); \
        u32x4 w = {r0[0], r1[0], r0[1], r1[1]}; OUT = *reinterpret_cast<bf16x8*>(&w); } while (0)
    PK4(p0, 0, pa0); PK4(p0, 8, pa1); PK4(p1, 0, pa2); PK4(p1, 8, pa3);
#undef PK4
}
template <int KB>
__device__ __forceinline__ void qkt(f32x16& p0, f32x16& p1, const char* lds, int r32, int hi, const bf16x8* qn, const char* qrr) {
    p0 = f32x16{}; p1 = f32x16{};
    bf16x8 qr[4];
#pragma unroll
    for (int d0 = 0; d0 < 4; ++d0) qr[d0] = *(const bf16x8*)(qrr + d0 * 1024);
    const char* ka = lds + OFF_K + KB * SHM_K + r32 * KP + hi * 16;
#pragma unroll
    for (int d0 = 0; d0 < 8; ++d0) {
        bf16x8 b0 = *reinterpret_cast<const bf16x8*>(ka + d0 * 32);
        bf16x8 b1 = *reinterpret_cast<const bf16x8*>(ka + d0 * 32 + 32 * KP);
        p0 = __builtin_amdgcn_mfma_f32_32x32x16_bf16(b0, qn[d0], p0, 0, 0, 0);
        p1 = __builtin_amdgcn_mfma_f32_32x32x16_bf16(b1, qn[d0], p1, 0, 0, 0); }
    const char* ra = lds + OFF_R + KB * SHM_R + r32 * RP + hi * 16;
#pragma unroll
    for (int d0 = 0; d0 < 4; ++d0) {
        bf16x8 b0 = *reinterpret_cast<const bf16x8*>(ra + d0 * 32);
        bf16x8 b1 = *reinterpret_cast<const bf16x8*>(ra + d0 * 32 + 32 * RP);
        p0 = __builtin_amdgcn_mfma_f32_32x32x16_bf16(b0, qr[d0], p0, 0, 0, 0);
        p1 = __builtin_amdgcn_mfma_f32_32x32x16_bf16(b1, qr[d0], p1, 0, 0, 0); }
}
template <int KB>
__device__ __forceinline__ void qkt_fin(f32x16& p0, f32x16& p1, f32x16& y0, f32x16& y1, float alpha, float& l_reg, bf16x8& pa0, bf16x8& pa1, bf16x8& pa2, bf16x8& pa3,
                                        const char* lds, int r32, int hi, const bf16x8* qn, const char* qrr) {
    p0 = f32x16{}; p1 = f32x16{};
    const char* ka = lds + OFF_K + KB * SHM_K + r32 * KP + hi * 16;
    const char* ra = lds + OFF_R + KB * SHM_R + r32 * RP + hi * 16;
#define QK_LD(i, X0, X1) do { if ((i) < 8) { X0 = *reinterpret_cast<const bf16x8*>(ka + (i) * 32); X1 = *reinterpret_cast<const bf16x8*>(ka + (i) * 32 + 32 * KP); } \
                              else { X0 = *reinterpret_cast<const bf16x8*>(ra + ((i) - 8) * 32); X1 = *reinterpret_cast<const bf16x8*>(ra + ((i) - 8) * 32 + 32 * RP); \
                                     Q##X0 = *(const bf16x8*)(qrr + ((i) - 8) * 1024); } } while (0)
#define QK_MM(i, X0, X1) do { const bf16x8 q_ = (i) < 8 ? qn[(i) < 8 ? (i) : 0] : Q##X0; \
        p0 = __builtin_amdgcn_mfma_f32_32x32x16_bf16(X0, q_, p0, 0, 0, 0); p1 = __builtin_amdgcn_mfma_f32_32x32x16_bf16(X1, q_, p1, 0, 0, 0); } while (0)
#define QK_PK4(P, B_, OUT) do { unsigned a0_ = cvtpk(P[B_+0], P[B_+1]), a1_ = cvtpk(P[B_+2], P[B_+3]); unsigned b0_ = cvtpk(P[B_+4], P[B_+5]), b1_ = cvtpk(P[B_+6], P[B_+7]); \
        auto r0_ = __builtin_amdgcn_permlane32_swap(a0_, b0_, false, false); auto r1_ = __builtin_amdgcn_permlane32_swap(a1_, b1_, false, false); \
        u32x4 w_ = {r0_[0], r1_[0], r0_[1], r1_[1]}; OUT = *reinterpret_cast<bf16x8*>(&w_); } while (0)
    bf16x8 A0, A1, B0, B1, C0, C1, QA0, QB0, QC0; float ps = 0.f;
    QK_LD(0, A0, A1); QK_LD(1, B0, B1); SBAR();
    QK_LD(2, C0, C1); QK_MM(0, A0, A1);
#pragma unroll
    for (int r = 0; r < 4; ++r) y1[r] = __builtin_amdgcn_exp2f(y1[r]);
    QK_PK4(y0, 0, pa0); SBAR();
    QK_LD(3, A0, A1); QK_MM(1, B0, B1);
#pragma unroll
    for (int r = 4; r < 8; ++r) y1[r] = __builtin_amdgcn_exp2f(y1[r]);
    QK_PK4(y0, 8, pa1); SBAR();
    QK_LD(4, B0, B1); QK_MM(2, C0, C1);
#pragma unroll
    for (int r = 8; r < 12; ++r) y1[r] = __builtin_amdgcn_exp2f(y1[r]);
#pragma unroll
    for (int r = 0; r < 8; ++r) ps += y0[r];
    SBAR();
    QK_LD(5, C0, C1); QK_MM(3, A0, A1);
#pragma unroll
    for (int r = 12; r < 16; ++r) y1[r] = __builtin_amdgcn_exp2f(y1[r]);
#pragma unroll
    for (int r = 8; r < 16; ++r) ps += y0[r];
    SBAR();
    QK_LD(6, A0, A1); QK_MM(4, B0, B1);
    QK_PK4(y1, 0, pa2);
#pragma unroll
    for (int r = 0; r < 8; ++r) ps += y1[r];
    SBAR();
    QK_LD(7, B0, B1); QK_MM(5, C0, C1);
    QK_PK4(y1, 8, pa3);
#pragma unroll
    for (int r = 8; r < 16; ++r) ps += y1[r];
    SBAR();
    QK_LD(8, C0, C1); QK_MM(6, A0, A1);
    { auto rr = __builtin_amdgcn_permlane32_swap(__float_as_uint(ps), __float_as_uint(ps), false, false); ps = __uint_as_float(rr[0]) + __uint_as_float(rr[1]); }
    l_reg = l_reg * alpha + ps;
    SBAR();
    QK_LD(9, A0, A1); QK_MM(7, B0, B1); SBAR();
    QK_LD(10, B0, B1); QK_MM(8, C0, C1); SBAR();
    QK_LD(11, C0, C1); QK_MM(9, A0, A1); SBAR();
    QK_MM(10, B0, B1); SBAR();
    QK_MM(11, C0, C1);
#undef QK_LD
#undef QK_MM
#undef QK_PK4
}
__device__ __forceinline__ void pv_tile(f32x16* o, int vb0, bf16x8 pa0, bf16x8 pa1, bf16x8 pa2, bf16x8 pa3) {
#define TRRD(dst, off) asm volatile("ds_read_b64_tr_b16 %0, %1 offset:%2" : "=&v"(dst) : "v"(vb0), "i"(off) : "memory")
#define PV_D0(d0) do { s16x4 l0, l1, l2, l3, h0, h1, h2, h3; constexpr int b_ = v_rd_off(d0, 0, 0); \
        TRRD(l0, b_); TRRD(h0, b_ + 2048); TRRD(l1, b_ + 4096); TRRD(h1, b_ + 6144); TRRD(l2, b_ + 8192); TRRD(h2, b_ + 10240); TRRD(l3, b_ + 12288); TRRD(h3, b_ + 14336); \
        asm volatile("s_waitcnt lgkmcnt(0)" ::: "memory"); SBAR();   \
        o[d0] = __builtin_amdgcn_mfma_f32_32x32x16_bf16(pa0, (bf16x8){l0[0], l0[1], l0[2], l0[3], h0[0], h0[1], h0[2], h0[3]}, o[d0], 0, 0, 0);   \
        o[d0] = __builtin_amdgcn_mfma_f32_32x32x16_bf16(pa1, (bf16x8){l1[0], l1[1], l1[2], l1[3], h1[0], h1[1], h1[2], h1[3]}, o[d0], 0, 0, 0);   \
        o[d0] = __builtin_amdgcn_mfma_f32_32x32x16_bf16(pa2, (bf16x8){l2[0], l2[1], l2[2], l2[3], h2[0], h2[1], h2[2], h2[3]}, o[d0], 0, 0, 0);   \
        o[d0] = __builtin_amdgcn_mfma_f32_32x32x16_bf16(pa3, (bf16x8){l3[0], l3[1], l3[2], l3[3], h3[0], h3[1], h3[2], h3[3]}, o[d0], 0, 0, 0); } while (0)
    PV_D0(0); PV_D0(1); PV_D0(2); PV_D0(3);
#undef PV_D0
#undef TRRD
}
__device__ __forceinline__ void attn_unit(int rb, int hh, int hl, int qb, unsigned char* wsb, char* lds, bool do_store = true) {
    const bf16* Qn = (const bf16*)(wsb + WS_QN); const bf16* Qr = (const bf16*)(wsb + WS_QR); const bf16* Kn = (const bf16*)(wsb + WS_KN); const bf16* Kr = (const bf16*)(wsb + WS_KR); const bf16* Vv = (const bf16*)(wsb + WS_V);
    int tid_ = threadIdx.x; asm volatile("" : "+v"(tid_));
    const int tid = tid_, wid = __builtin_amdgcn_readfirstlane(tid >> 6), lane = tid & 63, r32 = lane & 31, hi = lane >> 5;
    const int q0 = qb * QB, NT = (q0 + QB) / KVBLK;
    const int qlo = q0 + wid * 32, qm = qlo + r32 - 4 * hi;
    char* V_lds = lds + OFF_V; char* K_lds = lds + OFF_K; char* R_lds = lds + OFF_R;
    float* ws = (float*)(lds + OFF_WS) + wid * 64; float* li_l = ws; float* al_l = ws + 32;
    float* carry = (float*)(lds + OFF_CARRY);
    const int cb = (4 * hh + hl) * 128;
    const bf16* Kh = Kn + (size_t)rb * 512 + hl * 128; const bf16* Vh = Vv + (size_t)rb * 512 + hl * 128; const bf16* Rh = Kr + (size_t)rb * 64;
    const int sr = tid >> 4, sc = (tid & 15) * 8, vst0 = v_st(sr, sc), vst1 = v_st(32 + sr, sc), kws = sr * KP + sc * 2;
    const int rrow = tid >> 3, rc = (tid & 7) * 8, rws = rrow * RP + rc * 2;
    const int vb0 = (int)(uintptr_t)V_lds + v_rd_base(lane);
    bf16x8 st_v0, st_v1, st_k0, st_k1, st_r;
#define VMW() asm volatile("s_waitcnt vmcnt(0)" ::: "memory")
#define SLOAD(k0) do { st_v0 = *(const bf16x8*)(Vh + (size_t)((k0) + sr) * 512 + sc); st_v1 = *(const bf16x8*)(Vh + (size_t)((k0) + 32 + sr) * 512 + sc); \
                       st_k0 = *(const bf16x8*)(Kh + (size_t)((k0) + sr) * 512 + sc); st_k1 = *(const bf16x8*)(Kh + (size_t)((k0) + 32 + sr) * 512 + sc); \
                       st_r = *(const bf16x8*)(Rh + (size_t)((k0) + rrow) * 64 + rc); } while (0)
#define SWRITE(bf, vs) do { *(bf16x8*)(V_lds + (vs) + vst0) = st_v0; *(bf16x8*)(V_lds + (vs) + vst1) = st_v1; \
                        *(bf16x8*)(K_lds + (bf) * SHM_K + kws) = st_k0; *(bf16x8*)(K_lds + (bf) * SHM_K + kws + 32 * KP) = st_k1; \
                        *(bf16x8*)(R_lds + (bf) * SHM_R + rws) = st_r; } while (0)
    SLOAD(0);
    bf16x8 qn[8];
    const char* qrr = lds + OFF_QR + wid * 4096 + lane * 16;
    bf16x8 qrt[4];
    { const bf16* qg = Qr + (size_t)(rb + q0 + wid * 32 + r32) * 256 + hl * 64 + hi * 8;
#pragma unroll
      for (int d0 = 0; d0 < 4; ++d0) qrt[d0] = *(const bf16x8*)(qg + d0 * 16); }
    { const bf16* qrow = Qn + (size_t)(rb + q0 + wid * 32 + r32) * 512 + hl * 128 + hi * 8;
#pragma unroll
      for (int d0 = 0; d0 < 8; ++d0) qn[d0] = *(const bf16x8*)(qrow + d0 * 16); }
    __syncthreads();
#pragma unroll
    for (int d0 = 0; d0 < 4; ++d0) *(bf16x8*)(lds + OFF_QR + wid * 4096 + lane * 16 + d0 * 1024) = qrt[d0];
    if (tid < 256) { const int which = tid >> 7, c = tid & 127, kmax = qb * 2 + which; const size_t base = (size_t)(rb >> 7) * 1024 + cb + c;
        const float* sumP = (const float*)(wsb + WS_SUMP); const float* sumH = (const float*)(wsb + WS_SUMH);
        float H = 0.f;
        for (int j = 0; j < kmax; j += 8) { float hv[8], pw[8];
#pragma unroll
            for (int q = 0; q < 8; ++q) { const bool ok = j + q < kmax; hv[q] = ok ? sumH[base + (size_t)(j + q) * 1024] : 0.f; pw[q] = ok ? sumP[base + (size_t)(j + q) * 1024] : 1.f; }
#pragma unroll
            for (int q = 0; q < 8; ++q) H = hv[q] + pw[q] * H; }
        carry[which * 128 + c] = H; }
    VMW(); SWRITE(0, 0); SBAR();
    SLOAD(KVBLK);
    __syncthreads();
    float m_reg = -1e30f, l_reg = 0; f32x16 o[4] = {};
    f32x16 pA0, pA1, pB0, pB1; float mnA, mnB, alA, alB; bf16x8 pa0, pa1, pa2, pa3;
    int sl_prev = 0, sl_cur = 0, sl_next = SHM_V;
#define ROT() do { sl_prev = sl_cur; sl_cur = sl_next; sl_next = (sl_next == 2 * SHM_V) ? 0 : sl_next + SHM_V; } while (0)
#define RESC(a) do { if (__any((a) < 1.f)) { if (hi == 0) al_l[r32] = (a); asm volatile("s_waitcnt lgkmcnt(0)" ::: "memory");              \
                     for (int d_ = 0; d_ < 4; ++d_) for (int r = 0; r < 16; ++r) o[d_][r] *= al_l[crow(r, hi)]; } } while (0)
#define MASKT(P0_, P1_, t) do { const int kb_ = (t) * KVBLK; if (kb_ + KVBLK - 1 > qlo) mask_tile(P0_, P1_, qm - kb_); } while (0)
    SBAR(); qkt<0>(pA0, pA1, lds, r32, hi, qn, qrr);
    MASKT(pA0, pA1, 0); partialSM(pA0, pA1, m_reg, mnA, alA);
    VMW(); SWRITE(1, SHM_V);
    __syncthreads();
    ROT();
#define STEP(PX0, PX1, mnX, alX, PY0, PY1, alY, t, KB, LAST) do {                                                             \
        SBAR(); qkt_fin<KB>(PX0, PX1, PY0, PY1, alY, l_reg, pa0, pa1, pa2, pa3, lds, r32, hi, qn, qrr); SBAR();               \
        if (!(LAST)) { SLOAD(((t) + 1) * KVBLK); SBAR(); }                                                                    \
        pv_tile(o, vb0 + sl_prev, pa0, pa1, pa2, pa3); MASKT(PX0, PX1, (t)); partialSM(PX0, PX1, m_reg, mnX, alX);            \
        if (!(LAST)) { VMW(); SWRITE(1 - (KB), sl_next); }                                                                    \
        RESC(alX);                                                                                                            \
        if (!(LAST)) { __syncthreads(); ROT(); } } while (0)
    for (int t = 1; t + 1 < NT; t += 2) {
        STEP(pB0, pB1, mnB, alB, pA0, pA1, alA, t, 1, false);
        STEP(pA0, pA1, mnA, alA, pB0, pB1, alB, t + 1, 0, false);
    }
    STEP(pB0, pB1, mnB, alB, pA0, pA1, alA, NT - 1, 1, true);
    finishSM(pB0, pB1, alB, l_reg, pa0, pa1, pa2, pa3); SBAR(); pv_tile(o, vb0 + sl_cur, pa0, pa1, pa2, pa3);
    if (hi == 0) li_l[r32] = l_reg; asm volatile("s_waitcnt lgkmcnt(0)" ::: "memory");
    __syncthreads();
    {
        float* stg = (float*)lds + wid * 4096;
#pragma unroll
        for (int r = 0; r < 16; ++r) { const int orow = crow(r, hi); const float rl = __builtin_amdgcn_rcpf(li_l[orow]);
#pragma unroll
            for (int d0 = 0; d0 < 4; ++d0) stg[orow * 128 + d0 * 32 + r32] = o[d0][r] * rl; }
        asm volatile("s_waitcnt lgkmcnt(0)" ::: "memory");
        const float* cr = carry + (wid >> 2) * 128 + (lane & 15) * 8;
        const f32x4 h0 = *(const f32x4*)cr, h1 = *(const f32x4*)(cr + 4);
        const size_t gbase = (size_t)(rb + q0 + wid * 32 + (lane >> 4)) * DM + cb + (lane & 15) * 8;
        const bf16* U = (const bf16*)(wsb + WS_SGA) + gbase; const bf16* WC = (const bf16*)(wsb + WS_XS) + gbase; const bf16* SGB = (const bf16*)(wsb + WS_SGB) + gbase; bf16* Y = (bf16*)(wsb + WS_XL) + gbase;
        const float* sp = stg + (lane >> 4) * 128 + (lane & 15) * 8;
#pragma unroll 2
        for (int i = 0; i < 8; ++i) {
            const bf16x8 u = *(const bf16x8*)(U + (size_t)i * 4 * DM), w = *(const bf16x8*)(WC + (size_t)i * 4 * DM), g = *(const bf16x8*)(SGB + (size_t)i * 4 * DM);
            const f32x4 v0 = *(const f32x4*)(sp + i * 512), v1 = *(const f32x4*)(sp + i * 512 + 4);
            f32x4 y0, y1;
#pragma unroll
            for (int e = 0; e < 4; ++e) { y0[e] = bf2f((bf16)u[e]) + bf2f((bf16)w[e]) * h0[e] + bf2f((bf16)g[e]) * v0[e];
                                          y1[e] = bf2f((bf16)u[4 + e]) + bf2f((bf16)w[4 + e]) * h1[e] + bf2f((bf16)g[4 + e]) * v1[e]; }
            if (do_store) store8bf(Y + (size_t)i * 4 * DM, y0, y1);
        }
    }
#undef RESC
#undef MASKT
#undef STEP
#undef ROT
#undef SLOAD
#undef SWRITE
#undef VMW
}
#undef SBAR
}
__global__ void __launch_bounds__(512, 2) fwd_megakernel(Args a) {
    extern __shared__ __attribute__((aligned(16))) unsigned char lds[];
    cg::grid_group grid = cg::this_grid();
    {
        if (threadIdx.x < 8) ((LAS unsigned*)(lds + LDS_XB))[threadIdx.x] = 0u;
        __syncthreads();
    }
    grid.sync();
    (void)xcd_barrier_post((unsigned*)(a.ws + WS_BAR), (volatile LAS unsigned*)((LAS unsigned char*)lds + LDS_XB));
#define GSYNC() do { XcdBarrier b_; b_.bar = (unsigned*)(a.ws + WS_BAR); b_.x = xb_xcc_id(); b_.st = (volatile LAS unsigned*)((LAS unsigned char*)lds + LDS_XB); xcd_barrier(b_); } while (0)
    const int G = gridDim.x;
    LAS unsigned char* ldsl = (LAS unsigned char*)lds;
    unsigned char* ws = a.ws;
    float* mod = (float*)(ws + WS_MOD); float* ss = (float*)(ws + WS_SS);
    bf16* XS = (bf16*)(ws + WS_XS); bf16* XL = (bf16*)(ws + WS_XL); bf16* SGA = (bf16*)(ws + WS_SGA); bf16* SGB = (bf16*)(ws + WS_SGB); bf16* UU = (bf16*)(ws + WS_UU);
    bf16* QD = (bf16*)(ws + WS_QD); bf16* KVD = (bf16*)(ws + WS_KVD); float* KROPE = (float*)(ws + WS_KROPE); bf16* KR = (bf16*)(ws + WS_KR);
    bf16* QN = (bf16*)(ws + WS_QN); bf16* QR = (bf16*)(ws + WS_QR); bf16* KN = (bf16*)(ws + WS_KN); bf16* VV = (bf16*)(ws + WS_V);

#ifndef PHM
#define PHM 0xFFFF
#endif
    if (PHM & 1) phase0(a, ldsl);
    GSYNC();
    if (PHM & 2) phase1(a);
    GSYNC();
#ifdef PROBE_P01
    phase0(a, ldsl);
    GSYNC();
    phase1(a);
    GSYNC();
#endif
    for (int l = 0; l < DEPTH; ++l) {
        unsigned char* wl = ws + WS_W + (size_t)l * WL_STRIDE;
        float* ssA = ss + (size_t)(4 * l) * T; float* ssB = ssA + T; float* ssQ = ssA + 2 * T; float* ssKV = ssA + 3 * T; float* ssN = ssA + 4 * T;
        const float* modl = mod + (size_t)l * 4 * NMOD;
        if (PHM & 4) {
            pg8::Gemm g{(const bf16*)XS, (const bf16*)(wl + WL_IN), T, DINP, DM}; pg8::StaticOrder S; S.init(T, DINP, G, (int)blockIdx.x);
            EpiIn E{ssA, (const float*)(ws + WS_SHWIN) + (size_t)l * 4 * DINP, XL, QD, KVD, KROPE, SGA, SGB, ssQ, ssKV};
            pg8::gemm_phase<EpiIn, pg8::StaticOrder, true, true>(ldsl, g, S, E);
        }
        GSYNC();
        for (int hh = 0; hh < 2; ++hh) {
#ifdef PROBE_LRU2
            if (hh == 0 && l == 0) { lru_phase(a, l, (char*)lds, true); lru_phase(a, l, (char*)lds, true); }
#endif
            if ((PHM & 8) && hh == 0) { lru_phase(a, l, (char*)lds); krope_phase(a); }
            if (PHM & 16) {
                int Kq = 256; asm volatile("" : "+s"(Kq));
                pg8::Gemm g{(const bf16*)QD, (const bf16*)(wl + WL_UQ) + (size_t)hh * 768 * 256, T, 768, Kq}; pg8::StaticOrder S; S.init(T, 768, G, (int)blockIdx.x);
                EpiQ E{ssQ, (const float*)(ws + WS_CS), QN, QR};
                pg8::gemm_phase<EpiQ, pg8::StaticOrder, true, true>(ldsl, g, S, E);
            }
            if (PHM & 32) {
                int Kk = 128; asm volatile("" : "+s"(Kk));
                pg8::Gemm g{(const bf16*)KVD, (const bf16*)(wl + WL_UKV) + (size_t)hh * 1024 * 128, T, 1024, Kk}; pg8::StaticOrder S; S.init(T, 1024, G, (int)blockIdx.x);
                EpiKV E{ssKV, KN, VV};
                pg8::gemm_phase<EpiKV, pg8::StaticOrder, true, true>(ldsl, g, S, E);
            }
#ifdef PROBE_QKV2
            {
                int Kq = 256; asm volatile("" : "+s"(Kq));
                pg8::Gemm g{(const bf16*)QD, (const bf16*)(wl + WL_UQ) + (size_t)hh * 768 * 256, T, 768, Kq}; pg8::StaticOrder S; S.init(T, 768, G, (int)blockIdx.x);
                EpiQ E{ssQ, (const float*)(ws + WS_CS), QN, QR};
                pg8::gemm_phase<EpiQ, pg8::StaticOrder, true, true>(ldsl, g, S, E);
            }
            {
                int Kk = 128; asm volatile("" : "+s"(Kk));
                pg8::Gemm g{(const bf16*)KVD, (const bf16*)(wl + WL_UKV) + (size_t)hh * 1024 * 128, T, 1024, Kk}; pg8::StaticOrder S; S.init(T, 1024, G, (int)blockIdx.x);
                EpiKV E{ssKV, KN, VV};
                pg8::gemm_phase<EpiKV, pg8::StaticOrder, true, true>(ldsl, g, S, E);
            }
#endif
            GSYNC();
            const int vcu = (G % 8 == 0) ? (int)(blockIdx.x & 7) * (G / 8) + (int)(blockIdx.x >> 3) : (int)blockIdx.x;
            if (PHM & 64) for (int p2 = 2 * vcu; p2 < 512; p2 += ((p2 & 1) ? 2 * G - 1 : 1)) {
                const int p = p2 >> 1, bh = p >> 4, s = p & 15, b = bh >> 2, hl = bh & 3;
                att::attn_unit(b * SEQ, hh, hl, (p2 & 1) ? s : 31 - s, ws, (char*)lds);
            }
#ifdef PROBE_ATT2
#ifndef PROBE_NOSYNC
            GSYNC();
#endif
            if (hh == PROBE_ATT2 - 1) for (int p2 = 2 * blockIdx.x; p2 < 512; p2 += ((p2 & 1) ? 2 * G - 1 : 1)) {
                const int p = p2 >> 1, bh = p >> 4, s = p & 15, b = bh >> 2, hl = bh & 3;
                att::attn_unit(b * SEQ, hh, hl, (p2 & 1) ? s : 31 - s, ws, (char*)lds, PROBE_STORE);
            }
#endif
            GSYNC();
        }
        if (PHM & 128) {
            pg8::Gemm g{(const bf16*)XL, (const bf16*)(wl + WL_OUT), T, DM, DM}; pg8::StaticOrder S; S.init(T, DM, G, (int)blockIdx.x);
            EpiRes E{l == 0 ? a.x : a.out, a.out, modl + 2048, modl + 4096, XS, ssB};
            pg8::gemm_phase<EpiRes, pg8::StaticOrder, true, true>(ldsl, g, S, E);
        }
        GSYNC();
        if (PHM & 256) {
            pg8::Gemm g{(const bf16*)XS, (const bf16*)(wl + WL_FFI), T, 2 * DFF, DM}; pg8::StaticOrder S; S.init(T, 2 * DFF, G, (int)blockIdx.x);
            EpiFfi E{ssB, (const float*)(ws + WS_SHWF) + (size_t)l * 4 * 2 * DFF, UU};
            pg8::gemm_phase<EpiFfi, pg8::StaticOrder, true, true>(ldsl, g, S, E);
#ifdef PROBE_FFI2
            GSYNC();
            pg8::gemm_phase<EpiFfi, pg8::StaticOrder, true, true>(ldsl, g, S, E);
#endif
        }
        GSYNC();
        if (PHM & 512) {
            pg8::Gemm g{(const bf16*)UU, (const bf16*)(wl + WL_FFO), T, DM, DFF}; pg8::StaticOrder S; S.init(T, DM, G, (int)blockIdx.x);
            EpiRes E{a.out, a.out, modl + 5120, (l + 1 < DEPTH) ? modl + 4 * NMOD + 1024 : nullptr, XS, ssN};
            pg8::gemm_phase<EpiRes, pg8::StaticOrder, true, true>(ldsl, g, S, E);
        }
        GSYNC();
    }
    if (PHM & 1024) final_phase(a);
}

extern "C" void kernel_launch(void* const* d_in, const int* in_sizes, int n_in, void* d_out, int out_size, void* d_ws, size_t ws_size, hipStream_t stream) {
    static int grid = 0;
    if (grid == 0) {
        int dev = 0, cus = 0, per_cu = 0;
        if (hipGetDevice(&dev) != hipSuccess || hipDeviceGetAttribute(&cus, hipDeviceAttributeMultiprocessorCount, dev) != hipSuccess) { grid = -1; return; }
        if (hipFuncSetAttribute((const void*)fwd_megakernel, hipFuncAttributeMaxDynamicSharedMemorySize, LDS_BYTES) != hipSuccess) { fprintf(stderr, "hipFuncSetAttribute failed\n"); grid = -1; return; }
        if (hipOccupancyMaxActiveBlocksPerMultiprocessor(&per_cu, (const void*)fwd_megakernel, 512, LDS_BYTES) != hipSuccess || per_cu < 1) per_cu = 1;
        (void)hipGetLastError();
        grid = cus;
        if (ws_size < WS_END) { fprintf(stderr, "workspace too small: %zu < %zu\n", ws_size, (size_t)WS_END); grid = -1; return; }
    }
    if (grid < 0) return;
    Args a{};
    a.x = (const float*)d_in[0]; a.c = (const float*)d_in[1]; a.pos = (const int*)d_in[2]; a.w_ada = (const float*)d_in[3]; a.b_ada = (const float*)d_in[4];
    a.w_in = (const float*)d_in[5]; a.conv_w = (const float*)d_in[6]; a.conv_b = (const float*)d_in[7]; a.lru_wa = (const float*)d_in[8]; a.lru_ba = (const float*)d_in[9];
    a.lru_wx = (const float*)d_in[10]; a.lru_bx = (const float*)d_in[11]; a.lru_a = (const float*)d_in[12]; a.qg = (const float*)d_in[13]; a.kvg = (const float*)d_in[14];
    a.w_uq = (const float*)d_in[15]; a.w_ukv = (const float*)d_in[16]; a.w_out = (const float*)d_in[17]; a.w_ffi = (const float*)d_in[18]; a.w_ffo = (const float*)d_in[19];
    a.fg = (const float*)d_in[20]; a.out = (float*)d_out; a.ws = (unsigned char*)d_ws;
    if (hipMemsetAsync((char*)d_ws + WS_BAR, 0, 16384, stream) != hipSuccess) { fprintf(stderr, "memset failed\n"); return; }
    void* args[] = {&a};
    hipError_t e = hipLaunchCooperativeKernel((const void*)fwd_megakernel, dim3(grid), dim3(512), args, LDS_BYTES, stream);
    if (e != hipSuccess) fprintf(stderr, "cooperative launch failed: %s (grid %d)\n", hipGetErrorString(e), grid);
}
```

```cpp
#include <hip/hip_runtime.h>
#include <hip/hip_cooperative_groups.h>
#include <hip/hip_bf16.h>
#include <cstdio>
#include <cstdint>
namespace cg = cooperative_groups;
namespace pg8 {
#define PG8_LAS __attribute__((address_space(3)))
typedef unsigned short bf16_t;
typedef short bf16x8 __attribute__((ext_vector_type(8)));
typedef float f32x4 __attribute__((ext_vector_type(4)));
typedef unsigned u32x4 __attribute__((ext_vector_type(4)));
constexpr int BM = 256, BK = 64, HALF = 128, HTB = HALF * BK * 2  , STAGE_BYTES = 8 * HTB, NXCD = 8, WGM = 8;

__host__ __device__ __forceinline__ int lds_byte(int r, int c) { const int st = (r >> 4) * 2 + (c >> 5), rr = r & 15, cc = c & 31, ob = rr * 64 + cc * 2; return st * 1024 + (ob ^ (((ob >> 9) & 1) << 5)); }
__host__ __device__ __forceinline__ void stage_rc(int b, int& R, int& C) { const int st = b / 1024, sb = b % 1024, swz = sb ^ (((sb >> 9) & 1) << 5); R = (st >> 1) * 16 + swz / 64; C = (st & 1) * 32 + (swz % 64) / 2; }
__host__ __device__ __forceinline__ int perm32(int rho) { const int n = rho >> 4, i = rho & 15; return 8 * (i >> 2) + 4 * n + (i & 3); }

struct Unit { int pm, pn; };
struct Gemm { const bf16_t* A; const bf16_t* Bt; int M, N, K; };

struct StaticOrder {
    int nM, nN, nwg, G, c;
    __host__ __device__ void init(int M, int N, int G_, int c_) { nM = M / BM; nN = N / BM; nwg = nM * nN; G = G_; c = c_; }
    __host__ __device__ bool next(int i, Unit& u) const {
        const long L = (long)i * G + c; if (L >= nwg) return false;
        int wgid = (int)L; { const int q = nwg / NXCD, r = nwg % NXCD, xcd = wgid % NXCD, off = wgid / NXCD; wgid = (xcd < r ? xcd * (q + 1) : r * (q + 1) + (xcd - r) * q) + off; }
        const int nig = WGM * nN, gid = wgid / nig, fm = gid * WGM, gsz = (nM - fm) < WGM ? (nM - fm) : WGM;
        u.pm = fm + ((wgid % nig) % gsz); u.pn = (wgid % nig) / gsz; return true;
    }
    __device__ __forceinline__ void a_ready(const Unit&) const {}
    __device__ __forceinline__ void done(const Unit&) const {}
};

typedef float cvt_f32x2_t __attribute__((ext_vector_type(2))); typedef __bf16 cvt_bf16x2_t __attribute__((ext_vector_type(2)));
__device__ __forceinline__ unsigned cvt_pk_bf16(float lo, float hi) { cvt_f32x2_t v = {lo, hi}; cvt_bf16x2_t b = __builtin_convertvector(v, cvt_bf16x2_t); return __builtin_bit_cast(unsigned, b); }
typedef float f32x2 __attribute__((ext_vector_type(2)));
template <class Epi, class Sched, bool ALIGN_EPI = false, bool SP2 = false>
__device__ __forceinline__ void gemm_phase(PG8_LAS unsigned char* lds, const Gemm g, const Sched& S, const Epi& E) {
    int tid_ = threadIdx.x; asm volatile("" : "+v"(tid_));
    const int tid = tid_, wid = __builtin_amdgcn_readfirstlane(tid >> 6), lane = tid & 63, wr = wid >> 2, wc = wid & 3, fr = lane & 15, fq = lane >> 4;
    const int K = g.K, nt = K / BK;
    unsigned voffA[2], voffB[2];
#pragma unroll
    for (int i = 0; i < 2; ++i) { int R, C; stage_rc(tid * 16 + i * 8192, R, C); const int Rb = Epi::PERM ? ((R & ~31) + perm32(R & 31)) : R;
        voffA[i] = (unsigned)(R * K + C) * 2u; voffB[i] = (unsigned)(Rb * K + C) * 2u; }
    const size_t kstep = (size_t)(BK * 2);
    const size_t hstep = (size_t)HALF * K * 2;
    const size_t tstep = 2 * hstep;
    const unsigned ldsw = (unsigned)wid * 1024u;
    const int aoff = lds_byte(wr * 64 + fr, fq * 8), boff = lds_byte(wc * 32 + fr, fq * 8);
#define PG8_SA(b, h) (((b) * 2 + (h)) * HTB)
#define PG8_SB(b, h) ((4 + (b) * 2 + (h)) * HTB)
#define PG8_STAGE(bufoff, gbase, voff) do { _Pragma("unroll") for (int _i = 0; _i < 2; ++_i) \
        __builtin_amdgcn_global_load_lds((const unsigned*)((const char*)(gbase) + (voff)[_i]), (PG8_LAS unsigned*)(lds + (bufoff) + ldsw + _i * 8192), 16, 0, 0); } while (0)
#define PG8_LDA(dst, b, h) do { _Pragma("unroll") for (int m = 0; m < 4; ++m) _Pragma("unroll") for (int k = 0; k < 2; ++k) dst[m][k] = *(const PG8_LAS bf16x8*)(lds + PG8_SA(b, h) + aoff + m * 2048 + k * 1024); } while (0)
#define PG8_LDB(dst, b, h) do { _Pragma("unroll") for (int n = 0; n < 2; ++n) _Pragma("unroll") for (int k = 0; k < 2; ++k) dst[n][k] = *(const PG8_LAS bf16x8*)(lds + PG8_SB(b, h) + boff + n * 2048 + k * 1024); } while (0)
#define PG8_MMA(ai, bj, At, Bt) do { __builtin_amdgcn_s_setprio(1); _Pragma("unroll") for (int m = 0; m < 4; ++m) _Pragma("unroll") for (int n = 0; n < 2; ++n) _Pragma("unroll") for (int k = 0; k < 2; ++k) \
        acc[ai][bj][m][n] = __builtin_amdgcn_mfma_f32_16x16x32_bf16(Bt[n][k], At[m][k], acc[ai][bj][m][n], 0, 0, 0); __builtin_amdgcn_s_setprio(0); } while (0)
#define PG8_WAIT_V(n) asm volatile("s_waitcnt vmcnt(" #n ")" ::: "memory")
#define PG8_WAIT_L(n) asm volatile("s_waitcnt lgkmcnt(" #n ")" ::: "memory")
#define PG8_BAR __builtin_amdgcn_s_barrier()
#define PG8_SCHED __builtin_amdgcn_sched_barrier(0)
    Unit cur, nxt; int ui = 0;
    if (!S.next(0, cur)) return;
    f32x4 acc[2][2][4][2];
#pragma unroll
    for (int a = 0; a < 2; ++a)
#pragma unroll
        for (int b = 0; b < 2; ++b)
#pragma unroll
            for (int m = 0; m < 4; ++m)
#pragma unroll
                for (int n = 0; n < 2; ++n) acc[a][b][m][n] = (f32x4){0.f, 0.f, 0.f, 0.f};
    bf16x8 At[4][2], B0[2][2], B1[2][2];
    const char* cA = (const char*)g.A + (size_t)cur.pm * tstep; const char* cB = (const char*)g.Bt + (size_t)cur.pn * tstep;
    S.a_ready(cur);
    if constexpr (SP2) {
        PG8_STAGE(PG8_SB(0, 0), cB, voffB); PG8_STAGE(PG8_SB(0, 1), cB + hstep, voffB); PG8_STAGE(PG8_SA(0, 0), cA, voffA); PG8_STAGE(PG8_SA(0, 1), cA + hstep, voffA);
        if (wr == 1) PG8_BAR;
        PG8_WAIT_V(2); PG8_BAR;
        PG8_STAGE(PG8_SB(1, 0), cB + kstep, voffB); PG8_STAGE(PG8_SA(1, 0), cA + kstep, voffA); PG8_STAGE(PG8_SB(1, 1), cB + hstep + kstep, voffB);
        PG8_WAIT_V(6); PG8_BAR;
    } else {
        PG8_STAGE(PG8_SB(0, 0), cB, voffB); PG8_STAGE(PG8_SA(0, 0), cA, voffA); PG8_STAGE(PG8_SB(0, 1), cB + hstep, voffB); PG8_STAGE(PG8_SA(0, 1), cA + hstep, voffA);
        if (wr == 1) PG8_BAR;
        PG8_WAIT_V(4); PG8_BAR;
        PG8_STAGE(PG8_SB(1, 0), cB + kstep, voffB); PG8_STAGE(PG8_SA(1, 0), cA + kstep, voffA); PG8_STAGE(PG8_SB(1, 1), cB + hstep + kstep, voffB);
        PG8_WAIT_V(6); PG8_BAR;
    }
    for (;;) {
        const bool has_next = S.next(ui + 1, nxt);
        const char* nA = has_next ? (const char*)g.A + (size_t)nxt.pm * tstep : cA; const char* nB = has_next ? (const char*)g.Bt + (size_t)nxt.pn * tstep : cB;
        for (int t = 0; t < nt; t += 2) {
            const bool last = (t == nt - 2);
            const char* a1 = cA + (size_t)(t + 1) * kstep;
            const char* a2 = last ? nA : cA + (size_t)(t + 2) * kstep; const char* b2 = last ? nB : cB + (size_t)(t + 2) * kstep;
            const char* a3 = a2 + kstep; const char* b3 = b2 + kstep;
            if (last && has_next) S.a_ready(nxt);
            if constexpr (SP2) {
            PG8_LDB(B0, 0, 0); PG8_LDB(B1, 0, 1); PG8_SCHED; PG8_LDA(At, 0, 0); PG8_STAGE(PG8_SA(1, 1), a1 + hstep, voffA);
            PG8_WAIT_V(8); PG8_WAIT_L(0); PG8_BAR; PG8_MMA(0, 0, At, B0); PG8_MMA(0, 1, At, B1); PG8_BAR; PG8_SCHED;
            PG8_LDA(At, 0, 1); PG8_STAGE(PG8_SB(0, 0), b2, voffB); PG8_STAGE(PG8_SB(0, 1), b2 + hstep, voffB); PG8_STAGE(PG8_SA(0, 0), a2, voffA);
            PG8_WAIT_V(8); PG8_WAIT_L(0); PG8_BAR; PG8_MMA(1, 0, At, B0); PG8_MMA(1, 1, At, B1); PG8_BAR; PG8_SCHED;
            PG8_LDB(B0, 1, 0); PG8_LDB(B1, 1, 1); PG8_SCHED; PG8_LDA(At, 1, 0); PG8_STAGE(PG8_SA(0, 1), a2 + hstep, voffA);
            PG8_WAIT_V(8); PG8_WAIT_L(0); PG8_BAR; PG8_MMA(0, 0, At, B0); PG8_MMA(0, 1, At, B1); PG8_BAR; PG8_SCHED;
            PG8_LDA(At, 1, 1); PG8_STAGE(PG8_SB(1, 0), b3, voffB); PG8_STAGE(PG8_SB(1, 1), b3 + hstep, voffB); PG8_STAGE(PG8_SA(1, 0), a3, voffA);
            PG8_WAIT_V(8); PG8_WAIT_L(0); PG8_BAR; PG8_MMA(1, 0, At, B0); PG8_MMA(1, 1, At, B1); PG8_BAR; PG8_SCHED;
            } else {
            PG8_LDB(B0, 0, 0); PG8_SCHED; PG8_LDA(At, 0, 0); PG8_STAGE(PG8_SA(1, 1), a1 + hstep, voffA);
            PG8_WAIT_L(8); PG8_BAR; PG8_WAIT_L(0); PG8_MMA(0, 0, At, B0); PG8_BAR; PG8_SCHED;
            PG8_LDB(B1, 0, 1); PG8_STAGE(PG8_SB(0, 0), b2, voffB);
            PG8_BAR; PG8_WAIT_L(0); PG8_MMA(0, 1, At, B1); PG8_BAR;
            PG8_LDA(At, 0, 1); PG8_STAGE(PG8_SA(0, 0), a2, voffA);
            PG8_BAR; PG8_WAIT_L(0); PG8_MMA(1, 0, At, B0); PG8_BAR; PG8_SCHED;
            PG8_STAGE(PG8_SB(0, 1), b2 + hstep, voffB);
            PG8_WAIT_V(6); PG8_BAR; PG8_MMA(1, 1, At, B1); PG8_BAR;
            PG8_LDB(B0, 1, 0); PG8_SCHED; PG8_LDA(At, 1, 0); PG8_STAGE(PG8_SA(0, 1), a2 + hstep, voffA);
            PG8_WAIT_L(8); PG8_BAR; PG8_WAIT_L(0); PG8_MMA(0, 0, At, B0); PG8_BAR; PG8_SCHED;
            PG8_LDB(B1, 1, 1); PG8_STAGE(PG8_SB(1, 0), b3, voffB);
            PG8_BAR; PG8_WAIT_L(0); PG8_MMA(0, 1, At, B1); PG8_BAR;
            PG8_LDA(At, 1, 1); PG8_STAGE(PG8_SA(1, 0), a3, voffA);
            PG8_BAR; PG8_WAIT_L(0); PG8_MMA(1, 0, At, B0); PG8_BAR; PG8_SCHED;
            PG8_STAGE(PG8_SB(1, 1), b3 + hstep, voffB);
            PG8_WAIT_V(6); PG8_BAR; PG8_MMA(1, 1, At, B1); PG8_BAR;
            }
        }
        if constexpr (ALIGN_EPI) { if (wr == 0) PG8_BAR; }
        if constexpr (!Epi::AFTER_DRAIN) { E(acc, cur, wr, wc, fr, fq); S.done(cur); }
        if (!has_next) break;
#pragma unroll
        for (int a = 0; a < 2; ++a)
#pragma unroll
            for (int b = 0; b < 2; ++b)
#pragma unroll
                for (int m = 0; m < 4; ++m)
#pragma unroll
                    for (int n = 0; n < 2; ++n) acc[a][b][m][n] = (f32x4){0.f, 0.f, 0.f, 0.f};
        cur = nxt; cA = nA; cB = nB; ++ui;
        if constexpr (ALIGN_EPI) { if (wr == 1) PG8_BAR; }
    }
    PG8_WAIT_V(0);
    if constexpr (!ALIGN_EPI) { if (wr == 0) PG8_BAR; }
    PG8_BAR;
    if constexpr (Epi::AFTER_DRAIN) { E.fused(acc, cur, wr, wc, fr, fq, lds, wid, lane); S.done(cur); }
#undef PG8_SA
#undef PG8_SB
#undef PG8_STAGE
#undef PG8_LDA
#undef PG8_LDB
#undef PG8_MMA
#undef PG8_WAIT_V
#undef PG8_WAIT_L
#undef PG8_BAR
#undef PG8_SCHED
}
}
#define LAS __attribute__((address_space(3)))
typedef unsigned short bf16;
typedef float f32x4 __attribute__((ext_vector_type(4)));
typedef float f32x2 __attribute__((ext_vector_type(2)));
typedef float f32x16 __attribute__((ext_vector_type(16)));
typedef unsigned u32x4 __attribute__((ext_vector_type(4)));
typedef unsigned u32x2 __attribute__((ext_vector_type(2)));
typedef short bf16x8 __attribute__((ext_vector_type(8)));
typedef short s16x4 __attribute__((ext_vector_type(4)));
using pg8::Unit; using pg8::cvt_pk_bf16;

constexpr int NB = 4, SEQ = 8192, T = NB * SEQ, DM = 1024, DEPTH = 2, DINP = 3584, DFF = 2816, NMOD = 6144;
constexpr float EPS = 1e-6f;
constexpr size_t MiB = 1u << 20;
constexpr size_t WS_MOD = 0, WS_SHWIN = 256 * 1024, WS_SHWF = 512 * 1024, WS_SS = 1 * MiB, WS_SUMP = 3 * MiB, WS_SUMH = 4 * MiB, WS_CS = 8 * MiB, WS_W = 16 * MiB;
constexpr size_t WL_STRIDE = 28 * MiB, WL_IN = 0, WL_OUT = 7 * MiB, WL_FFI = 9 * MiB, WL_FFO = 20 * MiB, WL_UQ = 25 * MiB + 512 * 1024, WL_UKV = 26 * MiB + 256 * 1024, WL_LRU = 26 * MiB + 768 * 1024;
constexpr size_t WS_XS = 72 * MiB, WS_XL = 136 * MiB, WS_SGA = 200 * MiB, WS_SGB = 264 * MiB, WS_UU = 136 * MiB, WS_QD = 328 * MiB, WS_KVD = 344 * MiB, WS_KROPE = 352 * MiB,
                 WS_KR = 360 * MiB, WS_QN = 364 * MiB, WS_QR = 396 * MiB, WS_KN = 412 * MiB, WS_V = 444 * MiB, WS_END = 476 * MiB;
constexpr size_t WS_BAR = 5 * MiB;
constexpr int LDS_BYTES = 147456, LDS_XB = 144384;

__device__ const float INV_FREQ[32] = {1.0f, 0.7498942613601685f, 0.5623413324356079f, 0.4216965138912201f, 0.3162277638912201f, 0.23713737726211548f, 0.17782793939113617f, 0.133352130651474f, 0.10000000149011612f, 0.07498941570520401f, 0.05623413249850273f, 0.04216965287923813f, 0.03162277489900589f, 0.023713737726211548f, 0.017782794311642647f, 0.01333521492779255f, 0.009999999776482582f, 0.007498941849917173f, 0.005623413249850273f, 0.0042169648222625256f, 0.003162277629598975f, 0.00237137358635664f, 0.0017782794311642647f, 0.0013335214462131262f, 0.0010000000474974513f, 0.0007498942431993783f, 0.000562341301701963f, 0.0004216965171508491f, 0.0003162277571391314f, 0.00023713737027719617f, 0.00017782794020604342f, 0.0001333521504420787f};

struct Args {
    const float* x; const float* c; const int* pos; const float* w_ada; const float* b_ada; const float* w_in; const float* conv_w; const float* conv_b;
    const float* lru_wa; const float* lru_ba; const float* lru_wx; const float* lru_bx; const float* lru_a; const float* qg; const float* kvg;
    const float* w_uq; const float* w_ukv; const float* w_out; const float* w_ffi; const float* w_ffo; const float* fg;
    float* out; unsigned char* ws;
};

__device__ __forceinline__ float bf2f(bf16 u) { return __uint_as_float(((unsigned)u) << 16); }
__device__ __forceinline__ unsigned f2bf(float f) { unsigned u = __float_as_uint(f); return (u + 0x7fffu + ((u >> 16) & 1u)) >> 16; }
__device__ __forceinline__ float sigmoidf_(float x) { return __builtin_amdgcn_rcpf(1.0f + __builtin_amdgcn_exp2f(-1.4426950408889634f * x)); }
__device__ __forceinline__ void store8bf(bf16* p, f32x4 a, f32x4 b) { u32x4 w; w.x = cvt_pk_bf16(a[0], a[1]); w.y = cvt_pk_bf16(a[2], a[3]); w.z = cvt_pk_bf16(b[0], b[1]); w.w = cvt_pk_bf16(b[2], b[3]); *(u32x4*)p = w; }
__device__ __forceinline__ float sumsq4(f32x4 v) { return (v[0] * v[0] + v[1] * v[1]) + (v[2] * v[2] + v[3] * v[3]); }
__device__ __forceinline__ void atomic_addf(float* p, float v) { (void)__hip_atomic_fetch_add(p, v, __ATOMIC_RELAXED, __HIP_MEMORY_SCOPE_AGENT); }
__device__ __forceinline__ float wave_sum(float v) {
#pragma unroll
    for (int o = 1; o < 64; o <<= 1) v += __shfl_xor(v, o);
    return v;
}
#define LDS_WAIT() asm volatile("s_waitcnt lgkmcnt(0)" ::: "memory")

struct EpiIn {
    static constexpr bool PERM = true, AFTER_DRAIN = false;
    const float* ss; const float* shw; bf16* XL; bf16* QD; bf16* KVD; float* KROPE; bf16* SGA; bf16* SGB; float* ssq; float* sskv;
    __device__ __forceinline__ void operator()(const f32x4 (&acc)[2][2][4][2], const Unit& u, int wr, int wc, int fr, int fq) const {
        const int row0 = u.pm * 256 + wr * 64 + fr, b = u.pm >> 5, pn = u.pn, c8 = wc * 32 + 8 * fq;
        f32x4 sv[2][2];
#pragma unroll
        for (int bj = 0; bj < 2; ++bj)
#pragma unroll
            for (int n = 0; n < 2; ++n) sv[bj][n] = *(const f32x4*)(shw + b * DINP + pn * 256 + bj * 128 + c8 + 4 * n);
        float ssv[2][4];
#pragma unroll
        for (int ai = 0; ai < 2; ++ai)
#pragma unroll
            for (int m = 0; m < 4; ++m) ssv[ai][m] = ss[row0 + ai * 128 + m * 16];
#pragma unroll
        for (int ai = 0; ai < 2; ++ai)
#pragma unroll
            for (int m = 0; m < 4; ++m) {
                const size_t row = (size_t)(row0 + ai * 128 + m * 16);
                const float rstd = __builtin_amdgcn_rsqf(ssv[ai][m] * (1.0f / 1024.0f) + EPS);
                f32x4 v[2][2];
#pragma unroll
                for (int bj = 0; bj < 2; ++bj)
#pragma unroll
                    for (int n = 0; n < 2; ++n) v[bj][n] = acc[ai][bj][m][n] * rstd + sv[bj][n];
                if (pn < 4) {
#pragma unroll
                    for (int bj = 0; bj < 2; ++bj) store8bf(XL + row * 1024 + pn * 256 + bj * 128 + c8, v[bj][0], v[bj][1]);
                } else if (pn == 4) {
#pragma unroll
                    for (int bj = 0; bj < 2; ++bj) store8bf(QD + row * 256 + bj * 128 + c8, v[bj][0], v[bj][1]);
                    float s = (sumsq4(v[0][0]) + sumsq4(v[0][1])) + (sumsq4(v[1][0]) + sumsq4(v[1][1]));
                    s += __shfl_xor(s, 16); s += __shfl_xor(s, 32);
                    if (fq == 0) atomic_addf(ssq + row, s);
                } else if (pn == 5) {
                    store8bf(KVD + row * 128 + c8, v[0][0], v[0][1]);
                    float s = sumsq4(v[0][0]) + sumsq4(v[0][1]);
                    s += __shfl_xor(s, 16); s += __shfl_xor(s, 32);
                    if (fq == 0) atomic_addf(sskv + row, s);
                    if (wc < 2) { *(f32x4*)(KROPE + row * 64 + c8) = v[1][0]; *(f32x4*)(KROPE + row * 64 + c8 + 4) = v[1][1]; }
                } else {
                    bf16* G = (pn < 10) ? SGA + (pn - 6) * 256 : SGB + (pn - 10) * 256;
#pragma unroll
                    for (int bj = 0; bj < 2; ++bj) {
                        f32x4 a, c;
#pragma unroll
                        for (int j = 0; j < 4; ++j) { a[j] = sigmoidf_(v[bj][0][j]); c[j] = sigmoidf_(v[bj][1][j]); }
                        store8bf(G + row * 1024 + bj * 128 + c8, a, c);
                    }
                }
            }
    }
};
struct EpiQ {
    static constexpr bool PERM = true, AFTER_DRAIN = false;
    const float* ssq; const float* cs; bf16* QN; bf16* QR;
    __device__ __forceinline__ void operator()(const f32x4 (&acc)[2][2][4][2], const Unit& u, int wr, int wc, int fr, int fq) const {
        const int row0 = u.pm * 256 + wr * 64 + fr, pn = u.pn, c8 = wc * 32 + 8 * fq;
        float ssv[2][4];
#pragma unroll
        for (int ai = 0; ai < 2; ++ai)
#pragma unroll
            for (int m = 0; m < 4; ++m) ssv[ai][m] = ssq[row0 + ai * 128 + m * 16];
#pragma unroll
        for (int ai = 0; ai < 2; ++ai)
#pragma unroll
            for (int m = 0; m < 4; ++m) {
                const size_t row = (size_t)(row0 + ai * 128 + m * 16);
                const float rstd = __builtin_amdgcn_rsqf(ssv[ai][m] * (1.0f / 256.0f) + EPS);
                if (pn < 2) {
#pragma unroll
                    for (int bj = 0; bj < 2; ++bj) store8bf(QN + row * 512 + pn * 256 + bj * 128 + c8, acc[ai][bj][m][0] * rstd, acc[ai][bj][m][1] * rstd);
                } else {
                    const int i0 = (wc & 1) * 16 + 4 * fq;
                    const f32x4 cs0 = *(const f32x4*)(cs + row * 64 + 2 * i0), cs1 = *(const f32x4*)(cs + row * 64 + 2 * i0 + 4);
#pragma unroll
                    for (int bj = 0; bj < 2; ++bj) {
                        const f32x4 a = acc[ai][bj][m][0] * rstd, c = acc[ai][bj][m][1] * rstd; f32x4 oa, oc;
                        oa[0] = a[0] * cs0[0] - a[1] * cs0[1]; oa[1] = a[1] * cs0[0] + a[0] * cs0[1];
                        oa[2] = a[2] * cs0[2] - a[3] * cs0[3]; oa[3] = a[3] * cs0[2] + a[2] * cs0[3];
                        oc[0] = c[0] * cs1[0] - c[1] * cs1[1]; oc[1] = c[1] * cs1[0] + c[0] * cs1[1];
                        oc[2] = c[2] * cs1[2] - c[3] * cs1[3]; oc[3] = c[3] * cs1[2] + c[2] * cs1[3];
                        store8bf(QR + row * 256 + bj * 128 + c8, oa, oc);
                    }
                }
            }
    }
};
struct EpiKV {
    static constexpr bool PERM = true, AFTER_DRAIN = false;
    const float* sskv; bf16* KN; bf16* V;
    __device__ __forceinline__ void operator()(const f32x4 (&acc)[2][2][4][2], const Unit& u, int wr, int wc, int fr, int fq) const {
        const int row0 = u.pm * 256 + wr * 64 + fr, pn = u.pn, c8 = wc * 32 + 8 * fq;
        bf16* O = (pn < 2) ? KN + pn * 256 : V + (pn - 2) * 256;
        float ssv[2][4];
#pragma unroll
        for (int ai = 0; ai < 2; ++ai)
#pragma unroll
            for (int m = 0; m < 4; ++m) ssv[ai][m] = sskv[row0 + ai * 128 + m * 16];
#pragma unroll
        for (int ai = 0; ai < 2; ++ai)
#pragma unroll
            for (int m = 0; m < 4; ++m) {
                const size_t row = (size_t)(row0 + ai * 128 + m * 16);
                const float rstd = __builtin_amdgcn_rsqf(ssv[ai][m] * (1.0f / 128.0f) + EPS);
#pragma unroll
                for (int bj = 0; bj < 2; ++bj) store8bf(O + row * 512 + bj * 128 + c8, acc[ai][bj][m][0] * rstd, acc[ai][bj][m][1] * rstd);
            }
    }
};
struct EpiRes {
    static constexpr bool PERM = false, AFTER_DRAIN = false;
    const float* xres; float* xout; const float* g; const float* sc; bf16* XS; float* ssn;
    __device__ __forceinline__ void operator()(const f32x4 (&acc)[2][2][4][2], const Unit& u, int wr, int wc, int fr, int fq) const {
        const int row0 = u.pm * 256 + wr * 64 + fr, b = u.pm >> 5, col0 = u.pn * 256 + wc * 32 + 4 * fq;
        f32x4 gv[2][2], scv[2][2];
#pragma unroll
        for (int bj = 0; bj < 2; ++bj)
#pragma unroll
            for (int n = 0; n < 2; ++n) { gv[bj][n] = *(const f32x4*)(g + b * NMOD + col0 + bj * 128 + n * 16);
                scv[bj][n] = sc ? *(const f32x4*)(sc + b * NMOD + col0 + bj * 128 + n * 16) + 1.0f : (f32x4){1.f, 1.f, 1.f, 1.f}; }
#pragma unroll
        for (int ai = 0; ai < 2; ++ai)
#pragma unroll
        for (int mp = 0; mp < 2; ++mp) {
            f32x4 pre[2][2][2];
#pragma unroll
            for (int mm = 0; mm < 2; ++mm)
#pragma unroll
                for (int bj = 0; bj < 2; ++bj)
#pragma unroll
                    for (int n = 0; n < 2; ++n) pre[mm][bj][n] = *(const f32x4*)(xres + (size_t)(row0 + ai * 128 + (2 * mp + mm) * 16) * 1024 + col0 + bj * 128 + n * 16);
#pragma unroll
            for (int mm = 0; mm < 2; ++mm) { const int m = 2 * mp + mm;
                const size_t row = (size_t)(row0 + ai * 128 + m * 16); float s = 0.f;
#pragma unroll
                for (int bj = 0; bj < 2; ++bj)
#pragma unroll
                    for (int n = 0; n < 2; ++n) { const size_t off = row * 1024 + col0 + bj * 128 + n * 16;
                        const f32x4 xv = pre[mm][bj][n] + gv[bj][n] * acc[ai][bj][m][n];
                        *(f32x4*)(xout + off) = xv; s += sumsq4(xv);
                        if (sc) { const f32x4 y = xv * scv[bj][n]; u32x2 w; w.x = cvt_pk_bf16(y[0], y[1]); w.y = cvt_pk_bf16(y[2], y[3]); *(u32x2*)(XS + off) = w; } }
                s += __shfl_xor(s, 16); s += __shfl_xor(s, 32);
                if (fq == 0) atomic_addf(ssn + row, s);
            }
        }
    }
};
struct EpiFfi {
    static constexpr bool PERM = true, AFTER_DRAIN = false;
    const float* ss; const float* shw; bf16* UU;
    __device__ __forceinline__ void operator()(const f32x4 (&acc)[2][2][4][2], const Unit& u, int wr, int wc, int fr, int fq) const {
        const int row0 = u.pm * 256 + wr * 64 + fr, b = u.pm >> 5, pn = u.pn, c8 = wc * 32 + 8 * fq;
        f32x4 sv[2][2];
#pragma unroll
        for (int bj = 0; bj < 2; ++bj)
#pragma unroll
            for (int n = 0; n < 2; ++n) sv[bj][n] = *(const f32x4*)(shw + b * (2 * DFF) + pn * 256 + bj * 128 + c8 + 4 * n);
        float ssv[2][4];
#pragma unroll
        for (int ai = 0; ai < 2; ++ai)
#pragma unroll
            for (int m = 0; m < 4; ++m) ssv[ai][m] = ss[row0 + ai * 128 + m * 16];
#pragma unroll
        for (int ai = 0; ai < 2; ++ai)
#pragma unroll
            for (int m = 0; m < 4; ++m) {
                const size_t row = (size_t)(row0 + ai * 128 + m * 16);
                const float rstd = __builtin_amdgcn_rsqf(ssv[ai][m] * (1.0f / 1024.0f) + EPS);
                f32x4 h[2];
#pragma unroll
                for (int n = 0; n < 2; ++n) { const f32x4 gt = acc[ai][0][m][n] * rstd + sv[0][n], up = acc[ai][1][m][n] * rstd + sv[1][n];
#pragma unroll
                    for (int j = 0; j < 4; ++j) h[n][j] = gt[j] * sigmoidf_(gt[j]) * up[j]; }
                store8bf(UU + row * DFF + pn * 128 + c8, h[0], h[1]);
            }
    }
};
#define XB_TMO      128
#define XB_XCNT(j)  (256  + 64 * (j))
#define XB_XSUB(j)  (1280 + 64 * (j))
#define XB_XGEN(j)  (2304 + 64 * (j))
#define XB_TOP      3328
#define XB_TOPGEN   3392
#define XCD_BAR_WORDS 3456
#define XB_SPIN_CAP (1u << 18)

__device__ __forceinline__ unsigned xb_ld(unsigned* p)              { return __hip_atomic_load(p, __ATOMIC_RELAXED, __HIP_MEMORY_SCOPE_AGENT); }
__device__ __forceinline__ unsigned xb_add(unsigned* p, unsigned v) { return __hip_atomic_fetch_add(p, v, __ATOMIC_RELAXED, __HIP_MEMORY_SCOPE_AGENT); }
__device__ __forceinline__ unsigned xb_xcc_id() { return (unsigned)__builtin_amdgcn_s_getreg((3 << 11) | 20) & 0xFu; }
#define XB_SPIN(cond, bar) do { unsigned _sp = 0; while (cond) { __builtin_amdgcn_s_sleep(1); \
    if ((++_sp & 255u) == 0u) { if (xb_ld(&(bar)[XB_TMO])) break; if (_sp > XB_SPIN_CAP) { atomicAdd(&(bar)[XB_TMO], 1u); break; } } } } while (0)

struct XcdBarrier {
    unsigned* bar; unsigned x;
    volatile LAS unsigned* st;
};

__device__ __forceinline__ XcdBarrier xcd_barrier_post(unsigned* bar, volatile LAS unsigned* st) {
    XcdBarrier b; b.bar = bar; b.x = xb_xcc_id(); b.st = st;
    if (threadIdx.x == 0) (void)xb_add(&bar[XB_XCNT(b.x)], 1u);
    return b;
}
__device__ __forceinline__ void xcd_barrier_complete(unsigned* bar, unsigned x, unsigned& nloc, unsigned& nx) {
    const unsigned G = gridDim.x * gridDim.y * gridDim.z;
    unsigned sum, cnt, mine, sp = 0u;
    for (;;) {
        sum = 0u; cnt = 0u; mine = 0u;
#pragma unroll
        for (unsigned j = 0; j < 16; ++j) { const unsigned c = xb_ld(&bar[XB_XCNT(j)]); sum += c; cnt += (c > 0u) ? 1u : 0u; mine = (j == x) ? c : mine; }
        if (sum == G) break;
        __builtin_amdgcn_s_sleep(1);
        if ((++sp & 255u) == 0u) { if (xb_ld(&bar[XB_TMO])) break; if (sp > XB_SPIN_CAP) { atomicAdd(&bar[XB_TMO], 1u); break; } }
    }
    nloc = mine > 0u ? mine : 1u; nx = cnt > 0u ? cnt : 1u;
}

__device__ __forceinline__ void xcd_barrier(const XcdBarrier& b) {
    asm volatile("s_waitcnt vmcnt(0)" ::: "memory");
    __syncthreads();
    if (threadIdx.x == 0) {
        unsigned* bar = b.bar;
        __builtin_amdgcn_s_waitcnt(0);
        unsigned nloc = b.st[0], nx = b.st[1];
        if (nloc == 0u) { xcd_barrier_complete(bar, b.x, nloc, nx); b.st[0] = nloc; b.st[1] = nx; }
        const unsigned old = xb_add(&bar[XB_XSUB(b.x)], 1u);
        const unsigned gen = old / nloc;
        if (old + 1u == (gen + 1u) * nloc) {
            __builtin_amdgcn_fence(__ATOMIC_RELEASE, "agent");
            asm volatile("s_waitcnt vmcnt(0)" ::: "memory");
            const unsigned og = xb_add(&bar[XB_TOP], 1u);
            const unsigned tg = og / nx;
            if (og + 1u == (tg + 1u) * nx) xb_add(&bar[XB_TOPGEN], 1u);
            else XB_SPIN(xb_ld(&bar[XB_TOPGEN]) == tg, bar);
            __builtin_amdgcn_fence(__ATOMIC_ACQUIRE, "agent");
            xb_add(&bar[XB_XGEN(b.x)], 1u);
            asm volatile("s_waitcnt vmcnt(0)" ::: "memory");
        } else {
            XB_SPIN(xb_ld(&bar[XB_XGEN(b.x)]) == gen, bar);
            __builtin_amdgcn_fence(__ATOMIC_ACQUIRE, "agent");
            asm volatile("s_waitcnt vmcnt(0)" ::: "memory");
        }
    }
    __syncthreads();
}
__device__ __forceinline__ int map_col(int id, int n) {
    switch (id) {
        case 0: return n < 1472 ? n : (n < 1536 ? -1 : n - 64);
        case 2: { const int pn = n >> 8, w = n & 255; return w < 128 ? pn * 128 + w : DFF + pn * 128 + (w - 128); }
        case 3: { const int hh = n / 768; int r = n % 768;
                  if (r < 512) return (4 * hh + (r >> 7)) * 192 + (r & 127);
                  r -= 512; const int e = r & 63; return (4 * hh + (r >> 6)) * 192 + 128 + (e >> 1) + 32 * (e & 1); }
        case 4: { const int hh = n >> 10; int r = n & 1023;
                  if (r < 512) return (4 * hh + (r >> 7)) * 256 + (r & 127);
                  r -= 512; return (4 * hh + (r >> 7)) * 256 + 128 + (r & 127); }
        default: return n;
    }
}
__device__ __forceinline__ void transpose_item(const float* W, int ldw, int K, bf16* WT, int id, const float* kscale, int nblk, int item, LAS float* scr, int lane) {
    const int kb = item / nblk, nb = item % nblk, k0 = 64 * kb, n0 = 32 * nb;
    const int sc = map_col(id, n0 + (lane & 31));
#pragma unroll 16
    for (int i = 0; i < 32; ++i) { const int kk = 2 * i + (lane >> 5); float v = sc >= 0 ? W[(size_t)(k0 + kk) * ldw + sc] : 0.f; if (kscale) v *= kscale[k0 + kk]; scr[kk * 33 + (lane & 31)] = v; }
    LDS_WAIT(); asm volatile("" ::: "memory");
    const int c = lane & 7;
#pragma unroll
    for (int j = 0; j < 4; ++j) { const int n = (lane >> 3) + 8 * j; const LAS float* s = scr + (8 * c) * 33 + n;
        u32x4 o; o.x = cvt_pk_bf16(s[0 * 33], s[1 * 33]); o.y = cvt_pk_bf16(s[2 * 33], s[3 * 33]); o.z = cvt_pk_bf16(s[4 * 33], s[5 * 33]); o.w = cvt_pk_bf16(s[6 * 33], s[7 * 33]);
        *(u32x4*)(WT + (size_t)(n0 + n) * K + k0 + 8 * c) = o; }
    LDS_WAIT(); asm volatile("" ::: "memory");
}
#define OPAQUE_TID() int tid_ = threadIdx.x; asm volatile("" : "+v"(tid_)); const int lane = tid_ & 63, wave = __builtin_amdgcn_readfirstlane(tid_ >> 6), NGW = gridDim.x * 8, gw = blockIdx.x * 8 + wave; (void)lane; (void)wave; (void)NGW; (void)gw
__device__ __forceinline__ void phase0(const Args& a, LAS unsigned char* lds) {
    OPAQUE_TID();
    LAS float* scr = (LAS float*)(lds + wave * 16384);
    float* mod = (float*)(a.ws + WS_MOD);
    for (int it = blockIdx.x; it < DEPTH * (NMOD / 64); it += gridDim.x) {
        const int l = it / (NMOD / 64), n = (it % (NMOD / 64)) * 64 + lane;
        float a0 = 0.f, a1 = 0.f, a2 = 0.f, a3 = 0.f;
        const float* w = a.w_ada + (size_t)l * DM * NMOD + (size_t)(wave * 128) * NMOD + n; const float* cc = a.c + wave * 128;
#pragma unroll 16
        for (int k = 0; k < 128; ++k) { const float wv = w[(size_t)k * NMOD]; a0 += cc[k] * wv; a1 += cc[DM + k] * wv; a2 += cc[2 * DM + k] * wv; a3 += cc[3 * DM + k] * wv; }
        LAS float* red = (LAS float*)(lds + 73728);
        red[(wave * 4 + 0) * 64 + lane] = a0; red[(wave * 4 + 1) * 64 + lane] = a1; red[(wave * 4 + 2) * 64 + lane] = a2; red[(wave * 4 + 3) * 64 + lane] = a3;
        __syncthreads();
        if (wave < 4) { float s = a.b_ada[l * NMOD + n];
#pragma unroll
            for (int q = 0; q < 8; ++q) s += red[(q * 4 + wave) * 64 + lane];
            mod[(l * 4 + wave) * NMOD + n] = s; }
        __syncthreads();
    }
    constexpr int I_IN = 16 * (DINP / 32), I_OUT = 16 * 32, I_FFI = 16 * (2 * DFF / 32), I_FFO = (DFF / 64) * 32, I_UQ = 4 * 48, I_UKV = 2 * 64, I_LRU = 16 * 8;
    constexpr int I_L = I_IN + I_OUT + I_FFI + I_FFO + I_UQ + I_UKV + I_LRU;
    for (int it = gw; it < DEPTH * I_L; it += NGW) {
        const int l = it / I_L; int r = it % I_L; unsigned char* wl = a.ws + WS_W + (size_t)l * WL_STRIDE;
        if (r < I_IN) { transpose_item(a.w_in + (size_t)l * DM * 3520, 3520, DM, (bf16*)(wl + WL_IN), 0, nullptr, DINP / 32, r, scr, lane); continue; } r -= I_IN;
        if (r < I_OUT) { transpose_item(a.w_out + (size_t)l * DM * DM, DM, DM, (bf16*)(wl + WL_OUT), 1, nullptr, 32, r, scr, lane); continue; } r -= I_OUT;
        if (r < I_FFI) { transpose_item(a.w_ffi + (size_t)l * DM * 2 * DFF, 2 * DFF, DM, (bf16*)(wl + WL_FFI), 2, nullptr, 2 * DFF / 32, r, scr, lane); continue; } r -= I_FFI;
        if (r < I_FFO) { transpose_item(a.w_ffo + (size_t)l * DFF * DM, DM, DFF, (bf16*)(wl + WL_FFO), 1, nullptr, 32, r, scr, lane); continue; } r -= I_FFO;
        if (r < I_UQ) { transpose_item(a.w_uq + (size_t)l * 256 * 1536, 1536, 256, (bf16*)(wl + WL_UQ), 3, a.qg + l * 256, 48, r, scr, lane); continue; } r -= I_UQ;
        if (r < I_UKV) { transpose_item(a.w_ukv + (size_t)l * 128 * 2048, 2048, 128, (bf16*)(wl + WL_UKV), 4, a.kvg + l * 128, 64, r, scr, lane); continue; } r -= I_UKV;
        { const int mtx = r >> 3, nb = mtx >> 1, which = mtx & 1;
          const float* src = (which ? a.lru_wx : a.lru_wa) + (size_t)l * 8 * 16384 + (size_t)nb * 16384;
          transpose_item(src, 128, 128, (bf16*)(wl + WL_LRU) + (size_t)(nb * 256 + which * 128) * 128, 1, nullptr, 4, r & 7, scr, lane); }
    }
    f32x2* cs = (f32x2*)(a.ws + WS_CS);
    for (int e = gw * 64 + lane; e < T * 32; e += NGW * 64) {
        const int t = e >> 5, i = e & 31;
        const float ang = (float)a.pos[t] * INV_FREQ[i];
        const double q = rint((double)ang * 0.15915494309189535);
        const float rr = (float)((double)ang - q * 6.283185307179586);
        cs[e] = (f32x2){__cosf(rr), __sinf(rr)};
    }
}
__device__ __forceinline__ void phase1(const Args& a) {
    OPAQUE_TID();
    const float* mod = (const float*)(a.ws + WS_MOD);
    float* ss = (float*)(a.ws + WS_SS); bf16* XS = (bf16*)(a.ws + WS_XS);
    for (int row0 = gw; row0 < T; row0 += 4 * NGW) {
        f32x4 v[4][4]; float s[4];
#pragma unroll
        for (int q = 0; q < 4; ++q) { const int row = row0 + q * NGW; const f32x4* xr = (const f32x4*)(a.x + (size_t)row * DM) + lane; s[q] = 0.f;
#pragma unroll
            for (int j = 0; j < 4; ++j) { v[q][j] = xr[64 * j]; } }
#pragma unroll
        for (int q = 0; q < 4; ++q) { const int row = row0 + q * NGW, b = row >> 13; const f32x4* scp = (const f32x4*)(mod + b * NMOD + 1024) + lane;
#pragma unroll
            for (int j = 0; j < 4; ++j) s[q] += sumsq4(v[q][j]);
            s[q] = wave_sum(s[q]);
            u32x2* o = (u32x2*)(XS + (size_t)row * DM) + lane;
#pragma unroll
            for (int j = 0; j < 4; ++j) { const f32x4 y = v[q][j] * (scp[64 * j] + 1.0f); u32x2 w; w.x = cvt_pk_bf16(y[0], y[1]); w.y = cvt_pk_bf16(y[2], y[3]); o[64 * j] = w; }
            if (lane == 0) ss[row] = s[q];
            if (lane >= 1 && lane <= 8) ss[(size_t)lane * T + row] = 0.f; }
    }
    constexpr int NI = DINP + 2 * DFF;
    for (int it = gw; it < DEPTH * NI; it += NGW) {
        const int l = it / NI; int n = it % NI; const bool isf = n >= DINP; if (isf) n -= DINP;
        const bf16* wrow = (const bf16*)(a.ws + WS_W + (size_t)l * WL_STRIDE + (isf ? WL_FFI : WL_IN)) + (size_t)n * DM;
        const float* sh = mod + (size_t)l * 4 * NMOD + (isf ? 3072 : 0);
        float s0 = 0.f, s1 = 0.f, s2 = 0.f, s3 = 0.f;
#pragma unroll
        for (int h = 0; h < 2; ++h) { const int k0 = h * 512 + lane * 8; const bf16x8 wv = *(const bf16x8*)(wrow + k0);
#pragma unroll
            for (int j = 0; j < 8; ++j) { const float w = bf2f((bf16)wv[j]); s0 += w * sh[k0 + j]; s1 += w * sh[NMOD + k0 + j]; s2 += w * sh[2 * NMOD + k0 + j]; s3 += w * sh[3 * NMOD + k0 + j]; } }
        s0 = wave_sum(s0); s1 = wave_sum(s1); s2 = wave_sum(s2); s3 = wave_sum(s3);
        if (lane == 0) { float* o = (float*)(a.ws + (isf ? WS_SHWF : WS_SHWIN)) + (size_t)l * 4 * (isf ? 2 * DFF : DINP) + n; const int st = isf ? 2 * DFF : DINP; o[0] = s0; o[st] = s1; o[2 * st] = s2; o[3 * st] = s3; }
    }
}
__device__ __forceinline__ void lru_phase(const Args& a, int l, char* lds, bool dummy = false) {
    int tid_ = threadIdx.x; asm volatile("" : "+v"(tid_));
    const int tid = tid_, lane = tid & 63, wave = tid >> 6, fq = lane >> 4, fc = lane & 15;
    const bf16* XL = (const bf16*)(a.ws + WS_XL); bf16* SGA = (bf16*)(a.ws + WS_SGA); bf16* WC = (bf16*)(a.ws + WS_XS);
    float* sumP = (float*)(a.ws + WS_SUMP); float* sumH = (float*)(a.ws + WS_SUMH);
    const bf16* Wl = (const bf16*)(a.ws + WS_W + (size_t)l * WL_STRIDE + WL_LRU);
    const float* cw = a.conv_w + (size_t)l * 4 * DM; const float* cb = a.conv_b + (size_t)l * DM;
    constexpr int PITCH = 272, TILE = 128 * PITCH, OFF_SG = TILE, OFF_WC = 2 * TILE, OFF_PF = 3 * TILE;
    const int cgp = tid & 15, rr = tid >> 4;
    f32x4 w[4][2], bb[2]; bf16x8 bwa[4], bwx[4]; float ba = 0.f, bx = 0.f, c8 = 0.f; int nb_cur = -1;
    for (int unit = blockIdx.x; unit < (T / 128) * 8; unit += gridDim.x) {
        const int chunk = unit >> 3, nb = unit & 7, t0 = chunk * 128; const bool first = (t0 & (SEQ - 1)) == 0;
        const int ch = nb * 128 + cgp * 8;
        if (nb != nb_cur) { nb_cur = nb;
#pragma unroll
            for (int j = 0; j < 4; ++j) { w[j][0] = *(const f32x4*)(cw + j * DM + ch); w[j][1] = *(const f32x4*)(cw + j * DM + ch + 4); }
            bb[0] = *(const f32x4*)(cb + ch); bb[1] = *(const f32x4*)(cb + ch + 4);
            const bf16* wr_ = Wl + (size_t)(nb * 256 + 16 * wave + fc) * 128 + fq * 8;
#pragma unroll
            for (int ks = 0; ks < 4; ++ks) { bwa[ks] = *(const bf16x8*)(wr_ + ks * 32); bwx[ks] = *(const bf16x8*)(wr_ + 128 * 128 + ks * 32); }
            const int c_ = nb * 128 + 16 * wave + fc;
            ba = a.lru_ba[l * DM + c_]; bx = a.lru_bx[l * DM + c_]; c8 = -8.0f * log1pf(__expf(-a.lru_a[l * DM + c_])); }
        {
            bf16x8 sgv[4], xv[4][4];
#pragma unroll
            for (int p = 0; p < 4; ++p) sgv[p] = *(const bf16x8*)(SGA + (size_t)(t0 + p * 32 + rr) * DM + ch);
            int pf = 0; if (tid < 128) pf = a.pos[t0 + tid];
#pragma unroll
            for (int p = 0; p < 4; ++p)
#pragma unroll
                for (int j = 0; j < 4; ++j) { const int rj = p * 32 + rr - 3 + j;
                    xv[p][j] = (first && rj < 0) ? (bf16x8){0, 0, 0, 0, 0, 0, 0, 0} : *(const bf16x8*)(XL + (size_t)(t0 + rj) * DM + ch); }
            __syncthreads();
#pragma unroll
            for (int p = 0; p < 4; ++p) { const int row = p * 32 + rr; f32x4 o0 = bb[0], o1 = bb[1];
#pragma unroll
                for (int j = 0; j < 4; ++j) {
#pragma unroll
                    for (int e = 0; e < 4; ++e) { o0[e] += w[j][0][e] * bf2f((bf16)xv[p][j][e]); o1[e] += w[j][1][e] * bf2f((bf16)xv[p][j][4 + e]); } }
                u32x4 pk; pk.x = cvt_pk_bf16(o0[0], o0[1]); pk.y = cvt_pk_bf16(o0[2], o0[3]); pk.z = cvt_pk_bf16(o1[0], o1[1]); pk.w = cvt_pk_bf16(o1[2], o1[3]);
                *(u32x4*)(lds + row * PITCH + cgp * 16) = pk; }
#pragma unroll
            for (int p = 0; p < 4; ++p) *(bf16x8*)(lds + OFF_SG + (p * 32 + rr) * PITCH + cgp * 16) = sgv[p];
            if (tid < 128) *(int*)(lds + OFF_PF + tid * 4) = pf;
        }
        __syncthreads();
        f32x4 accA[8], accX[8];
        {
#pragma unroll
            for (int m = 0; m < 8; ++m) { accA[m] = (f32x4){0.f, 0.f, 0.f, 0.f}; accX[m] = (f32x4){0.f, 0.f, 0.f, 0.f};
#pragma unroll
                for (int ks = 0; ks < 4; ++ks) { const bf16x8 av = *(const bf16x8*)(lds + (16 * m + fc) * PITCH + ks * 64 + fq * 16);
                    accA[m] = __builtin_amdgcn_mfma_f32_16x16x32_bf16(av, bwa[ks], accA[m], 0, 0, 0);
                    accX[m] = __builtin_amdgcn_mfma_f32_16x16x32_bf16(av, bwx[ks], accX[m], 0, 0, 0); } }
        }
        const int cl = 16 * wave + fc, c = nb * 128 + cl;
        float Pm = 1.f, Hm = 0.f;
#pragma unroll
        for (int m = 0; m < 8; ++m) {
            float P[4], Hh[4], sg[4];
#pragma unroll
            for (int j = 0; j < 4; ++j) { const int tl = 16 * m + 4 * fq + j;
                const float r = sigmoidf_(accA[m][j] + ba), ig = sigmoidf_(accX[m][j] + bx);
                const float la = c8 * r, x2 = 2.0f * la;
                float av = __expf(la);
                float om = (x2 > -0.1f) ? -(x2 * (1.0f + x2 * (0.5f + x2 * (0.16666667f + x2 * 0.041666668f)))) : 1.0f - __expf(x2);
                float mult = __builtin_amdgcn_sqrtf(om);
                if (*(const int*)(lds + OFF_PF + tl * 4) == 0) { av = 0.f; mult = 1.f; }
                const float xc = bf2f(*(const bf16*)(lds + tl * PITCH + cl * 2));
                const float bv = xc * ig * mult;
                sg[j] = bf2f(*(const bf16*)(lds + OFF_SG + tl * PITCH + cl * 2));
                if (j == 0) { P[0] = av; Hh[0] = bv; } else { P[j] = P[j - 1] * av; Hh[j] = av * Hh[j - 1] + bv; } }
            float Pa = P[3], Ha = Hh[3];
            { const float Pp = __shfl_up(Pa, 16), Hp = __shfl_up(Ha, 16); if (fq >= 1) { Ha = Pa * Hp + Ha; Pa = Pp * Pa; } }
            { const float Pp = __shfl_up(Pa, 32), Hp = __shfl_up(Ha, 32); if (fq >= 2) { Ha = Pa * Hp + Ha; Pa = Pp * Pa; } }
            float Pex = __shfl_up(Pa, 16), Hex = __shfl_up(Ha, 16); if (fq == 0) { Pex = 1.f; Hex = 0.f; }
            const float Pt = __shfl(Pa, 48 + fc), Ht = __shfl(Ha, 48 + fc);
            const float Pin = Pm * Pex, Hin = Pex * Hm + Hex;
#pragma unroll
            for (int j = 0; j < 4; ++j) { const int tl = 16 * m + 4 * fq + j;
                const float cp = P[j] * Pin, hl = Hh[j] + P[j] * Hin;
                const unsigned pk = cvt_pk_bf16(sg[j] * hl, sg[j] * cp);
                *(bf16*)(lds + OFF_SG + tl * PITCH + cl * 2) = (bf16)(pk & 0xffffu); *(bf16*)(lds + OFF_WC + tl * PITCH + cl * 2) = (bf16)(pk >> 16); }
            Hm = Pt * Hm + Ht; Pm = Pm * Pt;
        }
        if (fq == 0) { sumP[(size_t)chunk * DM + c] = Pm; sumH[(size_t)chunk * DM + c] = Hm; }
        __syncthreads();
#pragma unroll
        for (int p = 0; p < 4; ++p) { const int row = p * 32 + rr; const size_t gi = (size_t)(t0 + row) * DM + ch;
            *(bf16x8*)((dummy ? (bf16*)a.out : SGA) + gi) = *(const bf16x8*)(lds + OFF_SG + row * PITCH + cgp * 16);
            *(bf16x8*)((dummy ? (bf16*)a.out + (size_t)T * DM : WC) + gi) = *(const bf16x8*)(lds + OFF_WC + row * PITCH + cgp * 16); }
    }
    __syncthreads();
}
__device__ __forceinline__ void krope_phase(const Args& a) {
    const float* KROPE = (const float*)(a.ws + WS_KROPE); unsigned* KR = (unsigned*)(a.ws + WS_KR); const f32x2* cs = (const f32x2*)(a.ws + WS_CS);
    int tid_ = threadIdx.x; asm volatile("" : "+v"(tid_));
    for (int e = blockIdx.x * 512 + tid_; e < T * 32; e += gridDim.x * 512) {
        const int t = e >> 5, i = e & 31; const float x1 = KROPE[t * 64 + i], x2 = KROPE[t * 64 + 32 + i]; const f32x2 v = cs[e];
        KR[e] = cvt_pk_bf16(x1 * v.x - x2 * v.y, x2 * v.x + x1 * v.y);
    }
}
__device__ __forceinline__ void final_phase(const Args& a) {
    OPAQUE_TID();
    for (int row0 = gw; row0 < T; row0 += 2 * NGW) {
        f32x4 v[2][4];
#pragma unroll
        for (int q = 0; q < 2; ++q) { const f32x4* xr = (const f32x4*)(a.out + (size_t)(row0 + q * NGW) * DM) + lane;
#pragma unroll
            for (int j = 0; j < 4; ++j) v[q][j] = xr[64 * j]; }
#pragma unroll
        for (int q = 0; q < 2; ++q) { float s = 0.f;
#pragma unroll
            for (int j = 0; j < 4; ++j) s += sumsq4(v[q][j]);
            const float rstd = __builtin_amdgcn_rsqf(wave_sum(s) * (1.0f / 1024.0f) + EPS);
            f32x4* xr = (f32x4*)(a.out + (size_t)(row0 + q * NGW) * DM) + lane; const f32x4* g = (const f32x4*)a.fg + lane;
#pragma unroll
            for (int j = 0; j < 4; ++j) xr[64 * j] = v[q][j] * rstd * g[64 * j]; }
    }
}
namespace att {
constexpr int KVBLK = 64, QB = 256;
constexpr int KP = 272, RP = 144;
constexpr int SHM_V = 16384, SHM_K = 64 * KP, SHM_R = 64 * RP;
constexpr int OFF_V = 0, OFF_K = 3 * SHM_V, OFF_R = OFF_K + 2 * SHM_K, OFF_QR = OFF_R + 2 * SHM_R  , OFF_WS = OFF_QR + 32768, OFF_CARRY = OFF_WS + 2048, ATT_LDS = OFF_CARRY + 1024;
static_assert(OFF_WS >= 131072 && ATT_LDS <= LDS_XB, "attention LDS map");
constexpr float SCALE = 0.07216878364870322f;
constexpr float THR = 8.f;
#define SBAR() __builtin_amdgcn_sched_barrier(0)
__device__ __forceinline__ int v_st(int k, int c) { const int kk = (k & ~0xC) | ((k & 4) << 1) | ((k & 8) >> 1); return ((kk >> 3) * 4 + (c >> 5)) * 512 + ((kk & 7) * 32 + (c & 31)) * 2; }
__device__ __forceinline__ int v_rd_base(int lane) { return ((lane & 3) << 3) | (((lane >> 2) & 3) << 6) | (((lane >> 4) & 1) << 5) | (((lane >> 5) & 1) << 8); }
constexpr int v_rd_off(int d0, int ks, int half) { return d0 * 512 + ks * 4096 + half * 2048; }
__device__ __forceinline__ int crow(int r, int hi) { return (r & 3) + 8 * (r >> 2) + 4 * hi; }
__device__ __forceinline__ unsigned cvtpk(float lo, float hi) { return pg8::cvt_pk_bf16(lo, hi); }
__device__ __forceinline__ void mask_tile(f32x16& p0, f32x16& p1, int dq) {
    const float NEG = -__builtin_inff();
#pragma unroll
    for (int r = 0; r < 16; ++r) { const int c = (r & 3) + 8 * (r >> 2);
        if (dq - c < 0) p0[r] = NEG;
        if (dq - c - 32 < 0) p1[r] = NEG; }
}
__device__ __forceinline__ void partialSM(f32x16& p0, f32x16& p1, float& m_reg, float& mn, float& alpha) {
    float pmax = p0[0];
#pragma unroll
    for (int r = 1; r < 16; ++r) pmax = fmaxf(pmax, p0[r]);
#pragma unroll
    for (int r = 0; r < 16; ++r) pmax = fmaxf(pmax, p1[r]);
    { auto rr = __builtin_amdgcn_permlane32_swap(__float_as_uint(pmax), __float_as_uint(pmax), false, false);
      pmax = fmaxf(__uint_as_float(rr[0]), __uint_as_float(rr[1])); }
    constexpr float C2 = 1.4426950408889634f * SCALE;
    if (__builtin_expect(__all((pmax - m_reg) * SCALE <= THR), 1)) { mn = m_reg; alpha = 1.f; }
    else { mn = fmaxf(m_reg, pmax); alpha = __builtin_amdgcn_exp2f((m_reg - mn) * C2); m_reg = mn; }
    const float mnL = -mn * C2;
#pragma unroll
    for (int r = 0; r < 16; ++r) p0[r] = fmaf(p0[r], C2, mnL);
#pragma unroll
    for (int r = 0; r < 16; ++r) p1[r] = fmaf(p1[r], C2, mnL);
#pragma unroll
    for (int r = 0; r < 16; ++r) p0[r] = __builtin_amdgcn_exp2f(p0[r]);
}
__device__ __forceinline__ void finishSM(f32x16& p0, f32x16& p1, float alpha, float& l_reg, bf16x8& pa0, bf16x8& pa1, bf16x8& pa2, bf16x8& pa3) {
#pragma unroll
    for (int r = 0; r < 16; ++r) p1[r] = __builtin_amdgcn_exp2f(p1[r]);
    float ps = 0;
#pragma unroll
    for (int r = 0; r < 16; ++r) ps += p0[r];
#pragma unroll
    for (int r = 0; r < 16; ++r) ps += p1[r];
    { auto rr = __builtin_amdgcn_permlane32_swap(__float_as_uint(ps), __float_as_uint(ps), false, false);
      ps = __uint_as_float(rr[0]) + __uint_as_float(rr[1]); }
    l_reg = l_reg * alpha + ps;
#define PK4(P, B_, OUT) do { unsigned a0 = cvtpk(P[B_+0], P[B_+1]), a1 = cvtpk(P[B_+2], P[B_+3]);                          \
        unsigned b0 = cvtpk(P[B_+4], P[B_+5]), b1 = cvtpk(P[B_+6], P[B_+7]);                                             \
        auto r0 = __builtin_amdgcn_permlane32_swap(a0, b0, false, false); auto r1 = __builtin_amdgcn_permlane32_swap(a1, b1, false, false); \
        u32x4 w = {r0[0], r1[0], r0[1], r1[1]}; OUT = *reinterpret_cast<bf16x8*>(&w); } while (0)
    PK4(p0, 0, pa0); PK4(p0, 8, pa1); PK4(p1, 0, pa2); PK4(p1, 8, pa3);
#undef PK4
}
template <int KB>
__device__ __forceinline__ void qkt(f32x16& p0, f32x16& p1, const char* lds, int r32, int hi, const bf16x8* qn, const char* qrr) {
    p0 = f32x16{}; p1 = f32x16{};
    bf16x8 qr[4];
#pragma unroll
    for (int d0 = 0; d0 < 4; ++d0) qr[d0] = *(const bf16x8*)(qrr + d0 * 1024);
    const char* ka = lds + OFF_K + KB * SHM_K + r32 * KP + hi * 16;
#pragma unroll
    for (int d0 = 0; d0 < 8; ++d0) {
        bf16x8 b0 = *reinterpret_cast<const bf16x8*>(ka + d0 * 32);
        bf16x8 b1 = *reinterpret_cast<const bf16x8*>(ka + d0 * 32 + 32 * KP);
        p0 = __builtin_amdgcn_mfma_f32_32x32x16_bf16(b0, qn[d0], p0, 0, 0, 0);
        p1 = __builtin_amdgcn_mfma_f32_32x32x16_bf16(b1, qn[d0], p1, 0, 0, 0); }
    const char* ra = lds + OFF_R + KB * SHM_R + r32 * RP + hi * 16;
#pragma unroll
    for (int d0 = 0; d0 < 4; ++d0) {
        bf16x8 b0 = *reinterpret_cast<const bf16x8*>(ra + d0 * 32);
        bf16x8 b1 = *reinterpret_cast<const bf16x8*>(ra + d0 * 32 + 32 * RP);
        p0 = __builtin_amdgcn_mfma_f32_32x32x16_bf16(b0, qr[d0], p0, 0, 0, 0);
        p1 = __builtin_amdgcn_mfma_f32_32x32x16_bf16(b1, qr[d0], p1, 0, 0, 0); }
}
template <int KB>
__device__ __forceinline__ void qkt_fin(f32x16& p0, f32x16& p1, f32x16& y0, f32x16& y1, float alpha, float& l_reg, bf16x8& pa0, bf16x8& pa1, bf16x8& pa2, bf16x8& pa3,
                                        const char* lds, int r32, int hi, const bf16x8* qn, const char* qrr) {
    p0 = f32x16{}; p1 = f32x16{};
    const char* ka = lds + OFF_K + KB * SHM_K + r32 * KP + hi * 16;
    const char* ra = lds + OFF_R + KB * SHM_R + r32 * RP + hi * 16;
#define QK_LD(i, X0, X1) do { if ((i) < 8) { X0 = *reinterpret_cast<const bf16x8*>(ka + (i) * 32); X1 = *reinterpret_cast<const bf16x8*>(ka + (i) * 32 + 32 * KP); } \
                              else { X0 = *reinterpret_cast<const bf16x8*>(ra + ((i) - 8) * 32); X1 = *reinterpret_cast<const bf16x8*>(ra + ((i) - 8) * 32 + 32 * RP); \
                                     Q##X0 = *(const bf16x8*)(qrr + ((i) - 8) * 1024); } } while (0)
#define QK_MM(i, X0, X1) do { const bf16x8 q_ = (i) < 8 ? qn[(i) < 8 ? (i) : 0] : Q##X0; \
        p0 = __builtin_amdgcn_mfma_f32_32x32x16_bf16(X0, q_, p0, 0, 0, 0); p1 = __builtin_amdgcn_mfma_f32_32x32x16_bf16(X1, q_, p1, 0, 0, 0); } while (0)
#define QK_PK4(P, B_, OUT) do { unsigned a0_ = cvtpk(P[B_+0], P[B_+1]), a1_ = cvtpk(P[B_+2], P[B_+3]); unsigned b0_ = cvtpk(P[B_+4], P[B_+5]), b1_ = cvtpk(P[B_+6], P[B_+7]); \
        auto r0_ = __builtin_amdgcn_permlane32_swap(a0_, b0_, false, false); auto r1_ = __builtin_amdgcn_permlane32_swap(a1_, b1_, false, false); \
        u32x4 w_ = {r0_[0], r1_[0], r0_[1], r1_[1]}; OUT = *reinterpret_cast<bf16x8*>(&w_); } while (0)
    bf16x8 A0, A1, B0, B1, C0, C1, QA0, QB0, QC0; float ps = 0.f;
    QK_LD(0, A0, A1); QK_LD(1, B0, B1); SBAR();
    QK_LD(2, C0, C1); QK_MM(0, A0, A1);
#pragma unroll
    for (int r = 0; r < 4; ++r) y1[r] = __builtin_amdgcn_exp2f(y1[r]);
    QK_PK4(y0, 0, pa0); SBAR();
    QK_LD(3, A0, A1); QK_MM(1, B0, B1);
#pragma unroll
    for (int r = 4; r < 8; ++r) y1[r] = __builtin_amdgcn_exp2f(y1[r]);
    QK_PK4(y0, 8, pa1); SBAR();
    QK_LD(4, B0, B1); QK_MM(2, C0, C1);
#pragma unroll
    for (int r = 8; r < 12; ++r) y1[r] = __builtin_amdgcn_exp2f(y1[r]);
#pragma unroll
    for (int r = 0; r < 8; ++r) ps += y0[r];
    SBAR();
    QK_LD(5, C0, C1); QK_MM(3, A0, A1);
#pragma unroll
    for (int r = 12; r < 16; ++r) y1[r] = __builtin_amdgcn_exp2f(y1[r]);
#pragma unroll
    for (int r = 8; r < 16; ++r) ps += y0[r];
    SBAR();
    QK_LD(6, A0, A1); QK_MM(4, B0, B1);
    QK_PK4(y1, 0, pa2);
#pragma unroll
    for (int r = 0; r < 8; ++r) ps += y1[r];
    SBAR();
    QK_LD(7, B0, B1); QK_MM(5, C0, C1);
    QK_PK4(y1, 8, pa3);
#pragma unroll
    for (int r = 8; r < 16; ++r) ps += y1[r];
    SBAR();
    QK_LD(8, C0, C1); QK_MM(6, A0, A1);
    { auto rr = __builtin_amdgcn_permlane32_swap(__float_as_uint(ps), __float_as_uint(ps), false, false); ps = __uint_as_float(rr[0]) + __uint_as_float(rr[1]); }
    l_reg = l_reg * alpha + ps;
    SBAR();
    QK_LD(9, A0, A1); QK_MM(7, B0, B1); SBAR();
    QK_LD(10, B0, B1); QK_MM(8, C0, C1); SBAR();
    QK_LD(11, C0, C1); QK_MM(9, A0, A1); SBAR();
    QK_MM(10, B0, B1); SBAR();
    QK_MM(11, C0, C1);
#undef QK_LD
#undef QK_MM
#undef QK_PK4
}
__device__ __forceinline__ void pv_tile(f32x16* o, int vb0, bf16x8 pa0, bf16x8 pa1, bf16x8 pa2, bf16x8 pa3) {
#define TRRD(dst, off) asm volatile("ds_read_b64_tr_b16 %0, %1 offset:%2" : "=&v"(dst) : "v"(vb0), "i"(off) : "memory")
#define PV_D0(d0) do { s16x4 l0, l1, l2, l3, h0, h1, h2, h3; constexpr int b_ = v_rd_off(d0, 0, 0); \
        TRRD(l0, b_); TRRD(h0, b_ + 2048); TRRD(l1, b_ + 4096); TRRD(h1, b_ + 6144); TRRD(l2, b_ + 8192); TRRD(h2, b_ + 10240); TRRD(l3, b_ + 12288); TRRD(h3, b_ + 14336); \
        asm volatile("s_waitcnt lgkmcnt(0)" ::: "memory"); SBAR();   \
        o[d0] = __builtin_amdgcn_mfma_f32_32x32x16_bf16(pa0, (bf16x8){l0[0], l0[1], l0[2], l0[3], h0[0], h0[1], h0[2], h0[3]}, o[d0], 0, 0, 0);   \
        o[d0] = __builtin_amdgcn_mfma_f32_32x32x16_bf16(pa1, (bf16x8){l1[0], l1[1], l1[2], l1[3], h1[0], h1[1], h1[2], h1[3]}, o[d0], 0, 0, 0);   \
        o[d0] = __builtin_amdgcn_mfma_f32_32x32x16_bf16(pa2, (bf16x8){l2[0], l2[1], l2[2], l2[3], h2[0], h2[1], h2[2], h2[3]}, o[d0], 0, 0, 0);   \
        o[d0] = __builtin_amdgcn_mfma_f32_32x32x16_bf16(pa3, (bf16x8){l3[0], l3[1], l3[2], l3[3], h3[0], h3[1], h3[2], h3[3]}, o[d0], 0, 0, 0); } while (0)
    PV_D0(0); PV_D0(1); PV_D0(2); PV_D0(3);
#undef PV_D0
#undef TRRD
}
__device__ __forceinline__ void attn_unit(int rb, int hh, int hl, int qb, unsigned char* wsb, char* lds, bool do_store = true) {
    const bf16* Qn = (const bf16*)(wsb + WS_QN); const bf16* Qr = (const bf16*)(wsb + WS_QR); const bf16* Kn = (const bf16*)(wsb + WS_KN); const bf16* Kr = (const bf16*)(wsb + WS_KR); const bf16* Vv = (const bf16*)(wsb + WS_V);
    int tid_ = threadIdx.x; asm volatile("" : "+v"(tid_));
    const int tid = tid_, wid = __builtin_amdgcn_readfirstlane(tid >> 6), lane = tid & 63, r32 = lane & 31, hi = lane >> 5;
    const int q0 = qb * QB, NT = (q0 + QB) / KVBLK;
    const int qlo = q0 + wid * 32, qm = qlo + r32 - 4 * hi;
    char* V_lds = lds + OFF_V; char* K_lds = lds + OFF_K; char* R_lds = lds + OFF_R;
    float* ws = (float*)(lds + OFF_WS) + wid * 64; float* li_l = ws; float* al_l = ws + 32;
    float* carry = (float*)(lds + OFF_CARRY);
    const int cb = (4 * hh + hl) * 128;
    const bf16* Kh = Kn + (size_t)rb * 512 + hl * 128; const bf16* Vh = Vv + (size_t)rb * 512 + hl * 128; const bf16* Rh = Kr + (size_t)rb * 64;
    const int sr = tid >> 4, sc = (tid & 15) * 8, vst0 = v_st(sr, sc), vst1 = v_st(32 + sr, sc), kws = sr * KP + sc * 2;
    const int rrow = tid >> 3, rc = (tid & 7) * 8, rws = rrow * RP + rc * 2;
    const int vb0 = (int)(uintptr_t)V_lds + v_rd_base(lane);
    bf16x8 st_v0, st_v1, st_k0, st_k1, st_r;
#define VMW() asm volatile("s_waitcnt vmcnt(0)" ::: "memory")
#define SLOAD(k0) do { st_v0 = *(const bf16x8*)(Vh + (size_t)((k0) + sr) * 512 + sc); st_v1 = *(const bf16x8*)(Vh + (size_t)((k0) + 32 + sr) * 512 + sc); \
                       st_k0 = *(const bf16x8*)(Kh + (size_t)((k0) + sr) * 512 + sc); st_k1 = *(const bf16x8*)(Kh + (size_t)((k0) + 32 + sr) * 512 + sc); \
                       st_r = *(const bf16x8*)(Rh + (size_t)((k0) + rrow) * 64 + rc); } while (0)
#define SWRITE(bf, vs) do { *(bf16x8*)(V_lds + (vs) + vst0) = st_v0; *(bf16x8*)(V_lds + (vs) + vst1) = st_v1; \
                        *(bf16x8*)(K_lds + (bf) * SHM_K + kws) = st_k0; *(bf16x8*)(K_lds + (bf) * SHM_K + kws + 32 * KP) = st_k1; \
                        *(bf16x8*)(R_lds + (bf) * SHM_R + rws) = st_r; } while (0)
    SLOAD(0);
    bf16x8 qn[8];
    const char* qrr = lds + OFF_QR + wid * 4096 + lane * 16;
    bf16x8 qrt[4];
    { const bf16* qg = Qr + (size_t)(rb + q0 + wid * 32 + r32) * 256 + hl * 64 + hi * 8;
#pragma unroll
      for (int d0 = 0; d0 < 4; ++d0) qrt[d0] = *(const bf16x8*)(qg + d0 * 16); }
    { const bf16* qrow = Qn + (size_t)(rb + q0 + wid * 32 + r32) * 512 + hl * 128 + hi * 8;
#pragma unroll
      for (int d0 = 0; d0 < 8; ++d0) qn[d0] = *(const bf16x8*)(qrow + d0 * 16); }
    float Hc = 0.f;
    if (tid < 256) { const int which = tid >> 7, c = tid & 127, kmax = qb * 2 + which; const size_t base = (size_t)(rb >> 7) * 1024 + cb + c;
        const float* sumP = (const float*)(wsb + WS_SUMP); const float* sumH = (const float*)(wsb + WS_SUMH);
        for (int j = 0; j < kmax; j += 8) { float hv[8], pw[8];
#pragma unroll
            for (int q = 0; q < 8; ++q) { const bool ok = j + q < kmax; hv[q] = ok ? sumH[base + (size_t)(j + q) * 1024] : 0.f; pw[q] = ok ? sumP[base + (size_t)(j + q) * 1024] : 1.f; }
#pragma unroll
            for (int q = 0; q < 8; ++q) Hc = hv[q] + pw[q] * Hc; } }
    __syncthreads();
#pragma unroll
    for (int d0 = 0; d0 < 4; ++d0) *(bf16x8*)(lds + OFF_QR + wid * 4096 + lane * 16 + d0 * 1024) = qrt[d0];
    if (tid < 256) carry[(tid >> 7) * 128 + (tid & 127)] = Hc;
    VMW(); SWRITE(0, 0); SBAR();
    SLOAD(KVBLK);
    __syncthreads();
    float m_reg = -1e30f, l_reg = 0; f32x16 o[4] = {};
    f32x16 pA0, pA1, pB0, pB1; float mnA, mnB, alA, alB; bf16x8 pa0, pa1, pa2, pa3;
    int sl_prev = 0, sl_cur = 0, sl_next = SHM_V;
#define ROT() do { sl_prev = sl_cur; sl_cur = sl_next; sl_next = (sl_next == 2 * SHM_V) ? 0 : sl_next + SHM_V; } while (0)
#define RESC(a) do { if (__any((a) < 1.f)) { if (hi == 0) al_l[r32] = (a); asm volatile("s_waitcnt lgkmcnt(0)" ::: "memory");              \
                     for (int d_ = 0; d_ < 4; ++d_) for (int r = 0; r < 16; ++r) o[d_][r] *= al_l[crow(r, hi)]; } } while (0)
#define MASKT(P0_, P1_, t) do { const int kb_ = (t) * KVBLK; if (kb_ + KVBLK - 1 > qlo) mask_tile(P0_, P1_, qm - kb_); } while (0)
    SBAR(); qkt<0>(pA0, pA1, lds, r32, hi, qn, qrr);
    MASKT(pA0, pA1, 0); partialSM(pA0, pA1, m_reg, mnA, alA);
    VMW(); SWRITE(1, SHM_V);
    __syncthreads();
    ROT();
#define STEP(PX0, PX1, mnX, alX, PY0, PY1, alY, t, KB, LAST) do {                                                             \
        SBAR(); qkt_fin<KB>(PX0, PX1, PY0, PY1, alY, l_reg, pa0, pa1, pa2, pa3, lds, r32, hi, qn, qrr); SBAR();               \
        if (!(LAST)) { SLOAD(((t) + 1) * KVBLK); SBAR(); }                                                                    \
        pv_tile(o, vb0 + sl_prev, pa0, pa1, pa2, pa3); MASKT(PX0, PX1, (t)); partialSM(PX0, PX1, m_reg, mnX, alX);            \
        if (!(LAST)) { VMW(); SWRITE(1 - (KB), sl_next); }                                                                    \
        RESC(alX);                                                                                                            \
        if (!(LAST)) { __syncthreads(); ROT(); } } while (0)
    for (int t = 1; t + 1 < NT; t += 2) {
        STEP(pB0, pB1, mnB, alB, pA0, pA1, alA, t, 1, false);
        STEP(pA0, pA1, mnA, alA, pB0, pB1, alB, t + 1, 0, false);
    }
    STEP(pB0, pB1, mnB, alB, pA0, pA1, alA, NT - 1, 1, true);
    finishSM(pB0, pB1, alB, l_reg, pa0, pa1, pa2, pa3); SBAR(); pv_tile(o, vb0 + sl_cur, pa0, pa1, pa2, pa3);
    if (hi == 0) li_l[r32] = l_reg; asm volatile("s_waitcnt lgkmcnt(0)" ::: "memory");
    __syncthreads();
    {
        float* stg = (float*)lds + wid * 4096;
#pragma unroll
        for (int r = 0; r < 16; ++r) { const int orow = crow(r, hi); const float rl = __builtin_amdgcn_rcpf(li_l[orow]);
#pragma unroll
            for (int d0 = 0; d0 < 4; ++d0) stg[orow * 128 + d0 * 32 + r32] = o[d0][r] * rl; }
        asm volatile("s_waitcnt lgkmcnt(0)" ::: "memory");
        const float* cr = carry + (wid >> 2) * 128 + (lane & 15) * 8;
        const f32x4 h0 = *(const f32x4*)cr, h1 = *(const f32x4*)(cr + 4);
        const size_t gbase = (size_t)(rb + q0 + wid * 32 + (lane >> 4)) * DM + cb + (lane & 15) * 8;
        const bf16* U = (const bf16*)(wsb + WS_SGA) + gbase; const bf16* WC = (const bf16*)(wsb + WS_XS) + gbase; const bf16* SGB = (const bf16*)(wsb + WS_SGB) + gbase; bf16* Y = (bf16*)(wsb + WS_XL) + gbase;
        const float* sp = stg + (lane >> 4) * 128 + (lane & 15) * 8;
#pragma unroll 2
        for (int i = 0; i < 8; ++i) {
            const bf16x8 u = *(const bf16x8*)(U + (size_t)i * 4 * DM), w = *(const bf16x8*)(WC + (size_t)i * 4 * DM), g = *(const bf16x8*)(SGB + (size_t)i * 4 * DM);
            const f32x4 v0 = *(const f32x4*)(sp + i * 512), v1 = *(const f32x4*)(sp + i * 512 + 4);
            f32x4 y0, y1;
#pragma unroll
            for (int e = 0; e < 4; ++e) { y0[e] = bf2f((bf16)u[e]) + bf2f((bf16)w[e]) * h0[e] + bf2f((bf16)g[e]) * v0[e];
                                          y1[e] = bf2f((bf16)u[4 + e]) + bf2f((bf16)w[4 + e]) * h1[e] + bf2f((bf16)g[4 + e]) * v1[e]; }
            if (do_store) store8bf(Y + (size_t)i * 4 * DM, y0, y1);
        }
    }
#undef RESC
#undef MASKT
#undef STEP
#undef ROT
#undef SLOAD
#undef SWRITE
#undef VMW
}
#undef SBAR
}
__global__ void __launch_bounds__(512, 2) fwd_megakernel(Args a) {
    extern __shared__ __attribute__((aligned(16))) unsigned char lds[];
    cg::grid_group grid = cg::this_grid();
    {
        if (threadIdx.x < 8) ((LAS unsigned*)(lds + LDS_XB))[threadIdx.x] = 0u;
        __syncthreads();
    }
    grid.sync();
    (void)xcd_barrier_post((unsigned*)(a.ws + WS_BAR), (volatile LAS unsigned*)((LAS unsigned char*)lds + LDS_XB));
#define GSYNC() do { XcdBarrier b_; b_.bar = (unsigned*)(a.ws + WS_BAR); b_.x = xb_xcc_id(); b_.st = (volatile LAS unsigned*)((LAS unsigned char*)lds + LDS_XB); xcd_barrier(b_); } while (0)
    const int G = gridDim.x;
    LAS unsigned char* ldsl = (LAS unsigned char*)lds;
    unsigned char* ws = a.ws;
    float* mod = (float*)(ws + WS_MOD); float* ss = (float*)(ws + WS_SS);
    bf16* XS = (bf16*)(ws + WS_XS); bf16* XL = (bf16*)(ws + WS_XL); bf16* SGA = (bf16*)(ws + WS_SGA); bf16* SGB = (bf16*)(ws + WS_SGB); bf16* UU = (bf16*)(ws + WS_UU);
    bf16* QD = (bf16*)(ws + WS_QD); bf16* KVD = (bf16*)(ws + WS_KVD); float* KROPE = (float*)(ws + WS_KROPE); bf16* KR = (bf16*)(ws + WS_KR);
    bf16* QN = (bf16*)(ws + WS_QN); bf16* QR = (bf16*)(ws + WS_QR); bf16* KN = (bf16*)(ws + WS_KN); bf16* VV = (bf16*)(ws + WS_V);

#ifndef PHM
#define PHM 0xFFFF
#endif
    if (PHM & 1) phase0(a, ldsl);
    GSYNC();
    if (PHM & 2) phase1(a);
    GSYNC();
#ifdef PROBE_P01
    phase0(a, ldsl);
    GSYNC();
    phase1(a);
    GSYNC();
#endif
    for (int l = 0; l < DEPTH; ++l) {
        unsigned char* wl = ws + WS_W + (size_t)l * WL_STRIDE;
        float* ssA = ss + (size_t)(4 * l) * T; float* ssB = ssA + T; float* ssQ = ssA + 2 * T; float* ssKV = ssA + 3 * T; float* ssN = ssA + 4 * T;
        const float* modl = mod + (size_t)l * 4 * NMOD;
        if (PHM & 4) {
            pg8::Gemm g{(const bf16*)XS, (const bf16*)(wl + WL_IN), T, DINP, DM}; pg8::StaticOrder S; S.init(T, DINP, G, (int)blockIdx.x);
            EpiIn E{ssA, (const float*)(ws + WS_SHWIN) + (size_t)l * 4 * DINP, XL, QD, KVD, KROPE, SGA, SGB, ssQ, ssKV};
            pg8::gemm_phase<EpiIn, pg8::StaticOrder, true, true>(ldsl, g, S, E);
        }
        GSYNC();
        for (int hh = 0; hh < 2; ++hh) {
#ifdef PROBE_LRU2
            if (hh == 0 && l == 0) { lru_phase(a, l, (char*)lds, true); lru_phase(a, l, (char*)lds, true); }
#endif
            if ((PHM & 8) && hh == 0) { lru_phase(a, l, (char*)lds); krope_phase(a); }
            if (PHM & 16) {
                int Kq = 256; asm volatile("" : "+s"(Kq));
                pg8::Gemm g{(const bf16*)QD, (const bf16*)(wl + WL_UQ) + (size_t)hh * 768 * 256, T, 768, Kq}; pg8::StaticOrder S; S.init(T, 768, G, (int)blockIdx.x);
                EpiQ E{ssQ, (const float*)(ws + WS_CS), QN, QR};
                pg8::gemm_phase<EpiQ, pg8::StaticOrder, true, true>(ldsl, g, S, E);
            }
            if (PHM & 32) {
                int Kk = 128; asm volatile("" : "+s"(Kk));
                pg8::Gemm g{(const bf16*)KVD, (const bf16*)(wl + WL_UKV) + (size_t)hh * 1024 * 128, T, 1024, Kk}; pg8::StaticOrder S; S.init(T, 1024, G, (int)blockIdx.x);
                EpiKV E{ssKV, KN, VV};
                pg8::gemm_phase<EpiKV, pg8::StaticOrder, true, true>(ldsl, g, S, E);
            }
#ifdef PROBE_QKV2
            {
                int Kq = 256; asm volatile("" : "+s"(Kq));
                pg8::Gemm g{(const bf16*)QD, (const bf16*)(wl + WL_UQ) + (size_t)hh * 768 * 256, T, 768, Kq}; pg8::StaticOrder S; S.init(T, 768, G, (int)blockIdx.x);
                EpiQ E{ssQ, (const float*)(ws + WS_CS), QN, QR};
                pg8::gemm_phase<EpiQ, pg8::StaticOrder, true, true>(ldsl, g, S, E);
            }
            {
                int Kk = 128; asm volatile("" : "+s"(Kk));
                pg8::Gemm g{(const bf16*)KVD, (const bf16*)(wl + WL_UKV) + (size_t)hh * 1024 * 128, T, 1024, Kk}; pg8::StaticOrder S; S.init(T, 1024, G, (int)blockIdx.x);
                EpiKV E{ssKV, KN, VV};
                pg8::gemm_phase<EpiKV, pg8::StaticOrder, true, true>(ldsl, g, S, E);
            }
#endif
            GSYNC();
            const int vcu = (G % 8 == 0) ? (int)(blockIdx.x & 7) * (G / 8) + (int)(blockIdx.x >> 3) : (int)blockIdx.x;
            if (PHM & 64) for (int p2 = 2 * vcu; p2 < 512; p2 += ((p2 & 1) ? 2 * G - 1 : 1)) {
                const int p = p2 >> 1, bh = p >> 4, s = p & 15, b = bh >> 2, hl = bh & 3;
                att::attn_unit(b * SEQ, hh, hl, (p2 & 1) ? s : 31 - s, ws, (char*)lds);
            }
#ifdef PROBE_ATT2
#ifndef PROBE_NOSYNC
            GSYNC();
#endif
            if (hh == PROBE_ATT2 - 1) for (int p2 = 2 * blockIdx.x; p2 < 512; p2 += ((p2 & 1) ? 2 * G - 1 : 1)) {
                const int p = p2 >> 1, bh = p >> 4, s = p & 15, b = bh >> 2, hl = bh & 3;
                att::attn_unit(b * SEQ, hh, hl, (p2 & 1) ? s : 31 - s, ws, (char*)lds, PROBE_STORE);
            }
#endif
            GSYNC();
        }
        if (PHM & 128) {
            pg8::Gemm g{(const bf16*)XL, (const bf16*)(wl + WL_OUT), T, DM, DM}; pg8::StaticOrder S; S.init(T, DM, G, (int)blockIdx.x);
            EpiRes E{l == 0 ? a.x : a.out, a.out, modl + 2048, modl + 4096, XS, ssB};
            pg8::gemm_phase<EpiRes, pg8::StaticOrder, true, true>(ldsl, g, S, E);
        }
        GSYNC();
        if (PHM & 256) {
            pg8::Gemm g{(const bf16*)XS, (const bf16*)(wl + WL_FFI), T, 2 * DFF, DM}; pg8::StaticOrder S; S.init(T, 2 * DFF, G, (int)blockIdx.x);
            EpiFfi E{ssB, (const float*)(ws + WS_SHWF) + (size_t)l * 4 * 2 * DFF, UU};
            pg8::gemm_phase<EpiFfi, pg8::StaticOrder, true, true>(ldsl, g, S, E);
#ifdef PROBE_FFI2
            GSYNC();
            pg8::gemm_phase<EpiFfi, pg8::StaticOrder, true, true>(ldsl, g, S, E);
#endif
        }
        GSYNC();
        if (PHM & 512) {
            pg8::Gemm g{(const bf16*)UU, (const bf16*)(wl + WL_FFO), T, DM, DFF}; pg8::StaticOrder S; S.init(T, DM, G, (int)blockIdx.x);
            EpiRes E{a.out, a.out, modl + 5120, (l + 1 < DEPTH) ? modl + 4 * NMOD + 1024 : nullptr, XS, ssN};
            pg8::gemm_phase<EpiRes, pg8::StaticOrder, true, true>(ldsl, g, S, E);
        }
        GSYNC();
    }
    if (PHM & 1024) final_phase(a);
}

extern "C" void kernel_launch(void* const* d_in, const int* in_sizes, int n_in, void* d_out, int out_size, void* d_ws, size_t ws_size, hipStream_t stream) {
    static int grid = 0;
    if (grid == 0) {
        int dev = 0, cus = 0, per_cu = 0;
        if (hipGetDevice(&dev) != hipSuccess || hipDeviceGetAttribute(&cus, hipDeviceAttributeMultiprocessorCount, dev) != hipSuccess) { grid = -1; return; }
        if (hipFuncSetAttribute((const void*)fwd_megakernel, hipFuncAttributeMaxDynamicSharedMemorySize, LDS_BYTES) != hipSuccess) { fprintf(stderr, "hipFuncSetAttribute failed\n"); grid = -1; return; }
        if (hipOccupancyMaxActiveBlocksPerMultiprocessor(&per_cu, (const void*)fwd_megakernel, 512, LDS_BYTES) != hipSuccess || per_cu < 1) per_cu = 1;
        (void)hipGetLastError();
        grid = cus;
        if (ws_size < WS_END) { fprintf(stderr, "workspace too small: %zu < %zu\n", ws_size, (size_t)WS_END); grid = -1; return; }
    }
    if (grid < 0) return;
    Args a{};
    a.x = (const float*)d_in[0]; a.c = (const float*)d_in[1]; a.pos = (const int*)d_in[2]; a.w_ada = (const float*)d_in[3]; a.b_ada = (const float*)d_in[4];
    a.w_in = (const float*)d_in[5]; a.conv_w = (const float*)d_in[6]; a.conv_b = (const float*)d_in[7]; a.lru_wa = (const float*)d_in[8]; a.lru_ba = (const float*)d_in[9];
    a.lru_wx = (const float*)d_in[10]; a.lru_bx = (const float*)d_in[11]; a.lru_a = (const float*)d_in[12]; a.qg = (const float*)d_in[13]; a.kvg = (const float*)d_in[14];
    a.w_uq = (const float*)d_in[15]; a.w_ukv = (const float*)d_in[16]; a.w_out = (const float*)d_in[17]; a.w_ffi = (const float*)d_in[18]; a.w_ffo = (const float*)d_in[19];
    a.fg = (const float*)d_in[20]; a.out = (float*)d_out; a.ws = (unsigned char*)d_ws;
    if (hipMemsetAsync((char*)d_ws + WS_BAR, 0, 16384, stream) != hipSuccess) { fprintf(stderr, "memset failed\n"); return; }
    void* args[] = {&a};
    hipError_t e = hipLaunchCooperativeKernel((const void*)fwd_megakernel, dim3(grid), dim3(512), args, LDS_BYTES, stream);
    if (e != hipSuccess) fprintf(stderr, "cooperative launch failed: %s (grid %d)\n", hipGetErrorString(e), grid);
}
```

```cpp
#include <hip/hip_runtime.h>
#include <hip/hip_cooperative_groups.h>
#include <hip/hip_bf16.h>
#include <cstdio>
#include <cstdint>
namespace cg = cooperative_groups;
namespace pg8 {
#define PG8_LAS __attribute__((address_space(3)))
typedef unsigned short bf16_t;
typedef short bf16x8 __attribute__((ext_vector_type(8)));
typedef float f32x4 __attribute__((ext_vector_type(4)));
typedef unsigned u32x4 __attribute__((ext_vector_type(4)));
constexpr int BM = 256, BK = 64, HALF = 128, HTB = HALF * BK * 2  , STAGE_BYTES = 8 * HTB, NXCD = 8, WGM = 8;

__host__ __device__ __forceinline__ int lds_byte(int r, int c) { const int st = (r >> 4) * 2 + (c >> 5), rr = r & 15, cc = c & 31, ob = rr * 64 + cc * 2; return st * 1024 + (ob ^ (((ob >> 9) & 1) << 5)); }
__host__ __device__ __forceinline__ void stage_rc(int b, int& R, int& C) { const int st = b / 1024, sb = b % 1024, swz = sb ^ (((sb >> 9) & 1) << 5); R = (st >> 1) * 16 + swz / 64; C = (st & 1) * 32 + (swz % 64) / 2; }
__host__ __device__ __forceinline__ int perm32(int rho) { const int n = rho >> 4, i = rho & 15; return 8 * (i >> 2) + 4 * n + (i & 3); }

struct Unit { int pm, pn; };
struct Gemm { const bf16_t* A; const bf16_t* Bt; int M, N, K; };

struct StaticOrder {
    int nM, nN, nwg, G, c;
    __host__ __device__ void init(int M, int N, int G_, int c_) { nM = M / BM; nN = N / BM; nwg = nM * nN; G = G_; c = c_; }
    __host__ __device__ bool next(int i, Unit& u) const {
        const long L = (long)i * G + c; if (L >= nwg) return false;
        int wgid = (int)L; { const int q = nwg / NXCD, r = nwg % NXCD, xcd = wgid % NXCD, off = wgid / NXCD; wgid = (xcd < r ? xcd * (q + 1) : r * (q + 1) + (xcd - r) * q) + off; }
        const int nig = WGM * nN, gid = wgid / nig, fm = gid * WGM, gsz = (nM - fm) < WGM ? (nM - fm) : WGM;
        u.pm = fm + ((wgid % nig) % gsz); u.pn = (wgid % nig) / gsz; return true;
    }
    __device__ __forceinline__ void a_ready(const Unit&) const {}
    __device__ __forceinline__ void done(const Unit&) const {}
};

typedef float cvt_f32x2_t __attribute__((ext_vector_type(2))); typedef __bf16 cvt_bf16x2_t __attribute__((ext_vector_type(2)));
__device__ __forceinline__ unsigned cvt_pk_bf16(float lo, float hi) { cvt_f32x2_t v = {lo, hi}; cvt_bf16x2_t b = __builtin_convertvector(v, cvt_bf16x2_t); return __builtin_bit_cast(unsigned, b); }
typedef float f32x2 __attribute__((ext_vector_type(2)));
template <class Epi, class Sched, bool ALIGN_EPI = false, bool SP2 = false>
__device__ __forceinline__ void gemm_phase(PG8_LAS unsigned char* lds, const Gemm g, const Sched& S, const Epi& E) {
    int tid_ = threadIdx.x; asm volatile("" : "+v"(tid_));
    const int tid = tid_, wid = __builtin_amdgcn_readfirstlane(tid >> 6), lane = tid & 63, wr = wid >> 2, wc = wid & 3, fr = lane & 15, fq = lane >> 4;
    const int K = g.K, nt = K / BK;
    unsigned voffA[2], voffB[2];
#pragma unroll
    for (int i = 0; i < 2; ++i) { int R, C; stage_rc(tid * 16 + i * 8192, R, C); const int Rb = Epi::PERM ? ((R & ~31) + perm32(R & 31)) : R;
        voffA[i] = (unsigned)(R * K + C) * 2u; voffB[i] = (unsigned)(Rb * K + C) * 2u; }
    const size_t kstep = (size_t)(BK * 2);
    const size_t hstep = (size_t)HALF * K * 2;
    const size_t tstep = 2 * hstep;
    const unsigned ldsw = (unsigned)wid * 1024u;
    const int aoff = lds_byte(wr * 64 + fr, fq * 8), boff = lds_byte(wc * 32 + fr, fq * 8);
#define PG8_SA(b, h) (((b) * 2 + (h)) * HTB)
#define PG8_SB(b, h) ((4 + (b) * 2 + (h)) * HTB)
#define PG8_STAGE(bufoff, gbase, voff) do { _Pragma("unroll") for (int _i = 0; _i < 2; ++_i) \
        __builtin_amdgcn_global_load_lds((const unsigned*)((const char*)(gbase) + (voff)[_i]), (PG8_LAS unsigned*)(lds + (bufoff) + ldsw + _i * 8192), 16, 0, 0); } while (0)
#define PG8_LDA(dst, b, h) do { _Pragma("unroll") for (int m = 0; m < 4; ++m) _Pragma("unroll") for (int k = 0; k < 2; ++k) dst[m][k] = *(const PG8_LAS bf16x8*)(lds + PG8_SA(b, h) + aoff + m * 2048 + k * 1024); } while (0)
#define PG8_LDB(dst, b, h) do { _Pragma("unroll") for (int n = 0; n < 2; ++n) _Pragma("unroll") for (int k = 0; k < 2; ++k) dst[n][k] = *(const PG8_LAS bf16x8*)(lds + PG8_SB(b, h) + boff + n * 2048 + k * 1024); } while (0)
#define PG8_MMA(ai, bj, At, Bt) do { __builtin_amdgcn_s_setprio(1); _Pragma("unroll") for (int m = 0; m < 4; ++m) _Pragma("unroll") for (int n = 0; n < 2; ++n) _Pragma("unroll") for (int k = 0; k < 2; ++k) \
        acc[ai][bj][m][n] = __builtin_amdgcn_mfma_f32_16x16x32_bf16(Bt[n][k], At[m][k], acc[ai][bj][m][n], 0, 0, 0); __builtin_amdgcn_s_setprio(0); } while (0)
#define PG8_WAIT_V(n) asm volatile("s_waitcnt vmcnt(" #n ")" ::: "memory")
#define PG8_WAIT_L(n) asm volatile("s_waitcnt lgkmcnt(" #n ")" ::: "memory")
#define PG8_BAR __builtin_amdgcn_s_barrier()
#define PG8_SCHED __builtin_amdgcn_sched_barrier(0)
    Unit cur, nxt; int ui = 0;
    if (!S.next(0, cur)) return;
    f32x4 acc[2][2][4][2];
#pragma unroll
    for (int a = 0; a < 2; ++a)
#pragma unroll
        for (int b = 0; b < 2; ++b)
#pragma unroll
            for (int m = 0; m < 4; ++m)
#pragma unroll
                for (int n = 0; n < 2; ++n) acc[a][b][m][n] = (f32x4){0.f, 0.f, 0.f, 0.f};
    bf16x8 At[4][2], B0[2][2], B1[2][2];
    const char* cA = (const char*)g.A + (size_t)cur.pm * tstep; const char* cB = (const char*)g.Bt + (size_t)cur.pn * tstep;
    S.a_ready(cur);
    if constexpr (SP2) {
        PG8_STAGE(PG8_SB(0, 0), cB, voffB); PG8_STAGE(PG8_SB(0, 1), cB + hstep, voffB); PG8_STAGE(PG8_SA(0, 0), cA, voffA); PG8_STAGE(PG8_SA(0, 1), cA + hstep, voffA);
        if (wr == 1) PG8_BAR;
        PG8_WAIT_V(2); PG8_BAR;
        PG8_STAGE(PG8_SB(1, 0), cB + kstep, voffB); PG8_STAGE(PG8_SA(1, 0), cA + kstep, voffA); PG8_STAGE(PG8_SB(1, 1), cB + hstep + kstep, voffB);
        PG8_WAIT_V(6); PG8_BAR;
    } else {
        PG8_STAGE(PG8_SB(0, 0), cB, voffB); PG8_STAGE(PG8_SA(0, 0), cA, voffA); PG8_STAGE(PG8_SB(0, 1), cB + hstep, voffB); PG8_STAGE(PG8_SA(0, 1), cA + hstep, voffA);
        if (wr == 1) PG8_BAR;
        PG8_WAIT_V(4); PG8_BAR;
        PG8_STAGE(PG8_SB(1, 0), cB + kstep, voffB); PG8_STAGE(PG8_SA(1, 0), cA + kstep, voffA); PG8_STAGE(PG8_SB(1, 1), cB + hstep + kstep, voffB);
        PG8_WAIT_V(6); PG8_BAR;
    }
    for (;;) {
        const bool has_next = S.next(ui + 1, nxt);
        const char* nA = has_next ? (const char*)g.A + (size_t)nxt.pm * tstep : cA; const char* nB = has_next ? (const char*)g.Bt + (size_t)nxt.pn * tstep : cB;
        for (int t = 0; t < nt; t += 2) {
            const bool last = (t == nt - 2);
            const char* a1 = cA + (size_t)(t + 1) * kstep;
            const char* a2 = last ? nA : cA + (size_t)(t + 2) * kstep; const char* b2 = last ? nB : cB + (size_t)(t + 2) * kstep;
            const char* a3 = a2 + kstep; const char* b3 = b2 + kstep;
            if (last && has_next) S.a_ready(nxt);
            if constexpr (SP2) {
            PG8_LDB(B0, 0, 0); PG8_LDB(B1, 0, 1); PG8_SCHED; PG8_LDA(At, 0, 0); PG8_STAGE(PG8_SA(1, 1), a1 + hstep, voffA);
            PG8_WAIT_V(8); PG8_WAIT_L(0); PG8_BAR; PG8_MMA(0, 0, At, B0); PG8_MMA(0, 1, At, B1); PG8_BAR; PG8_SCHED;
            PG8_LDA(At, 0, 1); PG8_STAGE(PG8_SB(0, 0), b2, voffB); PG8_STAGE(PG8_SB(0, 1), b2 + hstep, voffB); PG8_STAGE(PG8_SA(0, 0), a2, voffA);
            PG8_WAIT_V(8); PG8_WAIT_L(0); PG8_BAR; PG8_MMA(1, 0, At, B0); PG8_MMA(1, 1, At, B1); PG8_BAR; PG8_SCHED;
            PG8_LDB(B0, 1, 0); PG8_LDB(B1, 1, 1); PG8_SCHED; PG8_LDA(At, 1, 0); PG8_STAGE(PG8_SA(0, 1), a2 + hstep, voffA);
            PG8_WAIT_V(8); PG8_WAIT_L(0); PG8_BAR; PG8_MMA(0, 0, At, B0); PG8_MMA(0, 1, At, B1); PG8_BAR; PG8_SCHED;
            PG8_LDA(At, 1, 1); PG8_STAGE(PG8_SB(1, 0), b3, voffB); PG8_STAGE(PG8_SB(1, 1), b3 + hstep, voffB); PG8_STAGE(PG8_SA(1, 0), a3, voffA);
            PG8_WAIT_V(8); PG8_WAIT_L(0); PG8_BAR; PG8_MMA(1, 0, At, B0); PG8_MMA(1, 1, At, B1); PG8_BAR; PG8_SCHED;
            } else {
            PG8_LDB(B0, 0, 0); PG8_SCHED; PG8_LDA(At, 0, 0); PG8_STAGE(PG8_SA(1, 1), a1 + hstep, voffA);
            PG8_WAIT_L(8); PG8_BAR; PG8_WAIT_L(0); PG8_MMA(0, 0, At, B0); PG8_BAR; PG8_SCHED;
            PG8_LDB(B1, 0, 1); PG8_STAGE(PG8_SB(0, 0), b2, voffB);
            PG8_BAR; PG8_WAIT_L(0); PG8_MMA(0, 1, At, B1); PG8_BAR;
            PG8_LDA(At, 0, 1); PG8_STAGE(PG8_SA(0, 0), a2, voffA);
            PG8_BAR; PG8_WAIT_L(0); PG8_MMA(1, 0, At, B0); PG8_BAR; PG8_SCHED;
            PG8_STAGE(PG8_SB(0, 1), b2 + hstep, voffB);
            PG8_WAIT_V(6); PG8_BAR; PG8_MMA(1, 1, At, B1); PG8_BAR;
            PG8_LDB(B0, 1, 0); PG8_SCHED; PG8_LDA(At, 1, 0); PG8_STAGE(PG8_SA(0, 1), a2 + hstep, voffA);
            PG8_WAIT_L(8); PG8_BAR; PG8_WAIT_L(0); PG8_MMA(0, 0, At, B0); PG8_BAR; PG8_SCHED;
            PG8_LDB(B1, 1, 1); PG8_STAGE(PG8_SB(1, 0), b3, voffB);
            PG8_BAR; PG8_WAIT_L(0); PG8_MMA(0, 1, At, B1); PG8_BAR;
            PG8_LDA(At, 1, 1); PG8_STAGE(PG8_SA(1, 0), a3, voffA);
            PG8_BAR; PG8_WAIT_L(0); PG8_MMA(1, 0, At, B0); PG8_BAR; PG8_SCHED;
            PG8_STAGE(PG8_SB(1, 1), b3 + hstep, voffB);
            PG8_WAIT_V(6); PG8_BAR; PG8_MMA(1, 1, At, B1); PG8_BAR;
            }
        }
        if constexpr (ALIGN_EPI) { if (wr == 0) PG8_BAR; }
        if constexpr (!Epi::AFTER_DRAIN) { E(acc, cur, wr, wc, fr, fq); S.done(cur); }
        if (!has_next) break;
#pragma unroll
        for (int a = 0; a < 2; ++a)
#pragma unroll
            for (int b = 0; b < 2; ++b)
#pragma unroll
                for (int m = 0; m < 4; ++m)
#pragma unroll
                    for (int n = 0; n < 2; ++n) acc[a][b][m][n] = (f32x4){0.f, 0.f, 0.f, 0.f};
        cur = nxt; cA = nA; cB = nB; ++ui;
        if constexpr (ALIGN_EPI) { if (wr == 1) PG8_BAR; }
    }
    PG8_WAIT_V(0);
    if constexpr (!ALIGN_EPI) { if (wr == 0) PG8_BAR; }
    PG8_BAR;
    if constexpr (Epi::AFTER_DRAIN) { E.fused(acc, cur, wr, wc, fr, fq, lds, wid, lane); S.done(cur); }
#undef PG8_SA
#undef PG8_SB
#undef PG8_STAGE
#undef PG8_LDA
#undef PG8_LDB
#undef PG8_MMA
#undef PG8_WAIT_V
#undef PG8_WAIT_L
#undef PG8_BAR
#undef PG8_SCHED
}
}
#define LAS __attribute__((address_space(3)))
typedef unsigned short bf16;
typedef float f32x4 __attribute__((ext_vector_type(4)));
typedef float f32x2 __attribute__((ext_vector_type(2)));
typedef float f32x16 __attribute__((ext_vector_type(16)));
typedef unsigned u32x4 __attribute__((ext_vector_type(4)));
typedef unsigned u32x2 __attribute__((ext_vector_type(2)));
typedef short bf16x8 __attribute__((ext_vector_type(8)));
typedef short s16x4 __attribute__((ext_vector_type(4)));
using pg8::Unit; using pg8::cvt_pk_bf16;

constexpr int NB = 4, SEQ = 8192, T = NB * SEQ, DM = 1024, DEPTH = 2, DINP = 3584, DFF = 2816, NMOD = 6144;
constexpr float EPS = 1e-6f;
constexpr size_t MiB = 1u << 20;
constexpr size_t WS_MOD = 0, WS_SHWIN = 256 * 1024, WS_SHWF = 512 * 1024, WS_SS = 1 * MiB, WS_SUMP = 3 * MiB, WS_SUMH = 4 * MiB, WS_CS = 8 * MiB, WS_W = 16 * MiB;
constexpr size_t WL_STRIDE = 28 * MiB, WL_IN = 0, WL_OUT = 7 * MiB, WL_FFI = 9 * MiB, WL_FFO = 20 * MiB, WL_UQ = 25 * MiB + 512 * 1024, WL_UKV = 26 * MiB + 256 * 1024, WL_LRU = 26 * MiB + 768 * 1024;
constexpr size_t WS_XS = 72 * MiB, WS_XL = 136 * MiB, WS_SGA = 200 * MiB, WS_SGB = 264 * MiB, WS_UU = 136 * MiB, WS_QD = 328 * MiB, WS_KVD = 344 * MiB, WS_KROPE = 352 * MiB,
                 WS_KR = 360 * MiB, WS_QN = 364 * MiB, WS_QR = 396 * MiB, WS_KN = 412 * MiB, WS_V = 444 * MiB, WS_END = 476 * MiB;
constexpr size_t WS_BAR = 5 * MiB;
constexpr int LDS_BYTES = 147456, LDS_XB = 144384;

__device__ const float INV_FREQ[32] = {1.0f, 0.7498942613601685f, 0.5623413324356079f, 0.4216965138912201f, 0.3162277638912201f, 0.23713737726211548f, 0.17782793939113617f, 0.133352130651474f, 0.10000000149011612f, 0.07498941570520401f, 0.05623413249850273f, 0.04216965287923813f, 0.03162277489900589f, 0.023713737726211548f, 0.017782794311642647f, 0.01333521492779255f, 0.009999999776482582f, 0.007498941849917173f, 0.005623413249850273f, 0.0042169648222625256f, 0.003162277629598975f, 0.00237137358635664f, 0.0017782794311642647f, 0.0013335214462131262f, 0.0010000000474974513f, 0.0007498942431993783f, 0.000562341301701963f, 0.0004216965171508491f, 0.0003162277571391314f, 0.00023713737027719617f, 0.00017782794020604342f, 0.0001333521504420787f};

struct Args {
    const float* x; const float* c; const int* pos; const float* w_ada; const float* b_ada; const float* w_in; const float* conv_w; const float* conv_b;
    const float* lru_wa; const float* lru_ba; const float* lru_wx; const float* lru_bx; const float* lru_a; const float* qg; const float* kvg;
    const float* w_uq; const float* w_ukv; const float* w_out; const float* w_ffi; const float* w_ffo; const float* fg;
    float* out; unsigned char* ws;
};

__device__ __forceinline__ float bf2f(bf16 u) { return __uint_as_float(((unsigned)u) << 16); }
__device__ __forceinline__ unsigned f2bf(float f) { unsigned u = __float_as_uint(f); return (u + 0x7fffu + ((u >> 16) & 1u)) >> 16; }
__device__ __forceinline__ float sigmoidf_(float x) { return __builtin_amdgcn_rcpf(1.0f + __builtin_amdgcn_exp2f(-1.4426950408889634f * x)); }
__device__ __forceinline__ void store8bf(bf16* p, f32x4 a, f32x4 b) { u32x4 w; w.x = cvt_pk_bf16(a[0], a[1]); w.y = cvt_pk_bf16(a[2], a[3]); w.z = cvt_pk_bf16(b[0], b[1]); w.w = cvt_pk_bf16(b[2], b[3]); *(u32x4*)p = w; }
__device__ __forceinline__ float sumsq4(f32x4 v) { return (v[0] * v[0] + v[1] * v[1]) + (v[2] * v[2] + v[3] * v[3]); }
__device__ __forceinline__ void atomic_addf(float* p, float v) { (void)__hip_atomic_fetch_add(p, v, __ATOMIC_RELAXED, __HIP_MEMORY_SCOPE_AGENT); }
__device__ __forceinline__ float wave_sum(float v) {
#pragma unroll
    for (int o = 1; o < 64; o <<= 1) v += __shfl_xor(v, o);
    return v;
}
#define LDS_WAIT() asm volatile("s_waitcnt lgkmcnt(0)" ::: "memory")

struct EpiIn {
    static constexpr bool PERM = true, AFTER_DRAIN = false;
    const float* ss; const float* shw; bf16* XL; bf16* QD; bf16* KVD; float* KROPE; bf16* SGA; bf16* SGB; float* ssq; float* sskv;
    __device__ __forceinline__ void operator()(const f32x4 (&acc)[2][2][4][2], const Unit& u, int wr, int wc, int fr, int fq) const {
        const int row0 = u.pm * 256 + wr * 64 + fr, b = u.pm >> 5, pn = u.pn, c8 = wc * 32 + 8 * fq;
        f32x4 sv[2][2];
#pragma unroll
        for (int bj = 0; bj < 2; ++bj)
#pragma unroll
            for (int n = 0; n < 2; ++n) sv[bj][n] = *(const f32x4*)(shw + b * DINP + pn * 256 + bj * 128 + c8 + 4 * n);
        float ssv[2][4];
#pragma unroll
        for (int ai = 0; ai < 2; ++ai)
#pragma unroll
            for (int m = 0; m < 4; ++m) ssv[ai][m] = ss[row0 + ai * 128 + m * 16];
#pragma unroll
        for (int ai = 0; ai < 2; ++ai)
#pragma unroll
            for (int m = 0; m < 4; ++m) {
                const size_t row = (size_t)(row0 + ai * 128 + m * 16);
                const float rstd = __builtin_amdgcn_rsqf(ssv[ai][m] * (1.0f / 1024.0f) + EPS);
                f32x4 v[2][2];
#pragma unroll
                for (int bj = 0; bj < 2; ++bj)
#pragma unroll
                    for (int n = 0; n < 2; ++n) v[bj][n] = acc[ai][bj][m][n] * rstd + sv[bj][n];
                if (pn < 4) {
#pragma unroll
                    for (int bj = 0; bj < 2; ++bj) store8bf(XL + row * 1024 + pn * 256 + bj * 128 + c8, v[bj][0], v[bj][1]);
                } else if (pn == 4) {
#pragma unroll
                    for (int bj = 0; bj < 2; ++bj) store8bf(QD + row * 256 + bj * 128 + c8, v[bj][0], v[bj][1]);
                    float s = (sumsq4(v[0][0]) + sumsq4(v[0][1])) + (sumsq4(v[1][0]) + sumsq4(v[1][1]));
                    s += __shfl_xor(s, 16); s += __shfl_xor(s, 32);
                    if (fq == 0) atomic_addf(ssq + row, s);
                } else if (pn == 5) {
                    store8bf(KVD + row * 128 + c8, v[0][0], v[0][1]);
                    float s = sumsq4(v[0][0]) + sumsq4(v[0][1]);
                    s += __shfl_xor(s, 16); s += __shfl_xor(s, 32);
                    if (fq == 0) atomic_addf(sskv + row, s);
                    if (wc < 2) { *(f32x4*)(KROPE + row * 64 + c8) = v[1][0]; *(f32x4*)(KROPE + row * 64 + c8 + 4) = v[1][1]; }
                } else {
                    bf16* G = (pn < 10) ? SGA + (pn - 6) * 256 : SGB + (pn - 10) * 256;
#pragma unroll
                    for (int bj = 0; bj < 2; ++bj) {
                        f32x4 a, c;
#pragma unroll
                        for (int j = 0; j < 4; ++j) { a[j] = sigmoidf_(v[bj][0][j]); c[j] = sigmoidf_(v[bj][1][j]); }
                        store8bf(G + row * 1024 + bj * 128 + c8, a, c);
                    }
                }
            }
    }
};
struct EpiQ {
    static constexpr bool PERM = true, AFTER_DRAIN = false;
    const float* ssq; const float* cs; bf16* QN; bf16* QR;
    __device__ __forceinline__ void operator()(const f32x4 (&acc)[2][2][4][2], const Unit& u, int wr, int wc, int fr, int fq) const {
        const int row0 = u.pm * 256 + wr * 64 + fr, pn = u.pn, c8 = wc * 32 + 8 * fq;
        float ssv[2][4];
#pragma unroll
        for (int ai = 0; ai < 2; ++ai)
#pragma unroll
            for (int m = 0; m < 4; ++m) ssv[ai][m] = ssq[row0 + ai * 128 + m * 16];
#pragma unroll
        for (int ai = 0; ai < 2; ++ai)
#pragma unroll
            for (int m = 0; m < 4; ++m) {
                const size_t row = (size_t)(row0 + ai * 128 + m * 16);
                const float rstd = __builtin_amdgcn_rsqf(ssv[ai][m] * (1.0f / 256.0f) + EPS);
                if (pn < 2) {
#pragma unroll
                    for (int bj = 0; bj < 2; ++bj) store8bf(QN + row * 512 + pn * 256 + bj * 128 + c8, acc[ai][bj][m][0] * rstd, acc[ai][bj][m][1] * rstd);
                } else {
                    const int i0 = (wc & 1) * 16 + 4 * fq;
                    const f32x4 cs0 = *(const f32x4*)(cs + row * 64 + 2 * i0), cs1 = *(const f32x4*)(cs + row * 64 + 2 * i0 + 4);
#pragma unroll
                    for (int bj = 0; bj < 2; ++bj) {
                        const f32x4 a = acc[ai][bj][m][0] * rstd, c = acc[ai][bj][m][1] * rstd; f32x4 oa, oc;
                        oa[0] = a[0] * cs0[0] - a[1] * cs0[1]; oa[1] = a[1] * cs0[0] + a[0] * cs0[1];
                        oa[2] = a[2] * cs0[2] - a[3] * cs0[3]; oa[3] = a[3] * cs0[2] + a[2] * cs0[3];
                        oc[0] = c[0] * cs1[0] - c[1] * cs1[1]; oc[1] = c[1] * cs1[0] + c[0] * cs1[1];
                        oc[2] = c[2] * cs1[2] - c[3] * cs1[3]; oc[3] = c[3] * cs1[2] + c[2] * cs1[3];
                        store8bf(QR + row * 256 + bj * 128 + c8, oa, oc);
                    }
                }
            }
    }
};
struct EpiKV {
    static constexpr bool PERM = true, AFTER_DRAIN = false;
    const float* sskv; bf16* KN; bf16* V;
    __device__ __forceinline__ void operator()(const f32x4 (&acc)[2][2][4][2], const Unit& u, int wr, int wc, int fr, int fq) const {
        const int row0 = u.pm * 256 + wr * 64 + fr, pn = u.pn, c8 = wc * 32 + 8 * fq;
        bf16* O = (pn < 2) ? KN + pn * 256 : V + (pn - 2) * 256;
        float ssv[2][4];
#pragma unroll
        for (int ai = 0; ai < 2; ++ai)
#pragma unroll
            for (int m = 0; m < 4; ++m) ssv[ai][m] = sskv[row0 + ai * 128 + m * 16];
#pragma unroll
        for (int ai = 0; ai < 2; ++ai)
#pragma unroll
            for (int m = 0; m < 4; ++m) {
                const size_t row = (size_t)(row0 + ai * 128 + m * 16);
                const float rstd = __builtin_amdgcn_rsqf(ssv[ai][m] * (1.0f / 128.0f) + EPS);
#pragma unroll
                for (int bj = 0; bj < 2; ++bj) store8bf(O + row * 512 + bj * 128 + c8, acc[ai][bj][m][0] * rstd, acc[ai][bj][m][1] * rstd);
            }
    }
};
struct EpiRes {
    static constexpr bool PERM = false, AFTER_DRAIN = false;
    const float* xres; float* xout; const float* g; const float* sc; bf16* XS; float* ssn;
    __device__ __forceinline__ void operator()(const f32x4 (&acc)[2][2][4][2], const Unit& u, int wr, int wc, int fr, int fq) const {
        const int row0 = u.pm * 256 + wr * 64 + fr, b = u.pm >> 5, col0 = u.pn * 256 + wc * 32 + 4 * fq;
        f32x4 gv[2][2], scv[2][2];
#pragma unroll
        for (int bj = 0; bj < 2; ++bj)
#pragma unroll
            for (int n = 0; n < 2; ++n) { gv[bj][n] = *(const f32x4*)(g + b * NMOD + col0 + bj * 128 + n * 16);
                scv[bj][n] = sc ? *(const f32x4*)(sc + b * NMOD + col0 + bj * 128 + n * 16) + 1.0f : (f32x4){1.f, 1.f, 1.f, 1.f}; }
#pragma unroll
        for (int ai = 0; ai < 2; ++ai)
#pragma unroll
        for (int mp = 0; mp < 2; ++mp) {
            f32x4 pre[2][2][2];
#pragma unroll
            for (int mm = 0; mm < 2; ++mm)
#pragma unroll
                for (int bj = 0; bj < 2; ++bj)
#pragma unroll
                    for (int n = 0; n < 2; ++n) pre[mm][bj][n] = *(const f32x4*)(xres + (size_t)(row0 + ai * 128 + (2 * mp + mm) * 16) * 1024 + col0 + bj * 128 + n * 16);
#pragma unroll
            for (int mm = 0; mm < 2; ++mm) { const int m = 2 * mp + mm;
                const size_t row = (size_t)(row0 + ai * 128 + m * 16); float s = 0.f;
#pragma unroll
                for (int bj = 0; bj < 2; ++bj)
#pragma unroll
                    for (int n = 0; n < 2; ++n) { const size_t off = row * 1024 + col0 + bj * 128 + n * 16;
                        const f32x4 xv = pre[mm][bj][n] + gv[bj][n] * acc[ai][bj][m][n];
                        *(f32x4*)(xout + off) = xv; s += sumsq4(xv);
                        if (sc) { const f32x4 y = xv * scv[bj][n]; u32x2 w; w.x = cvt_pk_bf16(y[0], y[1]); w.y = cvt_pk_bf16(y[2], y[3]); *(u32x2*)(XS + off) = w; } }
                s += __shfl_xor(s, 16); s += __shfl_xor(s, 32);
                if (fq == 0) atomic_addf(ssn + row, s);
            }
        }
    }
};
struct EpiFfi {
    static constexpr bool PERM = true, AFTER_DRAIN = false;
    const float* ss; const float* shw; bf16* UU;
    __device__ __forceinline__ void operator()(const f32x4 (&acc)[2][2][4][2], const Unit& u, int wr, int wc, int fr, int fq) const {
        const int row0 = u.pm * 256 + wr * 64 + fr, b = u.pm >> 5, pn = u.pn, c8 = wc * 32 + 8 * fq;
        f32x4 sv[2][2];
#pragma unroll
        for (int bj = 0; bj < 2; ++bj)
#pragma unroll
            for (int n = 0; n < 2; ++n) sv[bj][n] = *(const f32x4*)(shw + b * (2 * DFF) + pn * 256 + bj * 128 + c8 + 4 * n);
        float ssv[2][4];
#pragma unroll
        for (int ai = 0; ai < 2; ++ai)
#pragma unroll
            for (int m = 0; m < 4; ++m) ssv[ai][m] = ss[row0 + ai * 128 + m * 16];
#pragma unroll
        for (int ai = 0; ai < 2; ++ai)
#pragma unroll
            for (int m = 0; m < 4; ++m) {
                const size_t row = (size_t)(row0 + ai * 128 + m * 16);
                const float rstd = __builtin_amdgcn_rsqf(ssv[ai][m] * (1.0f / 1024.0f) + EPS);
                f32x4 h[2];
#pragma unroll
                for (int n = 0; n < 2; ++n) { const f32x4 gt = acc[ai][0][m][n] * rstd + sv[0][n], up = acc[ai][1][m][n] * rstd + sv[1][n];
#pragma unroll
                    for (int j = 0; j < 4; ++j) h[n][j] = gt[j] * sigmoidf_(gt[j]) * up[j]; }
                store8bf(UU + row * DFF + pn * 128 + c8, h[0], h[1]);
            }
    }
};
#define XB_TMO      128
#define XB_XCNT(j)  (256  + 64 * (j))
#define XB_XSUB(j)  (1280 + 64 * (j))
#define XB_XGEN(j)  (2304 + 64 * (j))
#define XB_TOP      3328
#define XB_TOPGEN   3392
#define XCD_BAR_WORDS 3456
#define XB_SPIN_CAP (1u << 18)

__device__ __forceinline__ unsigned xb_ld(unsigned* p)              { return __hip_atomic_load(p, __ATOMIC_RELAXED, __HIP_MEMORY_SCOPE_AGENT); }
__device__ __forceinline__ unsigned xb_add(unsigned* p, unsigned v) { return __hip_atomic_fetch_add(p, v, __ATOMIC_RELAXED, __HIP_MEMORY_SCOPE_AGENT); }
__device__ __forceinline__ unsigned xb_xcc_id() { return (unsigned)__builtin_amdgcn_s_getreg((3 << 11) | 20) & 0xFu; }
#define XB_SPIN(cond, bar) do { unsigned _sp = 0; while (cond) { __builtin_amdgcn_s_sleep(1); \
    if ((++_sp & 255u) == 0u) { if (xb_ld(&(bar)[XB_TMO])) break; if (_sp > XB_SPIN_CAP) { atomicAdd(&(bar)[XB_TMO], 1u); break; } } } } while (0)

struct XcdBarrier {
    unsigned* bar; unsigned x;
    volatile LAS unsigned* st;
};

__device__ __forceinline__ XcdBarrier xcd_barrier_post(unsigned* bar, volatile LAS unsigned* st) {
    XcdBarrier b; b.bar = bar; b.x = xb_xcc_id(); b.st = st;
    if (threadIdx.x == 0) (void)xb_add(&bar[XB_XCNT(b.x)], 1u);
    return b;
}
__device__ __forceinline__ void xcd_barrier_complete(unsigned* bar, unsigned x, unsigned& nloc, unsigned& nx) {
    const unsigned G = gridDim.x * gridDim.y * gridDim.z;
    unsigned sum, cnt, mine, sp = 0u;
    for (;;) {
        sum = 0u; cnt = 0u; mine = 0u;
#pragma unroll
        for (unsigned j = 0; j < 16; ++j) { const unsigned c = xb_ld(&bar[XB_XCNT(j)]); sum += c; cnt += (c > 0u) ? 1u : 0u; mine = (j == x) ? c : mine; }
        if (sum == G) break;
        __builtin_amdgcn_s_sleep(1);
        if ((++sp & 255u) == 0u) { if (xb_ld(&bar[XB_TMO])) break; if (sp > XB_SPIN_CAP) { atomicAdd(&bar[XB_TMO], 1u); break; } }
    }
    nloc = mine > 0u ? mine : 1u; nx = cnt > 0u ? cnt : 1u;
}

__device__ __forceinline__ void xcd_barrier(const XcdBarrier& b) {
    asm volatile("s_waitcnt vmcnt(0)" ::: "memory");
    __syncthreads();
    if (threadIdx.x == 0) {
        unsigned* bar = b.bar;
        __builtin_amdgcn_s_waitcnt(0);
        unsigned nloc = b.st[0], nx = b.st[1];
        if (nloc == 0u) { xcd_barrier_complete(bar, b.x, nloc, nx); b.st[0] = nloc; b.st[1] = nx; }
        const unsigned old = xb_add(&bar[XB_XSUB(b.x)], 1u);
        const unsigned gen = old / nloc;
        if (old + 1u == (gen + 1u) * nloc) {
            __builtin_amdgcn_fence(__ATOMIC_RELEASE, "agent");
            asm volatile("s_waitcnt vmcnt(0)" ::: "memory");
            const unsigned og = xb_add(&bar[XB_TOP], 1u);
            const unsigned tg = og / nx;
            if (og + 1u == (tg + 1u) * nx) xb_add(&bar[XB_TOPGEN], 1u);
            else XB_SPIN(xb_ld(&bar[XB_TOPGEN]) == tg, bar);
            __builtin_amdgcn_fence(__ATOMIC_ACQUIRE, "agent");
            xb_add(&bar[XB_XGEN(b.x)], 1u);
            asm volatile("s_waitcnt vmcnt(0)" ::: "memory");
        } else {
            XB_SPIN(xb_ld(&bar[XB_XGEN(b.x)]) == gen, bar);
            __builtin_amdgcn_fence(__ATOMIC_ACQUIRE, "agent");
            asm volatile("s_waitcnt vmcnt(0)" ::: "memory");
        }
    }
    __syncthreads();
}
__device__ __forceinline__ int map_col(int id, int n) {
    switch (id) {
        case 0: return n < 1472 ? n : (n < 1536 ? -1 : n - 64);
        case 2: { const int pn = n >> 8, w = n & 255; return w < 128 ? pn * 128 + w : DFF + pn * 128 + (w - 128); }
        case 3: { const int hh = n / 768; int r = n % 768;
                  if (r < 512) return (4 * hh + (r >> 7)) * 192 + (r & 127);
                  r -= 512; const int e = r & 63; return (4 * hh + (r >> 6)) * 192 + 128 + (e >> 1) + 32 * (e & 1); }
        case 4: { const int hh = n >> 10; int r = n & 1023;
                  if (r < 512) return (4 * hh + (r >> 7)) * 256 + (r & 127);
                  r -= 512; return (4 * hh + (r >> 7)) * 256 + 128 + (r & 127); }
        default: return n;
    }
}
__device__ __forceinline__ void transpose_item(const float* W, int ldw, int K, bf16* WT, int id, const float* kscale, int nblk, int item, LAS float* scr, int lane) {
    const int kb = item / nblk, nb = item % nblk, k0 = 64 * kb, n0 = 32 * nb;
    const int sc = map_col(id, n0 + (lane & 31));
#pragma unroll 16
    for (int i = 0; i < 32; ++i) { const int kk = 2 * i + (lane >> 5); float v = sc >= 0 ? W[(size_t)(k0 + kk) * ldw + sc] : 0.f; if (kscale) v *= kscale[k0 + kk]; scr[kk * 33 + (lane & 31)] = v; }
    LDS_WAIT(); asm volatile("" ::: "memory");
    const int c = lane & 7;
#pragma unroll
    for (int j = 0; j < 4; ++j) { const int n = (lane >> 3) + 8 * j; const LAS float* s = scr + (8 * c) * 33 + n;
        u32x4 o; o.x = cvt_pk_bf16(s[0 * 33], s[1 * 33]); o.y = cvt_pk_bf16(s[2 * 33], s[3 * 33]); o.z = cvt_pk_bf16(s[4 * 33], s[5 * 33]); o.w = cvt_pk_bf16(s[6 * 33], s[7 * 33]);
        *(u32x4*)(WT + (size_t)(n0 + n) * K + k0 + 8 * c) = o; }
    LDS_WAIT(); asm volatile("" ::: "memory");
}
#define OPAQUE_TID() int tid_ = threadIdx.x; asm volatile("" : "+v"(tid_)); const int lane = tid_ & 63, wave = __builtin_amdgcn_readfirstlane(tid_ >> 6), NGW = gridDim.x * 8, gw = blockIdx.x * 8 + wave; (void)lane; (void)wave; (void)NGW; (void)gw
__device__ __forceinline__ void phase0(const Args& a, LAS unsigned char* lds) {
    OPAQUE_TID();
    LAS float* scr = (LAS float*)(lds + wave * 16384);
    float* mod = (float*)(a.ws + WS_MOD);
    for (int it = blockIdx.x; it < DEPTH * (NMOD / 64); it += gridDim.x) {
        const int l = it / (NMOD / 64), n = (it % (NMOD / 64)) * 64 + lane;
        float a0 = 0.f, a1 = 0.f, a2 = 0.f, a3 = 0.f;
        const float* w = a.w_ada + (size_t)l * DM * NMOD + (size_t)(wave * 128) * NMOD + n; const float* cc = a.c + wave * 128;
#pragma unroll 16
        for (int k = 0; k < 128; ++k) { const float wv = w[(size_t)k * NMOD]; a0 += cc[k] * wv; a1 += cc[DM + k] * wv; a2 += cc[2 * DM + k] * wv; a3 += cc[3 * DM + k] * wv; }
        LAS float* red = (LAS float*)(lds + 73728);
        red[(wave * 4 + 0) * 64 + lane] = a0; red[(wave * 4 + 1) * 64 + lane] = a1; red[(wave * 4 + 2) * 64 + lane] = a2; red[(wave * 4 + 3) * 64 + lane] = a3;
        __syncthreads();
        if (wave < 4) { float s = a.b_ada[l * NMOD + n];
#pragma unroll
            for (int q = 0; q < 8; ++q) s += red[(q * 4 + wave) * 64 + lane];
            mod[(l * 4 + wave) * NMOD + n] = s; }
        __syncthreads();
    }
    constexpr int I_IN = 16 * (DINP / 32), I_OUT = 16 * 32, I_FFI = 16 * (2 * DFF / 32), I_FFO = (DFF / 64) * 32, I_UQ = 4 * 48, I_UKV = 2 * 64, I_LRU = 16 * 8;
    constexpr int I_L = I_IN + I_OUT + I_FFI + I_FFO + I_UQ + I_UKV + I_LRU;
    for (int it = gw; it < DEPTH * I_L; it += NGW) {
        const int l = it / I_L; int r = it % I_L; unsigned char* wl = a.ws + WS_W + (size_t)l * WL_STRIDE;
        if (r < I_IN) { transpose_item(a.w_in + (size_t)l * DM * 3520, 3520, DM, (bf16*)(wl + WL_IN), 0, nullptr, DINP / 32, r, scr, lane); continue; } r -= I_IN;
        if (r < I_OUT) { transpose_item(a.w_out + (size_t)l * DM * DM, DM, DM, (bf16*)(wl + WL_OUT), 1, nullptr, 32, r, scr, lane); continue; } r -= I_OUT;
        if (r < I_FFI) { transpose_item(a.w_ffi + (size_t)l * DM * 2 * DFF, 2 * DFF, DM, (bf16*)(wl + WL_FFI), 2, nullptr, 2 * DFF / 32, r, scr, lane); continue; } r -= I_FFI;
        if (r < I_FFO) { transpose_item(a.w_ffo + (size_t)l * DFF * DM, DM, DFF, (bf16*)(wl + WL_FFO), 1, nullptr, 32, r, scr, lane); continue; } r -= I_FFO;
        if (r < I_UQ) { transpose_item(a.w_uq + (size_t)l * 256 * 1536, 1536, 256, (bf16*)(wl + WL_UQ), 3, a.qg + l * 256, 48, r, scr, lane); continue; } r -= I_UQ;
        if (r < I_UKV) { transpose_item(a.w_ukv + (size_t)l * 128 * 2048, 2048, 128, (bf16*)(wl + WL_UKV), 4, a.kvg + l * 128, 64, r, scr, lane); continue; } r -= I_UKV;
        { const int mtx = r >> 3, nb = mtx >> 1, which = mtx & 1;
          const float* src = (which ? a.lru_wx : a.lru_wa) + (size_t)l * 8 * 16384 + (size_t)nb * 16384;
          transpose_item(src, 128, 128, (bf16*)(wl + WL_LRU) + (size_t)(nb * 256 + which * 128) * 128, 1, nullptr, 4, r & 7, scr, lane); }
    }
    f32x2* cs = (f32x2*)(a.ws + WS_CS);
    for (int e = gw * 64 + lane; e < T * 32; e += NGW * 64) {
        const int t = e >> 5, i = e & 31;
        const float ang = (float)a.pos[t] * INV_FREQ[i];
        const double q = rint((double)ang * 0.15915494309189535);
        const float rr = (float)((double)ang - q * 6.283185307179586);
        cs[e] = (f32x2){__cosf(rr), __sinf(rr)};
    }
}
__device__ __forceinline__ void phase1(const Args& a) {
    OPAQUE_TID();
    const float* mod = (const float*)(a.ws + WS_MOD);
    float* ss = (float*)(a.ws + WS_SS); bf16* XS = (bf16*)(a.ws + WS_XS);
    for (int row0 = gw; row0 < T; row0 += 4 * NGW) {
        f32x4 v[4][4]; float s[4];
#pragma unroll
        for (int q = 0; q < 4; ++q) { const int row = row0 + q * NGW; const f32x4* xr = (const f32x4*)(a.x + (size_t)row * DM) + lane; s[q] = 0.f;
#pragma unroll
            for (int j = 0; j < 4; ++j) { v[q][j] = xr[64 * j]; } }
#pragma unroll
        for (int q = 0; q < 4; ++q) { const int row = row0 + q * NGW, b = row >> 13; const f32x4* scp = (const f32x4*)(mod + b * NMOD + 1024) + lane;
#pragma unroll
            for (int j = 0; j < 4; ++j) s[q] += sumsq4(v[q][j]);
            s[q] = wave_sum(s[q]);
            u32x2* o = (u32x2*)(XS + (size_t)row * DM) + lane;
#pragma unroll
            for (int j = 0; j < 4; ++j) { const f32x4 y = v[q][j] * (scp[64 * j] + 1.0f); u32x2 w; w.x = cvt_pk_bf16(y[0], y[1]); w.y = cvt_pk_bf16(y[2], y[3]); o[64 * j] = w; }
            if (lane == 0) ss[row] = s[q];
            if (lane >= 1 && lane <= 8) ss[(size_t)lane * T + row] = 0.f; }
    }
    constexpr int NI = DINP + 2 * DFF;
    for (int it = gw; it < DEPTH * NI; it += NGW) {
        const int l = it / NI; int n = it % NI; const bool isf = n >= DINP; if (isf) n -= DINP;
        const bf16* wrow = (const bf16*)(a.ws + WS_W + (size_t)l * WL_STRIDE + (isf ? WL_FFI : WL_IN)) + (size_t)n * DM;
        const float* sh = mod + (size_t)l * 4 * NMOD + (isf ? 3072 : 0);
        float s0 = 0.f, s1 = 0.f, s2 = 0.f, s3 = 0.f;
#pragma unroll
        for (int h = 0; h < 2; ++h) { const int k0 = h * 512 + lane * 8; const bf16x8 wv = *(const bf16x8*)(wrow + k0);
#pragma unroll
            for (int j = 0; j < 8; ++j) { const float w = bf2f((bf16)wv[j]); s0 += w * sh[k0 + j]; s1 += w * sh[NMOD + k0 + j]; s2 += w * sh[2 * NMOD + k0 + j]; s3 += w * sh[3 * NMOD + k0 + j]; } }
        s0 = wave_sum(s0); s1 = wave_sum(s1); s2 = wave_sum(s2); s3 = wave_sum(s3);
        if (lane == 0) { float* o = (float*)(a.ws + (isf ? WS_SHWF : WS_SHWIN)) + (size_t)l * 4 * (isf ? 2 * DFF : DINP) + n; const int st = isf ? 2 * DFF : DINP; o[0] = s0; o[st] = s1; o[2 * st] = s2; o[3 * st] = s3; }
    }
}
__device__ __forceinline__ void lru_phase(const Args& a, int l, char* lds, bool dummy = false) {
    int tid_ = threadIdx.x; asm volatile("" : "+v"(tid_));
    const int tid = tid_, lane = tid & 63, wave = tid >> 6, fq = lane >> 4, fc = lane & 15;
    const bf16* XL = (const bf16*)(a.ws + WS_XL); bf16* SGA = (bf16*)(a.ws + WS_SGA); bf16* WC = (bf16*)(a.ws + WS_XS);
    float* sumP = (float*)(a.ws + WS_SUMP); float* sumH = (float*)(a.ws + WS_SUMH);
    const bf16* Wl = (const bf16*)(a.ws + WS_W + (size_t)l * WL_STRIDE + WL_LRU);
    const float* cw = a.conv_w + (size_t)l * 4 * DM; const float* cb = a.conv_b + (size_t)l * DM;
    constexpr int PITCH = 272, TILE = 128 * PITCH, OFF_SG = TILE, OFF_WC = 2 * TILE, OFF_PF = 3 * TILE;
    const int cgp = tid & 15, rr = tid >> 4;
    f32x4 w[4][2], bb[2]; bf16x8 bwa[4], bwx[4]; float ba = 0.f, bx = 0.f, c8 = 0.f; int nb_cur = -1;
    for (int unit = blockIdx.x; unit < (T / 128) * 8; unit += gridDim.x) {
        const int chunk = unit >> 3, nb = unit & 7, t0 = chunk * 128; const bool first = (t0 & (SEQ - 1)) == 0;
        const int ch = nb * 128 + cgp * 8;
        if (nb != nb_cur) { nb_cur = nb;
#pragma unroll
            for (int j = 0; j < 4; ++j) { w[j][0] = *(const f32x4*)(cw + j * DM + ch); w[j][1] = *(const f32x4*)(cw + j * DM + ch + 4); }
            bb[0] = *(const f32x4*)(cb + ch); bb[1] = *(const f32x4*)(cb + ch + 4);
            const bf16* wr_ = Wl + (size_t)(nb * 256 + 16 * wave + fc) * 128 + fq * 8;
#pragma unroll
            for (int ks = 0; ks < 4; ++ks) { bwa[ks] = *(const bf16x8*)(wr_ + ks * 32); bwx[ks] = *(const bf16x8*)(wr_ + 128 * 128 + ks * 32); }
            const int c_ = nb * 128 + 16 * wave + fc;
            ba = a.lru_ba[l * DM + c_]; bx = a.lru_bx[l * DM + c_]; c8 = -8.0f * log1pf(__expf(-a.lru_a[l * DM + c_])); }
        {
            bf16x8 sgv[4], xv[4][4];
#pragma unroll
            for (int p = 0; p < 4; ++p) sgv[p] = *(const bf16x8*)(SGA + (size_t)(t0 + p * 32 + rr) * DM + ch);
            int pf = 0; if (tid < 128) pf = a.pos[t0 + tid];
#pragma unroll
            for (int p = 0; p < 4; ++p)
#pragma unroll
                for (int j = 0; j < 4; ++j) { const int rj = p * 32 + rr - 3 + j;
                    xv[p][j] = (first && rj < 0) ? (bf16x8){0, 0, 0, 0, 0, 0, 0, 0} : *(const bf16x8*)(XL + (size_t)(t0 + rj) * DM + ch); }
            __syncthreads();
#pragma unroll
            for (int p = 0; p < 4; ++p) { const int row = p * 32 + rr; f32x4 o0 = bb[0], o1 = bb[1];
#pragma unroll
                for (int j = 0; j < 4; ++j) {
#pragma unroll
                    for (int e = 0; e < 4; ++e) { o0[e] += w[j][0][e] * bf2f((bf16)xv[p][j][e]); o1[e] += w[j][1][e] * bf2f((bf16)xv[p][j][4 + e]); } }
                u32x4 pk; pk.x = cvt_pk_bf16(o0[0], o0[1]); pk.y = cvt_pk_bf16(o0[2], o0[3]); pk.z = cvt_pk_bf16(o1[0], o1[1]); pk.w = cvt_pk_bf16(o1[2], o1[3]);
                *(u32x4*)(lds + row * PITCH + cgp * 16) = pk; }
#pragma unroll
            for (int p = 0; p < 4; ++p) *(bf16x8*)(lds + OFF_SG + (p * 32 + rr) * PITCH + cgp * 16) = sgv[p];
            if (tid < 128) *(int*)(lds + OFF_PF + tid * 4) = pf;
        }
        __syncthreads();
        f32x4 accA[8], accX[8];
        {
#pragma unroll
            for (int m = 0; m < 8; ++m) { accA[m] = (f32x4){0.f, 0.f, 0.f, 0.f}; accX[m] = (f32x4){0.f, 0.f, 0.f, 0.f};
#pragma unroll
                for (int ks = 0; ks < 4; ++ks) { const bf16x8 av = *(const bf16x8*)(lds + (16 * m + fc) * PITCH + ks * 64 + fq * 16);
                    accA[m] = __builtin_amdgcn_mfma_f32_16x16x32_bf16(av, bwa[ks], accA[m], 0, 0, 0);
                    accX[m] = __builtin_amdgcn_mfma_f32_16x16x32_bf16(av, bwx[ks], accX[m], 0, 0, 0); } }
        }
        const int cl = 16 * wave + fc, c = nb * 128 + cl;
        float Pm = 1.f, Hm = 0.f;
#pragma unroll
        for (int m = 0; m < 8; ++m) {
            float P[4], Hh[4], sg[4];
#pragma unroll
            for (int j = 0; j < 4; ++j) { const int tl = 16 * m + 4 * fq + j;
                const float r = sigmoidf_(accA[m][j] + ba), ig = sigmoidf_(accX[m][j] + bx);
                const float la = c8 * r, x2 = 2.0f * la;
                float av = __expf(la);
                float om = (x2 > -0.1f) ? -(x2 * (1.0f + x2 * (0.5f + x2 * (0.16666667f + x2 * 0.041666668f)))) : 1.0f - __expf(x2);
                float mult = __builtin_amdgcn_sqrtf(om);
                if (*(const int*)(lds + OFF_PF + tl * 4) == 0) { av = 0.f; mult = 1.f; }
                const float xc = bf2f(*(const bf16*)(lds + tl * PITCH + cl * 2));
                const float bv = xc * ig * mult;
                sg[j] = bf2f(*(const bf16*)(lds + OFF_SG + tl * PITCH + cl * 2));
                if (j == 0) { P[0] = av; Hh[0] = bv; } else { P[j] = P[j - 1] * av; Hh[j] = av * Hh[j - 1] + bv; } }
            float Pa = P[3], Ha = Hh[3];
            { const float Pp = __shfl_up(Pa, 16), Hp = __shfl_up(Ha, 16); if (fq >= 1) { Ha = Pa * Hp + Ha; Pa = Pp * Pa; } }
            { const float Pp = __shfl_up(Pa, 32), Hp = __shfl_up(Ha, 32); if (fq >= 2) { Ha = Pa * Hp + Ha; Pa = Pp * Pa; } }
            float Pex = __shfl_up(Pa, 16), Hex = __shfl_up(Ha, 16); if (fq == 0) { Pex = 1.f; Hex = 0.f; }
            const float Pt = __shfl(Pa, 48 + fc), Ht = __shfl(Ha, 48 + fc);
            const float Pin = Pm * Pex, Hin = Pex * Hm + Hex;
#pragma unroll
            for (int j = 0; j < 4; ++j) { const int tl = 16 * m + 4 * fq + j;
                const float cp = P[j] * Pin, hl = Hh[j] + P[j] * Hin;
                const unsigned pk = cvt_pk_bf16(sg[j] * hl, sg[j] * cp);
                *(bf16*)(lds + OFF_SG + tl * PITCH + cl * 2) = (bf16)(pk & 0xffffu); *(bf16*)(lds + OFF_WC + tl * PITCH + cl * 2) = (bf16)(pk >> 16); }
            Hm = Pt * Hm + Ht; Pm = Pm * Pt;
        }
        if (fq == 0) { sumP[(size_t)chunk * DM + c] = Pm; sumH[(size_t)chunk * DM + c] = Hm; }
        __syncthreads();
#pragma unroll
        for (int p = 0; p < 4; ++p) { const int row = p * 32 + rr; const size_t gi = (size_t)(t0 + row) * DM + ch;
            *(bf16x8*)((dummy ? (bf16*)a.out : SGA) + gi) = *(const bf16x8*)(lds + OFF_SG + row * PITCH + cgp * 16);
            *(bf16x8*)((dummy ? (bf16*)a.out + (size_t)T * DM : WC) + gi) = *(const bf16x8*)(lds + OFF_WC + row * PITCH + cgp * 16); }
    }
    __syncthreads();
}
__device__ __forceinline__ void krope_phase(const Args& a) {
    const float* KROPE = (const float*)(a.ws + WS_KROPE); unsigned* KR = (unsigned*)(a.ws + WS_KR); const f32x2* cs = (const f32x2*)(a.ws + WS_CS);
    int tid_ = threadIdx.x; asm volatile("" : "+v"(tid_));
    for (int e = blockIdx.x * 512 + tid_; e < T * 32; e += gridDim.x * 512) {
        const int t = e >> 5, i = e & 31; const float x1 = KROPE[t * 64 + i], x2 = KROPE[t * 64 + 32 + i]; const f32x2 v = cs[e];
        KR[e] = cvt_pk_bf16(x1 * v.x - x2 * v.y, x2 * v.x + x1 * v.y);
    }
}
__device__ __forceinline__ void final_phase(const Args& a) {
    OPAQUE_TID();
    for (int row0 = gw; row0 < T; row0 += 2 * NGW) {
        f32x4 v[2][4];
#pragma unroll
        for (int q = 0; q < 2; ++q) { const f32x4* xr = (const f32x4*)(a.out + (size_t)(row0 + q * NGW) * DM) + lane;
#pragma unroll
            for (int j = 0; j < 4; ++j) v[q][j] = xr[64 * j]; }
#pragma unroll
        for (int q = 0; q < 2; ++q) { float s = 0.f;
#pragma unroll
            for (int j = 0; j < 4; ++j) s += sumsq4(v[q][j]);
            const float rstd = __builtin_amdgcn_rsqf(wave_sum(s) * (1.0f / 1024.0f) + EPS);
            f32x4* xr = (f32x4*)(a.out + (size_t)(row0 + q * NGW) * DM) + lane; const f32x4* g = (const f32x4*)a.fg + lane;
#pragma unroll
            for (int j = 0; j < 4; ++j) xr[64 * j] = v[q][j] * rstd * g[64 * j]; }
    }
}
namespace att {
constexpr int KVBLK = 64, QB = 256;
constexpr int KP = 272, RP = 144;
constexpr int SHM_V = 16384, SHM_K = 64 * KP, SHM_R = 64 * RP;
constexpr int OFF_V = 0, OFF_K = 3 * SHM_V, OFF_R = OFF_K + 2 * SHM_K, OFF_QR = OFF_R + 2 * SHM_R  , OFF_WS = OFF_QR + 32768, OFF_CARRY = OFF_WS + 2048, ATT_LDS = OFF_CARRY + 1024;
static_assert(OFF_WS >= 131072 && ATT_LDS <= LDS_XB, "attention LDS map");
constexpr float SCALE = 0.07216878364870322f;
constexpr float THR = 8.f;
#define SBAR() __builtin_amdgcn_sched_barrier(0)
__device__ __forceinline__ int v_st(int k, int c) { const int kk = (k & ~0xC) | ((k & 4) << 1) | ((k & 8) >> 1); return ((kk >> 3) * 4 + (c >> 5)) * 512 + ((kk & 7) * 32 + (c & 31)) * 2; }
__device__ __forceinline__ int v_rd_base(int lane) { return ((lane & 3) << 3) | (((lane >> 2) & 3) << 6) | (((lane >> 4) & 1) << 5) | (((lane >> 5) & 1) << 8); }
constexpr int v_rd_off(int d0, int ks, int half) { return d0 * 512 + ks * 4096 + half * 2048; }
__device__ __forceinline__ int crow(int r, int hi) { return (r & 3) + 8 * (r >> 2) + 4 * hi; }
__device__ __forceinline__ unsigned cvtpk(float lo, float hi) { return pg8::cvt_pk_bf16(lo, hi); }
__device__ __forceinline__ void mask_tile(f32x16& p0, f32x16& p1, int dq) {
    const float NEG = -__builtin_inff();
#pragma unroll
    for (int r = 0; r < 16; ++r) { const int c = (r & 3) + 8 * (r >> 2);
        if (dq - c < 0) p0[r] = NEG;
        if (dq - c - 32 < 0) p1[r] = NEG; }
}
__device__ __forceinline__ void partialSM(f32x16& p0, f32x16& p1, float& m_reg, float& mn, float& alpha) {
    float pmax = p0[0];
#pragma unroll
    for (int r = 1; r < 16; ++r) pmax = fmaxf(pmax, p0[r]);
#pragma unroll
    for (int r = 0; r < 16; ++r) pmax = fmaxf(pmax, p1[r]);
    { auto rr = __builtin_amdgcn_permlane32_swap(__float_as_uint(pmax), __float_as_uint(pmax), false, false);
      pmax = fmaxf(__uint_as_float(rr[0]), __uint_as_float(rr[1])); }
    constexpr float C2 = 1.4426950408889634f * SCALE;
    if (__builtin_expect(__all((pmax - m_reg) * SCALE <= THR), 1)) { mn = m_reg; alpha = 1.f; }
    else { mn = fmaxf(m_reg, pmax); alpha = __builtin_amdgcn_exp2f((m_reg - mn) * C2); m_reg = mn; }
    const float mnL = -mn * C2;
#pragma unroll
    for (int r = 0; r < 16; ++r) p0[r] = fmaf(p0[r], C2, mnL);
#pragma unroll
    for (int r = 0; r < 16; ++r) p1[r] = fmaf(p1[r], C2, mnL);
#pragma unroll
    for (int r = 0; r < 16; ++r) p0[r] = __builtin_amdgcn_exp2f(p0[r]);
}
__device__ __forceinline__ void finishSM(f32x16& p0, f32x16& p1, float alpha, float& l_reg, bf16x8& pa0, bf16x8& pa1, bf16x8& pa2, bf16x8& pa3) {
#pragma unroll
    for (int r = 0; r < 16; ++r) p1[r] = __builtin_amdgcn_exp2f(p1[r]);
    float ps = 0;
#pragma unroll
    for (int r = 0; r < 16; ++r) ps += p0[r];
#pragma unroll
    for (int r = 0; r < 16; ++r) ps += p1[r];
    { auto rr = __builtin_amdgcn_permlane32_swap(__float_as_uint(ps), __float_as_uint(ps), false, false);
      ps = __uint_as_float(rr[0]) + __uint_as_float(rr[1]); }
    l_reg = l_reg * alpha + ps;
#define PK4(P, B_, OUT) do { unsigned a0 = cvtpk(P[B_+0], P[B_+1]), a1 = cvtpk(P[B_+2], P[B_+3]);                          \
        unsigned b0 = cvtpk(P[B_+4], P[B_+5]), b1 = cvtpk(P[B_+6], P[B_+7]);                                             \
        auto r0 = __builtin_amdgcn_permlane32_swap(a0, b0, false, false); auto r1 = __builtin_amdgcn_permlane32_swap(a1, b1, false, false); \
        u32x4 w = {r0[0], r1[0], r0[1], r1[1]}; OUT = *reinterpret_cast<bf16x8*>(&w); } while (0)
    PK4(p0, 0, pa0); PK4(p0, 8, pa1); PK4(p1, 0, pa2); PK4(p1, 8, pa3);
#undef PK4
}
template <int KB>
__device__ __forceinline__ void qkt(f32x16& p0, f32x16& p1, const char* lds, int r32, int hi, const bf16x8* qn, const char* qrr) {
    p0 = f32x16{}; p1 = f32x16{};
    bf16x8 qr[4];
#pragma unroll
    for (int d0 = 0; d0 < 4; ++d0) qr[d0] = *(const bf16x8*)(qrr + d0 * 1024);
    const char* ka = lds + OFF_K + KB * SHM_K + r32 * KP + hi * 16;
#pragma unroll
    for (int d0 = 0; d0 < 8; ++d0) {
        bf16x8 b0 = *reinterpret_cast<const bf16x8*>(ka + d0 * 32);
        bf16x8 b1 = *reinterpret_cast<const bf16x8*>(ka + d0 * 32 + 32 * KP);
        p0 = __builtin_amdgcn_mfma_f32_32x32x16_bf16(b0, qn[d0], p0, 0, 0, 0);
        p1 = __builtin_amdgcn_mfma_f32_32x32x16_bf16(b1, qn[d0], p1, 0, 0, 0); }
    const char* ra = lds + OFF_R + KB * SHM_R + r32 * RP + hi * 16;
#pragma unroll
    for (int d0 = 0; d0 < 4; ++d0) {
        bf16x8 b0 = *reinterpret_cast<const bf16x8*>(ra + d0 * 32);
        bf16x8 b1 = *reinterpret_cast<const bf16x8*>(ra + d0 * 32 + 32 * RP);
        p0 = __builtin_amdgcn_mfma_f32_32x32x16_bf16(b0, qr[d0], p0, 0, 0, 0);
        p1 = __builtin_amdgcn_mfma_f32_32x32x16_bf16(b1, qr[d0], p1, 0, 0, 0); }
}
template <int KB>
__device__ __forceinline__ void qkt_fin(f32x16& p0, f32x16& p1, f32x16& y0, f32x16& y1, float alpha, float& l_reg, bf16x8& pa0, bf16x8& pa1, bf16x8& pa2, bf16x8& pa3,
                                        const char* lds, int r32, int hi, const bf16x8* qn, const char* qrr) {
    p0 = f32x16{}; p1 = f32x16{};
    const char* ka = lds + OFF_K + KB * SHM_K + r32 * KP + hi * 16;
    const char* ra = lds + OFF_R + KB * SHM_R + r32 * RP + hi * 16;
#define QK_LD(i, X0, X1) do { if ((i) < 8) { X0 = *reinterpret_cast<const bf16x8*>(ka + (i) * 32); X1 = *reinterpret_cast<const bf16x8*>(ka + (i) * 32 + 32 * KP); } \
                              else { X0 = *reinterpret_cast<const bf16x8*>(ra + ((i) - 8) * 32); X1 = *reinterpret_cast<const bf16x8*>(ra + ((i) - 8) * 32 + 32 * RP); \
                                     Q##X0 = *(const bf16x8*)(qrr + ((i) - 8) * 1024); } } while (0)
#define QK_MM(i, X0, X1) do { const bf16x8 q_ = (i) < 8 ? qn[(i) < 8 ? (i) : 0] : Q##X0; \
        p0 = __builtin_amdgcn_mfma_f32_32x32x16_bf16(X0, q_, p0, 0, 0, 0); p1 = __builtin_amdgcn_mfma_f32_32x32x16_bf16(X1, q_, p1, 0, 0, 0); } while (0)
#define QK_PK4(P, B_, OUT) do { unsigned a0_ = cvtpk(P[B_+0], P[B_+1]), a1_ = cvtpk(P[B_+2], P[B_+3]); unsigned b0_ = cvtpk(P[B_+4], P[B_+5]), b1_ = cvtpk(P[B_+6], P[B_+7]); \
        auto r0_ = __builtin_amdgcn_permlane32_swap(a0_, b0_, false, false); auto r1_ = __builtin_amdgcn_permlane32_swap(a1_, b1_, false, false); \
        u32x4 w_ = {r0_[0], r1_[0], r0_[1], r1_[1]}; OUT = *reinterpret_cast<bf16x8*>(&w_); } while (0)
    bf16x8 A0, A1, B0, B1, C0, C1, QA0, QB0, QC0; float ps = 0.f;
    QK_LD(0, A0, A1); QK_LD(1, B0, B1); SBAR();
    QK_LD(2, C0, C1); QK_MM(0, A0, A1);
#pragma unroll
    for (int r = 0; r < 4; ++r) y1[r] = __builtin_amdgcn_exp2f(y1[r]);
    QK_PK4(y0, 0, pa0); SBAR();
    QK_LD(3, A0, A1); QK_MM(1, B0, B1);
#pragma unroll
    for (int r = 4; r < 8; ++r) y1[r] = __builtin_amdgcn_exp2f(y1[r]);
    QK_PK4(y0, 8, pa1); SBAR();
    QK_LD(4, B0, B1); QK_MM(2, C0, C1);
#pragma unroll
    for (int r = 8; r < 12; ++r) y1[r] = __builtin_amdgcn_exp2f(y1[r]);
#pragma unroll
    for (int r = 0; r < 8; ++r) ps += y0[r];
    SBAR();
    QK_LD(5, C0, C1); QK_MM(3, A0, A1);
#pragma unroll
    for (int r = 12; r < 16; ++r) y1[r] = __builtin_amdgcn_exp2f(y1[r]);
#pragma unroll
    for (int r = 8; r < 16; ++r) ps += y0[r];
    SBAR();
    QK_LD(6, A0, A1); QK_MM(4, B0, B1);
    QK_PK4(y1, 0, pa2);
#pragma unroll
    for (int r = 0; r < 8; ++r) ps += y1[r];
    SBAR();
    QK_LD(7, B0, B1); QK_MM(5, C0, C1);
    QK_PK4(y1, 8, pa3);
#pragma unroll
    for (int r = 8; r < 16; ++r) ps += y1[r];
    SBAR();
    QK_LD(8, C0, C1); QK_MM(6, A0, A1);
    { auto rr = __builtin_amdgcn_permlane32_swap(__float_as_uint(ps), __float_as_uint(ps), false, false); ps = __uint_as_float(rr[0]) + __uint_as_float(rr[1]); }
    l_reg = l_reg * alpha + ps;
    SBAR();
    QK_LD(9, A0, A1); QK_MM(7, B0, B1); SBAR();
    QK_LD(10, B0, B1); QK_MM(8, C0, C1); SBAR();
    QK_LD(11, C0, C1); QK_MM(9, A0, A1); SBAR();
    QK_MM(10, B0, B1); SBAR();
    QK_MM(11, C0, C1);
#undef QK_LD
#undef QK_MM
#undef QK_PK4
}
__device__ __forceinline__ void pv_tile(f32x16* o, int vb0, bf16x8 pa0, bf16x8 pa1, bf16x8 pa2, bf16x8 pa3) {
#define TRRD(dst, off) asm volatile("ds_read_b64_tr_b16 %0, %1 offset:%2" : "=&v"(dst) : "v"(vb0), "i"(off) : "memory")
#define PV_D0(d0) do { s16x4 l0, l1, l2, l3, h0, h1, h2, h3; constexpr int b_ = v_rd_off(d0, 0, 0); \
        TRRD(l0, b_); TRRD(h0, b_ + 2048); TRRD(l1, b_ + 4096); TRRD(h1, b_ + 6144); TRRD(l2, b_ + 8192); TRRD(h2, b_ + 10240); TRRD(l3, b_ + 12288); TRRD(h3, b_ + 14336); \
        asm volatile("s_waitcnt lgkmcnt(0)" ::: "memory"); SBAR();   \
        o[d0] = __builtin_amdgcn_mfma_f32_32x32x16_bf16(pa0, (bf16x8){l0[0], l0[1], l0[2], l0[3], h0[0], h0[1], h0[2], h0[3]}, o[d0], 0, 0, 0);   \
        o[d0] = __builtin_amdgcn_mfma_f32_32x32x16_bf16(pa1, (bf16x8){l1[0], l1[1], l1[2], l1[3], h1[0], h1[1], h1[2], h1[3]}, o[d0], 0, 0, 0);   \
        o[d0] = __builtin_amdgcn_mfma_f32_32x32x16_bf16(pa2, (bf16x8){l2[0], l2[1], l2[2], l2[3], h2[0], h2[1], h2[2], h2[3]}, o[d0], 0, 0, 0);   \
        o[d0] = __builtin_amdgcn_mfma_f32_32x32x16_bf16(pa3, (bf16x8){l3[0], l3[1], l3[2], l3[3], h3[0], h3[1], h3[2], h3[3]}, o[d0], 0, 0, 0); } while (0)
    PV_D0(0); PV_D0(1); PV_D0(2); PV_D0(3);
#undef PV_D0
#undef TRRD
}
__device__ __forceinline__ void attn_unit(int rb, int hh, int hl, int qb, unsigned char* wsb, char* lds, bool do_store = true) {
    const bf16* Qn = (const bf16*)(wsb + WS_QN); const bf16* Qr = (const bf16*)(wsb + WS_QR); const bf16* Kn = (const bf16*)(wsb + WS_KN); const bf16* Kr = (const bf16*)(wsb + WS_KR); const bf16* Vv = (const bf16*)(wsb + WS_V);
    int tid_ = threadIdx.x; asm volatile("" : "+v"(tid_));
    const int tid = tid_, wid = __builtin_amdgcn_readfirstlane(tid >> 6), lane = tid & 63, r32 = lane & 31, hi = lane >> 5;
    const int q0 = qb * QB, NT = (q0 + QB) / KVBLK;
    const int qlo = q0 + wid * 32, qm = qlo + r32 - 4 * hi;
    char* V_lds = lds + OFF_V; char* K_lds = lds + OFF_K; char* R_lds = lds + OFF_R;
    float* ws = (float*)(lds + OFF_WS) + wid * 64; float* li_l = ws; float* al_l = ws + 32;
    float* carry = (float*)(lds + OFF_CARRY);
    const int cb = (4 * hh + hl) * 128;
    const bf16* Kh = Kn + (size_t)rb * 512 + hl * 128; const bf16* Vh = Vv + (size_t)rb * 512 + hl * 128; const bf16* Rh = Kr + (size_t)rb * 64;
    const int sr = tid >> 4, sc = (tid & 15) * 8, vst0 = v_st(sr, sc), vst1 = v_st(32 + sr, sc), kws = sr * KP + sc * 2;
    const int rrow = tid >> 3, rc = (tid & 7) * 8, rws = rrow * RP + rc * 2;
    const int vb0 = (int)(uintptr_t)V_lds + v_rd_base(lane);
    bf16x8 st_v0, st_v1, st_k0, st_k1, st_r;
#define VMW() asm volatile("s_waitcnt vmcnt(0)" ::: "memory")
#define SLOAD(k0) do { st_v0 = *(const bf16x8*)(Vh + (size_t)((k0) + sr) * 512 + sc); st_v1 = *(const bf16x8*)(Vh + (size_t)((k0) + 32 + sr) * 512 + sc); \
                       st_k0 = *(const bf16x8*)(Kh + (size_t)((k0) + sr) * 512 + sc); st_k1 = *(const bf16x8*)(Kh + (size_t)((k0) + 32 + sr) * 512 + sc); \
                       st_r = *(const bf16x8*)(Rh + (size_t)((k0) + rrow) * 64 + rc); } while (0)
#define SWRITE(bf, vs) do { *(bf16x8*)(V_lds + (vs) + vst0) = st_v0; *(bf16x8*)(V_lds + (vs) + vst1) = st_v1; \
                        *(bf16x8*)(K_lds + (bf) * SHM_K + kws) = st_k0; *(bf16x8*)(K_lds + (bf) * SHM_K + kws + 32 * KP) = st_k1; \
                        *(bf16x8*)(R_lds + (bf) * SHM_R + rws) = st_r; } while (0)
    SLOAD(0);
    bf16x8 qn[8];
    const char* qrr = lds + OFF_QR + wid * 4096 + lane * 16;
    bf16x8 qrt[4];
    { const bf16* qg = Qr + (size_t)(rb + q0 + wid * 32 + r32) * 256 + hl * 64 + hi * 8;
#pragma unroll
      for (int d0 = 0; d0 < 4; ++d0) qrt[d0] = *(const bf16x8*)(qg + d0 * 16); }
    { const bf16* qrow = Qn + (size_t)(rb + q0 + wid * 32 + r32) * 512 + hl * 128 + hi * 8;
#pragma unroll
      for (int d0 = 0; d0 < 8; ++d0) qn[d0] = *(const bf16x8*)(qrow + d0 * 16); }
    float Hc = 0.f;
    if (tid < 256) { const int which = tid >> 7, c = tid & 127, kmax = qb * 2 + which; const size_t base = (size_t)(rb >> 7) * 1024 + cb + c;
        const float* sumP = (const float*)(wsb + WS_SUMP); const float* sumH = (const float*)(wsb + WS_SUMH);
        for (int j = 0; j < kmax; j += 8) { float hv[8], pw[8];
#pragma unroll
            for (int q = 0; q < 8; ++q) { const bool ok = j + q < kmax; hv[q] = ok ? sumH[base + (size_t)(j + q) * 1024] : 0.f; pw[q] = ok ? sumP[base + (size_t)(j + q) * 1024] : 1.f; }
#pragma unroll
            for (int q = 0; q < 8; ++q) Hc = hv[q] + pw[q] * Hc; } }
    __syncthreads();
#pragma unroll
    for (int d0 = 0; d0 < 4; ++d0) *(bf16x8*)(lds + OFF_QR + wid * 4096 + lane * 16 + d0 * 1024) = qrt[d0];
    if (tid < 256) carry[(tid >> 7) * 128 + (tid & 127)] = Hc;
    VMW(); SWRITE(0, 0); SBAR();
    SLOAD(KVBLK);
    __syncthreads();
    float m_reg = -1e30f, l_reg = 0; f32x16 o[4] = {};
    f32x16 pA0, pA1, pB0, pB1; float mnA, mnB, alA, alB; bf16x8 pa0, pa1, pa2, pa3;
    int sl_prev = 0, sl_cur = 0, sl_next = SHM_V;
#define ROT() do { sl_prev = sl_cur; sl_cur = sl_next; sl_next = (sl_next == 2 * SHM_V) ? 0 : sl_next + SHM_V; } while (0)
#define RESC(a) do { if (__any((a) < 1.f)) { if (hi == 0) al_l[r32] = (a); asm volatile("s_waitcnt lgkmcnt(0)" ::: "memory");              \
                     for (int d_ = 0; d_ < 4; ++d_) for (int r = 0; r < 16; ++r) o[d_][r] *= al_l[crow(r, hi)]; } } while (0)
#define MASKT(P0_, P1_, t) do { const int kb_ = (t) * KVBLK; if (kb_ + KVBLK - 1 > qlo) mask_tile(P0_, P1_, qm - kb_); } while (0)
    SBAR(); qkt<0>(pA0, pA1, lds, r32, hi, qn, qrr);
    MASKT(pA0, pA1, 0); partialSM(pA0, pA1, m_reg, mnA, alA);
    VMW(); SWRITE(1, SHM_V);
    __syncthreads();
    ROT();
#define STEP(PX0, PX1, mnX, alX, PY0, PY1, alY, t, KB, LAST) do {                                                             \
        SBAR(); qkt_fin<KB>(PX0, PX1, PY0, PY1, alY, l_reg, pa0, pa1, pa2, pa3, lds, r32, hi, qn, qrr); SBAR();               \
        if (!(LAST)) { SLOAD(((t) + 1) * KVBLK); SBAR(); }                                                                    \
        pv_tile(o, vb0 + sl_prev, pa0, pa1, pa2, pa3); MASKT(PX0, PX1, (t)); partialSM(PX0, PX1, m_reg, mnX, alX);            \
        if (!(LAST)) { VMW(); SWRITE(1 - (KB), sl_next); }                                                                    \
        RESC(alX);                                                                                                            \
        if (!(LAST)) { __syncthreads(); ROT(); } } while (0)
    for (int t = 1; t + 1 < NT; t += 2) {
        STEP(pB0, pB1, mnB, alB, pA0, pA1, alA, t, 1, false);
        STEP(pA0, pA1, mnA, alA, pB0, pB1, alB, t + 1, 0, false);
    }
    STEP(pB0, pB1, mnB, alB, pA0, pA1, alA, NT - 1, 1, true);
    finishSM(pB0, pB1, alB, l_reg, pa0, pa1, pa2, pa3); SBAR(); pv_tile(o, vb0 + sl_cur, pa0, pa1, pa2, pa3);
    if (hi == 0) li_l[r32] = l_reg; asm volatile("s_waitcnt lgkmcnt(0)" ::: "memory");
    const size_t gbase = (size_t)(rb + q0 + wid * 32 + (lane >> 4)) * DM + cb + (lane & 15) * 8;
    bf16x8 uu[8], ww[8], gg[8];
    { const bf16* U = (const bf16*)(wsb + WS_SGA) + gbase; const bf16* WC = (const bf16*)(wsb + WS_XS) + gbase; const bf16* SGB = (const bf16*)(wsb + WS_SGB) + gbase;
#pragma unroll
      for (int i = 0; i < 8; ++i) { uu[i] = *(const bf16x8*)(U + (size_t)i * 4 * DM); ww[i] = *(const bf16x8*)(WC + (size_t)i * 4 * DM); gg[i] = *(const bf16x8*)(SGB + (size_t)i * 4 * DM); } }
    __syncthreads();
    {
        float* stg = (float*)lds + wid * 4096;
#pragma unroll
        for (int r = 0; r < 16; ++r) { const int orow = crow(r, hi); const float rl = __builtin_amdgcn_rcpf(li_l[orow]);
#pragma unroll
            for (int d0 = 0; d0 < 4; ++d0) stg[orow * 128 + d0 * 32 + r32] = o[d0][r] * rl; }
        asm volatile("s_waitcnt lgkmcnt(0)" ::: "memory");
        const float* cr = carry + (wid >> 2) * 128 + (lane & 15) * 8;
        const f32x4 h0 = *(const f32x4*)cr, h1 = *(const f32x4*)(cr + 4);
        bf16* Y = (bf16*)(wsb + WS_XL) + gbase;
        const float* sp = stg + (lane >> 4) * 128 + (lane & 15) * 8;
#pragma unroll
        for (int i = 0; i < 8; ++i) {
            const bf16x8 u = uu[i], w = ww[i], g = gg[i];
            const f32x4 v0 = *(const f32x4*)(sp + i * 512), v1 = *(const f32x4*)(sp + i * 512 + 4);
            f32x4 y0, y1;
#pragma unroll
            for (int e = 0; e < 4; ++e) { y0[e] = bf2f((bf16)u[e]) + bf2f((bf16)w[e]) * h0[e] + bf2f((bf16)g[e]) * v0[e];
                                          y1[e] = bf2f((bf16)u[4 + e]) + bf2f((bf16)w[4 + e]) * h1[e] + bf2f((bf16)g[4 + e]) * v1[e]; }
            if (do_store) store8bf(Y + (size_t)i * 4 * DM, y0, y1);
        }
    }
#undef RESC
#undef MASKT
#undef STEP
#undef ROT
#undef SLOAD
#undef SWRITE
#undef VMW
}
#undef SBAR
}
__global__ void __launch_bounds__(512, 2) fwd_megakernel(Args a) {
    extern __shared__ __attribute__((aligned(16))) unsigned char lds[];
    cg::grid_group grid = cg::this_grid();
    {
        if (threadIdx.x < 8) ((LAS unsigned*)(lds + LDS_XB))[threadIdx.x] = 0u;
        __syncthreads();
    }
    grid.sync();
    (void)xcd_barrier_post((unsigned*)(a.ws + WS_BAR), (volatile LAS unsigned*)((LAS unsigned char*)lds + LDS_XB));
#define GSYNC() do { XcdBarrier b_; b_.bar = (unsigned*)(a.ws + WS_BAR); b_.x = xb_xcc_id(); b_.st = (volatile LAS unsigned*)((LAS unsigned char*)lds + LDS_XB); xcd_barrier(b_); } while (0)
    const int G = gridDim.x;
    LAS unsigned char* ldsl = (LAS unsigned char*)lds;
    unsigned char* ws = a.ws;
    float* mod = (float*)(ws + WS_MOD); float* ss = (float*)(ws + WS_SS);
    bf16* XS = (bf16*)(ws + WS_XS); bf16* XL = (bf16*)(ws + WS_XL); bf16* SGA = (bf16*)(ws + WS_SGA); bf16* SGB = (bf16*)(ws + WS_SGB); bf16* UU = (bf16*)(ws + WS_UU);
    bf16* QD = (bf16*)(ws + WS_QD); bf16* KVD = (bf16*)(ws + WS_KVD); float* KROPE = (float*)(ws + WS_KROPE); bf16* KR = (bf16*)(ws + WS_KR);
    bf16* QN = (bf16*)(ws + WS_QN); bf16* QR = (bf16*)(ws + WS_QR); bf16* KN = (bf16*)(ws + WS_KN); bf16* VV = (bf16*)(ws + WS_V);

#ifndef PHM
#define PHM 0xFFFF
#endif
    if (PHM & 1) phase0(a, ldsl);
    GSYNC();
    if (PHM & 2) phase1(a);
    GSYNC();
#ifdef PROBE_P01
    phase0(a, ldsl);
    GSYNC();
    phase1(a);
    GSYNC();
#endif
    for (int l = 0; l < DEPTH; ++l) {
        unsigned char* wl = ws + WS_W + (size_t)l * WL_STRIDE;
        float* ssA = ss + (size_t)(4 * l) * T; float* ssB = ssA + T; float* ssQ = ssA + 2 * T; float* ssKV = ssA + 3 * T; float* ssN = ssA + 4 * T;
        const float* modl = mod + (size_t)l * 4 * NMOD;
        if (PHM & 4) {
            pg8::Gemm g{(const bf16*)XS, (const bf16*)(wl + WL_IN), T, DINP, DM}; pg8::StaticOrder S; S.init(T, DINP, G, (int)blockIdx.x);
            EpiIn E{ssA, (const float*)(ws + WS_SHWIN) + (size_t)l * 4 * DINP, XL, QD, KVD, KROPE, SGA, SGB, ssQ, ssKV};
            pg8::gemm_phase<EpiIn, pg8::StaticOrder, true, true>(ldsl, g, S, E);
        }
        GSYNC();
        for (int hh = 0; hh < 2; ++hh) {
#ifdef PROBE_LRU2
            if (hh == 0 && l == 0) { lru_phase(a, l, (char*)lds, true); lru_phase(a, l, (char*)lds, true); }
#endif
            if ((PHM & 8) && hh == 0) { lru_phase(a, l, (char*)lds); krope_phase(a); }
            if (PHM & 16) {
                int Kq = 256; asm volatile("" : "+s"(Kq));
                pg8::Gemm g{(const bf16*)QD, (const bf16*)(wl + WL_UQ) + (size_t)hh * 768 * 256, T, 768, Kq}; pg8::StaticOrder S; S.init(T, 768, G, (int)blockIdx.x);
                EpiQ E{ssQ, (const float*)(ws + WS_CS), QN, QR};
                pg8::gemm_phase<EpiQ, pg8::StaticOrder, true, true>(ldsl, g, S, E);
            }
            if (PHM & 32) {
                int Kk = 128; asm volatile("" : "+s"(Kk));
                pg8::Gemm g{(const bf16*)KVD, (const bf16*)(wl + WL_UKV) + (size_t)hh * 1024 * 128, T, 1024, Kk}; pg8::StaticOrder S; S.init(T, 1024, G, (int)blockIdx.x);
                EpiKV E{ssKV, KN, VV};
                pg8::gemm_phase<EpiKV, pg8::StaticOrder, true, true>(ldsl, g, S, E);
            }
#ifdef PROBE_QKV2
            {
                int Kq = 256; asm volatile("" : "+s"(Kq));
                pg8::Gemm g{(const bf16*)QD, (const bf16*)(wl + WL_UQ) + (size_t)hh * 768 * 256, T, 768, Kq}; pg8::StaticOrder S; S.init(T, 768, G, (int)blockIdx.x);
                EpiQ E{ssQ, (const float*)(ws + WS_CS), QN, QR};
                pg8::gemm_phase<EpiQ, pg8::StaticOrder, true, true>(ldsl, g, S, E);
            }
            {
                int Kk = 128; asm volatile("" : "+s"(Kk));
                pg8::Gemm g{(const bf16*)KVD, (const bf16*)(wl + WL_UKV) + (size_t)hh * 1024 * 128, T, 1024, Kk}; pg8::StaticOrder S; S.init(T, 1024, G, (int)blockIdx.x);
                EpiKV E{ssKV, KN, VV};
                pg8::gemm_phase<EpiKV, pg8::StaticOrder, true, true>(ldsl, g, S, E);
            }
#endif
            GSYNC();
            const int vcu = (G % 8 == 0) ? (int)(blockIdx.x & 7) * (G / 8) + (int)(blockIdx.x >> 3) : (int)blockIdx.x;
            if (PHM & 64) for (int p2 = 2 * vcu; p2 < 512; p2 += ((p2 & 1) ? 2 * G - 1 : 1)) {
                const int p = p2 >> 1, bh = p >> 4, s = p & 15, b = bh >> 2, hl = bh & 3;
                att::attn_unit(b * SEQ, hh, hl, (p2 & 1) ? s : 31 - s, ws, (char*)lds);
            }
#ifdef PROBE_ATT2
#ifndef PROBE_NOSYNC
            GSYNC();
#endif
            if (hh == PROBE_ATT2 - 1) for (int p2 = 2 * blockIdx.x; p2 < 512; p2 += ((p2 & 1) ? 2 * G - 1 : 1)) {
                const int p = p2 >> 1, bh = p >> 4, s = p & 15, b = bh >> 2, hl = bh & 3;
                att::attn_unit(b * SEQ, hh, hl, (p2 & 1) ? s : 31 - s, ws, (char*)lds, PROBE_STORE);
            }
#endif
            GSYNC();
        }
        if (PHM & 128) {
            pg8::Gemm g{(const bf16*)XL, (const bf16*)(wl + WL_OUT), T, DM, DM}; pg8::StaticOrder S; S.init(T, DM, G, (int)blockIdx.x);
            EpiRes E{l == 0 ? a.x : a.out, a.out, modl + 2048, modl + 4096, XS, ssB};
            pg8::gemm_phase<EpiRes, pg8::StaticOrder, true, true>(ldsl, g, S, E);
        }
        GSYNC();
        if (PHM & 256) {
            pg8::Gemm g{(const bf16*)XS, (const bf16*)(wl + WL_FFI), T, 2 * DFF, DM}; pg8::StaticOrder S; S.init(T, 2 * DFF, G, (int)blockIdx.x);
            EpiFfi E{ssB, (const float*)(ws + WS_SHWF) + (size_t)l * 4 * 2 * DFF, UU};
            pg8::gemm_phase<EpiFfi, pg8::StaticOrder, true, true>(ldsl, g, S, E);
#ifdef PROBE_FFI2
            GSYNC();
            pg8::gemm_phase<EpiFfi, pg8::StaticOrder, true, true>(ldsl, g, S, E);
#endif
        }
        GSYNC();
        if (PHM & 512) {
            pg8::Gemm g{(const bf16*)UU, (const bf16*)(wl + WL_FFO), T, DM, DFF}; pg8::StaticOrder S; S.init(T, DM, G, (int)blockIdx.x);
            EpiRes E{a.out, a.out, modl + 5120, (l + 1 < DEPTH) ? modl + 4 * NMOD + 1024 : nullptr, XS, ssN};
            pg8::gemm_phase<EpiRes, pg8::StaticOrder, true, true>(ldsl, g, S, E);
        }
        GSYNC();
    }
    if (PHM & 1024) final_phase(a);
}

extern "C" void kernel_launch(void* const* d_in, const int* in_sizes, int n_in, void* d_out, int out_size, void* d_ws, size_t ws_size, hipStream_t stream) {
    static int grid = 0;
    if (grid == 0) {
        int dev = 0, cus = 0, per_cu = 0;
        if (hipGetDevice(&dev) != hipSuccess || hipDeviceGetAttribute(&cus, hipDeviceAttributeMultiprocessorCount, dev) != hipSuccess) { grid = -1; return; }
        if (hipFuncSetAttribute((const void*)fwd_megakernel, hipFuncAttributeMaxDynamicSharedMemorySize, LDS_BYTES) != hipSuccess) { fprintf(stderr, "hipFuncSetAttribute failed\n"); grid = -1; return; }
        if (hipOccupancyMaxActiveBlocksPerMultiprocessor(&per_cu, (const void*)fwd_megakernel, 512, LDS_BYTES) != hipSuccess || per_cu < 1) per_cu = 1;
        (void)hipGetLastError();
        grid = cus;
        if (ws_size < WS_END) { fprintf(stderr, "workspace too small: %zu < %zu\n", ws_size, (size_t)WS_END); grid = -1; return; }
    }
    if (grid < 0) return;
    Args a{};
    a.x = (const float*)d_in[0]; a.c = (const float*)d_in[1]; a.pos = (const int*)d_in[2]; a.w_ada = (const float*)d_in[3]; a.b_ada = (const float*)d_in[4];
    a.w_in = (const float*)d_in[5]; a.conv_w = (const float*)d_in[6]; a.conv_b = (const float*)d_in[7]; a.lru_wa = (const float*)d_in[8]; a.lru_ba = (const float*)d_in[9];
    a.lru_wx = (const float*)d_in[10]; a.lru_bx = (const float*)d_in[11]; a.lru_a = (const float*)d_in[12]; a.qg = (const float*)d_in[13]; a.kvg = (const float*)d_in[14];
    a.w_uq = (const float*)d_in[15]; a.w_ukv = (const float*)d_in[16]; a.w_out = (const float*)d_in[17]; a.w_ffi = (const float*)d_in[18]; a.w_ffo = (const float*)d_in[19];
    a.fg = (const float*)d_in[20]; a.out = (float*)d_out; a.ws = (unsigned char*)d_ws;
    if (hipMemsetAsync((char*)d_ws + WS_BAR, 0, 16384, stream) != hipSuccess) { fprintf(stderr, "memset failed\n"); return; }
    void* args[] = {&a};
    hipError_t e = hipLaunchCooperativeKernel((const void*)fwd_megakernel, dim3(grid), dim3(512), args, LDS_BYTES, stream);
    if (e != hipSuccess) fprintf(stderr, "cooperative launch failed: %s (grid %d)\n", hipGetErrorString(e), grid);
}
```
